# Optimizing an MI355X kernel written in HIP

```python
import jax
import jax.numpy as jnp
from jax import lax
import numpy as np

D_MODEL = 1024
BATCH = 2
SEQ = 16384
DEPTH = 2

MIX_W = D_MODEL // 2
N_BRANCHES = 3
RET_HEADS = 4
RET_DV = MIX_W // RET_HEADS
RET_DK = RET_DV // 2
RET_CHUNK = 128
ML_HEADS = 4
ML_DH = MIX_W // ML_HEADS
ML_CONV = 4
ML_QK_BLOCK = 4
ML_CHUNK = 128
ATT_PATTERNS = ((128, 1), (512, 4), (2048, 16))
ATT_GROUPS = len(ATT_PATTERNS)
ATT_HEADS = 4
ATT_DV = MIX_W // ATT_HEADS
ATT_DK = ATT_DV // 2
N_EXPERTS = 32
TOP_K = 4
D_FF = D_MODEL
SWIGLU_LIMIT = 7.0
SWIGLU_ALPHA = 1.702
MOE_BLOCK = 128
DN_ALPHA = (2.0 * DEPTH) ** 0.25
DN_BETA = (8.0 * DEPTH) ** -0.25
EPS = 1e-5

IN_SIZES = (RET_HEADS * RET_DK, RET_HEADS * RET_DK, MIX_W, MIX_W,
            MIX_W, ML_HEADS, ML_HEADS, MIX_W,
            ATT_GROUPS * ATT_HEADS * ATT_DK, ATT_GROUPS * ATT_HEADS * ATT_DK, ATT_GROUPS * ATT_HEADS * ATT_DV,
            N_BRANCHES * D_MODEL)
IN_SPLITS = tuple(int(v) for v in np.cumsum(IN_SIZES)[:-1])
D_IN = int(sum(IN_SIZES))

kernel_name = 'hybrid_retention_mlstm_dilattn_moe_deepnorm'


def _layer_norm(x, g, b):
    xf = x.astype(jnp.float32)
    mu = jnp.mean(xf, -1, keepdims=True)
    var = jnp.mean(jnp.square(xf - mu), -1, keepdims=True)
    return ((xf - mu) * lax.rsqrt(var + EPS) * g.astype(jnp.float32) + b.astype(jnp.float32)).astype(x.dtype)


def _head_norm(h, g):
    mu = jnp.mean(h, -1, keepdims=True)
    var = jnp.mean(jnp.square(h - mu), -1, keepdims=True)
    y = (h - mu) * lax.rsqrt(var + EPS)
    return y.reshape(h.shape[:-2] + (-1,)) * g.astype(jnp.float32)


def _causal_conv(x, w, b):
    k_, c_ = w.shape
    y = lax.conv_general_dilated(x, w[:, None, :].astype(x.dtype), window_strides=(1,), padding=[(k_ - 1, 0)],
                                 dimension_numbers=('NWC', 'WIO', 'NWC'), feature_group_count=c_)
    return y + b


def _retention(q, k, v):
    f32 = jnp.float32
    b_, s_, h_, dk = q.shape
    c = RET_CHUNK
    n = s_ // c
    log_gamma = jnp.log1p(-jnp.exp2(-5.0 - jnp.arange(h_, dtype=f32)))
    q = q.astype(f32).reshape(b_, n, c, h_, dk)
    k = k.astype(f32).reshape(b_, n, c, h_, dk) * (dk ** -0.5)
    v = v.astype(f32).reshape(b_, n, c, h_, -1)
    pos = jnp.arange(c, dtype=f32)
    diff = pos[:, None] - pos[None, :]
    decay = jnp.where(diff >= 0, jnp.exp(log_gamma[:, None, None] * jnp.maximum(diff, 0.0)), 0.0)
    inner = jnp.einsum('bnhij,bnjhe->bnihe', jnp.einsum('bnihd,bnjhd->bnhij', q, k) * decay, v)
    k_decay = jnp.exp(log_gamma[:, None] * (c - 1.0 - pos))
    q_decay = jnp.exp(log_gamma[:, None] * (pos + 1.0))
    chunk_kv = jnp.einsum('bnjhd,bnjhe,hj->nbhde', k, v, k_decay)
    chunk_decay = jnp.exp(log_gamma * c)[None, :, None, None]

    def step(state, kv):
        return chunk_decay * state + kv, state

    _, prev = lax.scan(step, jnp.zeros(chunk_kv.shape[1:], f32), chunk_kv)
    cross = jnp.einsum('bnihd,nbhde,hi->bnihe', q, prev, q_decay)
    return (inner + cross).reshape(b_, s_, h_, -1)


def _mlstm(q, k, v, i_pre, f_pre):
    f32 = jnp.float32
    b_, s_, h_, dh = q.shape
    c = ML_CHUNK
    n = s_ // c

    def chunks(t):
        return t.astype(f32).reshape(b_, n, c, h_, dh).transpose(0, 3, 1, 2, 4)

    q = chunks(q)
    k = chunks(k) * (dh ** -0.5)
    v = chunks(v)
    ig = i_pre.reshape(b_, n, c, h_).transpose(0, 3, 1, 2)
    lf = jax.nn.log_sigmoid(f_pre).reshape(b_, n, c, h_).transpose(0, 3, 1, 2)
    cum = jnp.cumsum(lf, axis=-1)
    tot = cum[..., -1]
    a = tot[..., None] - cum + ig
    a_max = jnp.max(a, -1)
    wa = jnp.exp(a - a_max[..., None])
    chunk_c = jnp.einsum('bhnl,bhnld,bhnle->nbhde', wa, k, v)
    chunk_n = jnp.einsum('bhnl,bhnld->nbhd', wa, k)

    def step(carry, inp):
        cm, nv, m = carry
        cc, cn, g, am = inp
        m_new = jnp.maximum(g + m, am)
        s_old = jnp.exp(g + m - m_new)
        s_new = jnp.exp(am - m_new)
        cm_new = s_old[..., None, None] * cm + s_new[..., None, None] * cc
        nv_new = s_old[..., None] * nv + s_new[..., None] * cn
        return (cm_new, nv_new, m_new), (cm, nv, m)

    init = (jnp.zeros((b_, h_, dh, dh), f32), jnp.zeros((b_, h_, dh), f32), jnp.zeros((b_, h_), f32))
    _, (c_prev, n_prev, m_prev) = lax.scan(step, init, (chunk_c, chunk_n, tot.transpose(2, 0, 1), a_max.transpose(2, 0, 1)))
    m_inter = cum + m_prev.transpose(1, 2, 0)[..., None]
    causal = jnp.tril(jnp.ones((c, c), bool))
    dlog = jnp.where(causal, cum[..., :, None] - cum[..., None, :] + ig[..., None, :], -jnp.inf)
    m_q = jnp.maximum(m_inter, jnp.max(dlog, -1))
    w_qk = jnp.exp(dlog - m_q[..., None]) * jnp.einsum('bhnjd,bhnsd->bhnjs', q, k)
    inter = jnp.exp(m_inter - m_q)
    num = jnp.einsum('bhnjs,bhnse->bhnje', w_qk, v) + inter[..., None] * jnp.einsum('bhnjd,nbhde->bhnje', q, c_prev)
    den = jnp.sum(w_qk, -1) + inter * jnp.einsum('bhnjd,nbhd->bhnj', q, n_prev)
    h = num / jnp.maximum(jnp.abs(den), jnp.exp(-m_q))[..., None]
    return h.transpose(0, 2, 3, 1, 4).reshape(b_, s_, h_, dh)


def _alibi_slopes(n):
    return jnp.exp2(-8.0 * jnp.arange(1, n + 1, dtype=jnp.float32) / n)


def _dilated_group(q, k, v, window, dilation, slopes):
    f32 = jnp.float32
    b_, s_, h_, dk = q.shape
    wb = window // dilation
    l_sub = s_ // dilation
    n_blk = -(-l_sub // wb)
    l_pad = n_blk * wb

    def strided(t):
        t = t.astype(f32).reshape(b_, l_sub, dilation, h_, -1).transpose(0, 2, 1, 3, 4).reshape(b_ * dilation, l_sub, h_, -1)
        t = jnp.pad(t, ((0, 0), (0, l_pad - l_sub), (0, 0), (0, 0)))
        return t.reshape(b_ * dilation, n_blk, wb, h_, -1)

    def unstrided(t):
        return t.reshape(b_, dilation, l_pad, h_, -1)[:, :, :l_sub].transpose(0, 2, 1, 3, 4).reshape(b_, s_, h_, -1)

    def shift(t):
        return jnp.pad(t, ((0, 0), (1, 0), (0, 0), (0, 0), (0, 0)))[:, :-1]

    qs = strided(q) * (dk ** -0.5)
    ks = strided(k)
    vs = strided(v)
    kk = jnp.concatenate([shift(ks), ks], axis=2)
    vv = jnp.concatenate([shift(vs), vs], axis=2)
    scores = jnp.einsum('znihd,znjhd->znhij', qs, kk)
    qi = jnp.arange(wb)[:, None]
    kj = jnp.arange(2 * wb)[None, :]
    delta = qi + wb - kj
    valid = ((delta >= 0) & (delta <= wb))[None] & ((jnp.arange(n_blk)[:, None, None] > 0) | (kj >= wb)[None])
    bias = -slopes[:, None, None] * (dilation * delta).astype(f32)
    scores = jnp.where(valid[:, None], scores + bias, -jnp.inf)
    lse = jax.nn.logsumexp(scores, axis=-1)
    out = jnp.einsum('znhij,znjhe->znihe', jnp.exp(scores - lse[..., None]), vv)
    return unstrided(out), unstrided(jnp.swapaxes(lse, 2, 3)[..., None])


def _dilated_attention(q, k, v):
    slopes = _alibi_slopes(ATT_GROUPS * ATT_HEADS).reshape(ATT_GROUPS, ATT_HEADS)
    outs, lses = [], []
    for g, (window, dilation) in enumerate(ATT_PATTERNS):
        o, l = _dilated_group(q[:, :, g], k[:, :, g], v[:, :, g], window, dilation, slopes[g])
        outs.append(o)
        lses.append(l)
    wts = jax.nn.softmax(jnp.stack(lses), axis=0)
    return jnp.sum(wts * jnp.stack(outs), axis=0)


def _moe(x, w_router, b_router, w_gate, b_gate, w_up, b_up, w_down, b_down):
    b_, s_, d_ = x.shape
    xt = x.reshape(-1, d_)
    t_ = xt.shape[0]
    logits = (xt @ w_router + b_router).astype(jnp.float32)
    top_val, top_idx = lax.top_k(logits, TOP_K)
    probs = jax.nn.softmax(top_val, axis=-1)
    n_assign = t_ * TOP_K
    flat_e = top_idx.reshape(-1)
    order = jnp.argsort(flat_e)
    e_sorted = flat_e[order]
    tok_sorted = (order // TOP_K).astype(jnp.int32)
    p_sorted = probs.reshape(-1)[order]
    counts = jnp.bincount(flat_e, length=N_EXPERTS)
    padded = (counts + MOE_BLOCK - 1) // MOE_BLOCK * MOE_BLOCK
    start = jnp.cumsum(counts) - counts
    pstart = jnp.cumsum(padded) - padded
    n_blocks = -(-n_assign // MOE_BLOCK) + N_EXPERTS
    dest = pstart[e_sorted] + jnp.arange(n_assign) - start[e_sorted]
    row_tok = jnp.zeros((n_blocks * MOE_BLOCK,), jnp.int32).at[dest].set(tok_sorted)
    row_p = jnp.zeros((n_blocks * MOE_BLOCK,), jnp.float32).at[dest].set(p_sorted)
    block_e = jnp.minimum(jnp.searchsorted(jnp.cumsum(padded) // MOE_BLOCK, jnp.arange(n_blocks), side='right'), N_EXPERTS - 1)

    def block(acc, inp):
        e, tok, p = inp
        xb = xt[tok]
        gate = jnp.minimum(xb @ w_gate[e] + b_gate[e], SWIGLU_LIMIT)
        up = jnp.clip(xb @ w_up[e] + b_up[e], -SWIGLU_LIMIT, SWIGLU_LIMIT)
        y = ((up + 1.0) * gate * jax.nn.sigmoid(SWIGLU_ALPHA * gate)) @ w_down[e] + b_down[e]
        return acc.at[tok].add(y * p[:, None].astype(y.dtype)), None

    out, _ = lax.scan(block, jnp.zeros_like(xt), (block_e, row_tok.reshape(n_blocks, MOE_BLOCK), row_p.reshape(n_blocks, MOE_BLOCK)))
    return out.reshape(b_, s_, d_)


def _layer(x, w_in, ret_gn, ml_conv_w, ml_conv_b, ml_wq, ml_wk, ml_wv, ml_bi, ml_bf, ml_gn, ml_skip,
           w_branch, w_out, ln1_g, ln1_b, w_router, b_router, w_gate, b_gate, w_up, b_up, w_down, b_down, ln2_g, ln2_b):
    f32 = jnp.float32
    b_, s_, d_ = x.shape
    (r_q, r_k, r_v, r_g, m_x, m_i, m_f, m_o, a_q, a_k, a_v, gates) = jnp.split(x @ w_in, IN_SPLITS, axis=-1)
    ret = _retention(r_q.reshape(b_, s_, RET_HEADS, RET_DK), r_k.reshape(b_, s_, RET_HEADS, RET_DK),
                     r_v.reshape(b_, s_, RET_HEADS, RET_DV))
    y_ret = _head_norm(ret, ret_gn) * jax.nn.silu(r_g.astype(f32))
    m_c = jax.nn.silu(_causal_conv(m_x, ml_conv_w, ml_conv_b))

    def blockdiag(t, w):
        return jnp.einsum('bsnc,ncd->bsnd', t.reshape(b_, s_, -1, ML_QK_BLOCK), w).reshape(b_, s_, ML_HEADS, ML_DH)

    h_ml = _mlstm(blockdiag(m_c, ml_wq), blockdiag(m_c, ml_wk), blockdiag(m_x, ml_wv),
                  m_i.astype(f32) + ml_bi.astype(f32), m_f.astype(f32) + ml_bf.astype(f32))
    y_ml = jax.nn.sigmoid(m_o.astype(f32)) * (_head_norm(h_ml, ml_gn) + ml_skip.astype(f32) * m_c.astype(f32))
    att = _dilated_attention(a_q.reshape(b_, s_, ATT_GROUPS, ATT_HEADS, ATT_DK),
                             a_k.reshape(b_, s_, ATT_GROUPS, ATT_HEADS, ATT_DK),
                             a_v.reshape(b_, s_, ATT_GROUPS, ATT_HEADS, ATT_DV))
    y_att = att.reshape(b_, s_, MIX_W)
    gate_pre = gates.reshape(b_, s_, N_BRANCHES, d_)
    merged = jax.nn.sigmoid(gate_pre[:, :, 0]) * (y_ret.astype(x.dtype) @ w_branch[0])
    merged = merged + jax.nn.sigmoid(gate_pre[:, :, 1]) * (y_ml.astype(x.dtype) @ w_branch[1])
    merged = merged + jax.nn.sigmoid(gate_pre[:, :, 2]) * (y_att.astype(x.dtype) @ w_branch[2])
    x = _layer_norm(DN_ALPHA * x + merged @ w_out, ln1_g, ln1_b)
    x = _layer_norm(DN_ALPHA * x + _moe(x, w_router, b_router, w_gate, b_gate, w_up, b_up, w_down, b_down), ln2_g, ln2_b)
    return x


def setup_inputs(seed: int = 0) -> dict:
    key = jax.random.key(seed)
    ks = jax.random.split(key, 26)
    f32 = jnp.float32
    L = DEPTH
    nb = MIX_W // ML_QK_BLOCK

    def nrm(k, shape, scale):
        return jax.random.normal(k, shape, f32) * scale

    return {
        'x': nrm(ks[0], (BATCH, SEQ, D_MODEL), 1.0),
        'w_in': nrm(ks[1], (L, D_MODEL, D_IN), D_MODEL ** -0.5),
        'ret_gn': 1.0 + nrm(ks[2], (L, MIX_W), 0.01),
        'ml_conv_w': nrm(ks[3], (L, ML_CONV, MIX_W), ML_CONV ** -0.5),
        'ml_conv_b': nrm(ks[4], (L, MIX_W), 0.01),
        'ml_wq': nrm(ks[5], (L, nb, ML_QK_BLOCK, ML_QK_BLOCK), ML_QK_BLOCK ** -0.5),
        'ml_wk': nrm(ks[6], (L, nb, ML_QK_BLOCK, ML_QK_BLOCK), ML_QK_BLOCK ** -0.5),
        'ml_wv': nrm(ks[7], (L, nb, ML_QK_BLOCK, ML_QK_BLOCK), ML_QK_BLOCK ** -0.5),
        'ml_bi': nrm(ks[8], (L, ML_HEADS), 0.1),
        'ml_bf': jnp.linspace(3.0, 6.0, ML_HEADS, dtype=f32) + nrm(ks[9], (L, ML_HEADS), 0.1),
        'ml_gn': 1.0 + nrm(ks[10], (L, MIX_W), 0.01),
        'ml_skip': 1.0 + nrm(ks[11], (L, MIX_W), 0.1),
        'w_branch': nrm(ks[12], (L, N_BRANCHES, MIX_W, D_MODEL), MIX_W ** -0.5 * DN_BETA),
        'w_out': nrm(ks[13], (L, D_MODEL, D_MODEL), D_MODEL ** -0.5 * DN_BETA),
        'ln1_g': 1.0 + nrm(ks[14], (L, D_MODEL), 0.01),
        'ln1_b': nrm(ks[15], (L, D_MODEL), 0.01),
        'w_router': nrm(ks[16], (L, D_MODEL, N_EXPERTS), D_MODEL ** -0.5),
        'b_router': nrm(ks[17], (L, N_EXPERTS), 0.01),
        'w_gate': nrm(ks[18], (L, N_EXPERTS, D_MODEL, D_FF), D_MODEL ** -0.5),
        'b_gate': nrm(ks[19], (L, N_EXPERTS, D_FF), 0.01),
        'w_up': nrm(ks[20], (L, N_EXPERTS, D_MODEL, D_FF), D_MODEL ** -0.5),
        'b_up': nrm(ks[21], (L, N_EXPERTS, D_FF), 0.01),
        'w_down': nrm(ks[22], (L, N_EXPERTS, D_FF, D_MODEL), D_FF ** -0.5 * DN_BETA),
        'b_down': nrm(ks[23], (L, N_EXPERTS, D_MODEL), 0.01),
        'ln2_g': 1.0 + nrm(ks[24], (L, D_MODEL), 0.01),
        'ln2_b': nrm(ks[25], (L, D_MODEL), 0.01),
    }


def reference(x, w_in, ret_gn, ml_conv_w, ml_conv_b, ml_wq, ml_wk, ml_wv, ml_bi, ml_bf, ml_gn, ml_skip,
              w_branch, w_out, ln1_g, ln1_b, w_router, b_router, w_gate, b_gate, w_up, b_up, w_down, b_down, ln2_g, ln2_b):
    for l in range(DEPTH):
        x = _layer(x, w_in[l], ret_gn[l], ml_conv_w[l], ml_conv_b[l], ml_wq[l], ml_wk[l], ml_wv[l], ml_bi[l], ml_bf[l],
                   ml_gn[l], ml_skip[l], w_branch[l], w_out[l], ln1_g[l], ln1_b[l], w_router[l], b_router[l],
                   w_gate[l], b_gate[l], w_up[l], b_up[l], w_down[l], b_down[l], ln2_g[l], ln2_b[l])
    return x
```

```cpp
#include <hip/hip_runtime.h>
#include <stdint.h>
#include <stdio.h>
#include <string.h>

namespace {
typedef unsigned short bf16_t;
constexpr int D = 1024, BATCH = 2, SEQ = 16384, T = BATCH * SEQ, DEPTH = 2;
constexpr int MIXW = 512, DIN = 8712, NP = 8704;
constexpr int C_RQ = 0, C_RK = 256, C_RV = 512, C_RG = 1024, C_MX = 1536, C_MO = 2048, C_AQ = 2560, C_AK = 3328, C_AV = 4096, C_GT = 5632;
constexpr int NE = 32, TOPK = 4, RMAX = 139264  , MAXTILES = 544;
constexpr float DN_ALPHA = 1.41421356237f, LN_EPS = 1e-5f, SWI_LIMIT = 7.0f, SWI_ALPHA = 1.702f;
constexpr int NTHR = 512;

constexpr size_t MiB = 1u << 20;
constexpr size_t WS_CTL = 0, CTL_BYTES = 1 * MiB;
constexpr size_t WS_P = WS_CTL + CTL_BYTES;
constexpr size_t P_BYTES = (size_t)T * NP * 2;
constexpr size_t WS_H = WS_P, WS_Y = WS_P + (size_t)RMAX * D * 2;
constexpr size_t WS_B = WS_P + P_BYTES;
constexpr size_t B_BYTES = (size_t)NE * 3 * D * D * 2;
constexpr size_t WS_RO = WS_B;
constexpr size_t WS_MO = WS_RO + (size_t)T * MIXW * 4;
constexpr size_t WS_YR = WS_MO + (size_t)T * MIXW * 4;
constexpr size_t WS_YM = WS_YR + (size_t)T * MIXW * 2;
constexpr size_t WS_X = WS_B + B_BYTES;
constexpr size_t WS_XB = WS_X + (size_t)T * D * 4;
constexpr size_t WS_IGF = WS_XB + (size_t)T * D * 2;
constexpr size_t WS_TOPI = WS_IGF + (size_t)T * 8 * 4;
constexpr size_t WS_TOPP = WS_TOPI + (size_t)T * 4 * 4;
constexpr size_t WS_TOKROW = WS_TOPP + (size_t)T * 4 * 4;
constexpr size_t WS_ROWTOK = WS_TOKROW + (size_t)T * 4 * 4;
constexpr size_t WS_ROWP = WS_ROWTOK + (size_t)RMAX * 4;
constexpr size_t WS_END = WS_ROWP + (size_t)RMAX * 4;
constexpr size_t DO_MG = 0;
constexpr size_t DO_MQ = 0, DO_MK = (size_t)T * MIXW * 2, DO_MV = 2 * (size_t)T * MIXW * 2;
constexpr size_t DO_YA = 3 * (size_t)T * MIXW * 2;
constexpr int CW_CHCNT = 1024;
constexpr int CW_PSTART = 16384;
constexpr int CW_NTILES = 16500;
constexpr int CW_TILEE = 16640;

struct Params {
    const float* in[26];
    float* out;
    char* ws;
};

__device__ __forceinline__ float bf2f(bf16_t b) { return __uint_as_float(((unsigned)b) << 16); }
__device__ __forceinline__ bf16_t f2bf(float f) { unsigned u = __float_as_uint(f); u += 0x7FFFu + ((u >> 16) & 1u); return (bf16_t)(u >> 16); }
__device__ __forceinline__ float sigmoidf_(float x) { return 1.0f / (1.0f + __expf(-x)); }
__device__ __forceinline__ float wsum(float v) {
#pragma unroll
    for (int o = 32; o > 0; o >>= 1) v += __shfl_xor(v, o);
    return v; }
__device__ __forceinline__ float wmax(float v) {
#pragma unroll
    for (int o = 32; o > 0; o >>= 1) v = fmaxf(v, __shfl_xor(v, o));
    return v; }

template <bool DUAL, class AL, class BL, class EP>
__device__ __forceinline__ void g32_tile(float* As, float* Bs, int K, AL aload, BL bload, EP epi) {
    const int tid = threadIdx.x, tx = tid & 31, ty = tid >> 5;
    float4 acc[8], acc2[8];
#pragma unroll
    for (int i = 0; i < 8; ++i) { acc[i] = make_float4(0.f, 0.f, 0.f, 0.f); acc2[i] = acc[i]; }
    for (int k0 = 0; k0 < K; k0 += 16) {
        { const int r = tid >> 2, kq = (tid & 3) * 4; const float4 a = aload(r, k0 + kq);
          As[(kq + 0) * 132 + r] = a.x; As[(kq + 1) * 132 + r] = a.y; As[(kq + 2) * 132 + r] = a.z; As[(kq + 3) * 132 + r] = a.w; }
        { const int k = tid >> 5, c4 = (tid & 31) * 4; *(float4*)&Bs[k * 132 + c4] = bload(0, k0 + k, c4);
          if (DUAL) *(float4*)&Bs[16 * 132 + k * 132 + c4] = bload(1, k0 + k, c4); }
        __syncthreads();
#pragma unroll
        for (int k = 0; k < 16; ++k) {
            const float4 a0 = *(const float4*)&As[k * 132 + ty * 8], a1 = *(const float4*)&As[k * 132 + ty * 8 + 4];
            const float av[8] = {a0.x, a0.y, a0.z, a0.w, a1.x, a1.y, a1.z, a1.w};
            const float4 b = *(const float4*)&Bs[k * 132 + tx * 4];
#pragma unroll
            for (int i = 0; i < 8; ++i) { acc[i].x += av[i] * b.x; acc[i].y += av[i] * b.y; acc[i].z += av[i] * b.z; acc[i].w += av[i] * b.w; }
            if (DUAL) { const float4 b2 = *(const float4*)&Bs[16 * 132 + k * 132 + tx * 4];
#pragma unroll
                for (int i = 0; i < 8; ++i) { acc2[i].x += av[i] * b2.x; acc2[i].y += av[i] * b2.y; acc2[i].z += av[i] * b2.z; acc2[i].w += av[i] * b2.w; } }
        }
        __syncthreads();
    }
#pragma unroll
    for (int i = 0; i < 8; ++i) epi(i, ty * 8 + i, tx * 4, acc[i], acc2[i]);
}
__device__ __forceinline__ float4 ld_bf4(const bf16_t* p) { const uint2 u = *(const uint2*)p; return make_float4(__uint_as_float(u.x << 16), __uint_as_float(u.x & 0xffff0000u), __uint_as_float(u.y << 16), __uint_as_float(u.y & 0xffff0000u)); }
__device__ __forceinline__ void st_bf4(bf16_t* p, float4 v) { uint2 u; u.x = (unsigned)f2bf(v.x) | ((unsigned)f2bf(v.y) << 16); u.y = (unsigned)f2bf(v.z) | ((unsigned)f2bf(v.w) << 16); *(uint2*)p = u; }

__device__ void ph_inproj(const Params& p, int l, float* lds) {
    float* As = lds; float* Bs = lds + 16 * 132;
    const float* X = l == 0 ? p.in[0] : (const float*)(p.ws + WS_X);
    const float* W = p.in[1] + (size_t)l * D * DIN;
    bf16_t* P = (bf16_t*)(p.ws + WS_P); float* IGF = (float*)(p.ws + WS_IGF);
    const int nN = (DIN + 127) / 128, nM = T / 128;
    for (int u = blockIdx.x; u < nM * nN; u += gridDim.x) {
        const int pm = u / nN, pn = u % nN;
        g32_tile<false>(As, Bs, D,
            [&](int r, int k) { return *(const float4*)(X + (size_t)(pm * 128 + r) * D + k); },
            [&](int, int k, int c) { const int col = pn * 128 + c; return col < DIN ? *(const float4*)(W + (size_t)k * DIN + col) : make_float4(0.f, 0.f, 0.f, 0.f); },
            [&](int, int r, int c, float4 v, float4) { const int row = pm * 128 + r, col = pn * 128 + c;
                if (col >= DIN) return;
                if (col < 2048) st_bf4(P + (size_t)row * NP + col, v);
                else if (col < 2056) *(float4*)(IGF + (size_t)row * 8 + (col - 2048)) = v;
                else st_bf4(P + (size_t)row * NP + col - 8, v); });
    }
}

__device__ void ph_ret_rec(const Params& p, int l) {
    const bf16_t* P = (const bf16_t*)(p.ws + WS_P); float* RO = (float*)(p.ws + WS_RO);
    for (int u = blockIdx.x; u < BATCH * 4; u += gridDim.x) {
        const int b = u >> 2, h = u & 3, e = threadIdx.x;
        if (e >= 128) continue;
        const float gamma = 1.0f - exp2f(-5.0f - (float)h);
        float S[64];
#pragma unroll
        for (int d = 0; d < 64; ++d) S[d] = 0.f;
        for (int t = 0; t < SEQ; ++t) {
            const bf16_t* row = P + (size_t)(b * SEQ + t) * NP;
            const float v = bf2f(row[C_RV + h * 128 + e]);
            float o = 0.f;
#pragma unroll
            for (int d4 = 0; d4 < 16; ++d4) {
                const float4 q = ld_bf4(row + C_RQ + h * 64 + d4 * 4), k = ld_bf4(row + C_RK + h * 64 + d4 * 4);
                S[d4 * 4 + 0] = gamma * S[d4 * 4 + 0] + k.x * 0.125f * v; o += q.x * S[d4 * 4 + 0];
                S[d4 * 4 + 1] = gamma * S[d4 * 4 + 1] + k.y * 0.125f * v; o += q.y * S[d4 * 4 + 1];
                S[d4 * 4 + 2] = gamma * S[d4 * 4 + 2] + k.z * 0.125f * v; o += q.z * S[d4 * 4 + 2];
                S[d4 * 4 + 3] = gamma * S[d4 * 4 + 3] + k.w * 0.125f * v; o += q.w * S[d4 * 4 + 3];
            }
            RO[(size_t)(b * SEQ + t) * MIXW + h * 128 + e] = o;
        }
    }
}

__device__ __forceinline__ float ml_conv(const Params& p, int l, const bf16_t* P, int tok, int c) {
    const float* cw = p.in[3] + (size_t)l * 4 * MIXW; const float* cb = p.in[4] + (size_t)l * MIXW;
    const int t = tok % SEQ; float a = cb[c];
#pragma unroll
    for (int i = 0; i < 4; ++i) { const int tt = t - 3 + i; if (tt >= 0) a += cw[i * MIXW + c] * bf2f(P[(size_t)(tok - 3 + i) * NP + C_MX + c]); }
    return a * sigmoidf_(a);
}
__device__ void ph_ml_pre(const Params& p, int l) {
    const bf16_t* P = (const bf16_t*)(p.ws + WS_P);
    bf16_t* MQ = (bf16_t*)((char*)p.out + DO_MQ); bf16_t* MK = (bf16_t*)((char*)p.out + DO_MK); bf16_t* MV = (bf16_t*)((char*)p.out + DO_MV);
    const float* wq = p.in[5] + (size_t)l * 128 * 16; const float* wk = p.in[6] + (size_t)l * 128 * 16; const float* wv = p.in[7] + (size_t)l * 128 * 16;
    for (size_t i = (size_t)blockIdx.x * NTHR + threadIdx.x; i < (size_t)T * 128; i += (size_t)gridDim.x * NTHR) {
        const int tok = (int)(i >> 7), n = (int)(i & 127);
        float mc[4], mx[4];
#pragma unroll
        for (int c = 0; c < 4; ++c) { mc[c] = ml_conv(p, l, P, tok, n * 4 + c); mx[c] = bf2f(P[(size_t)tok * NP + C_MX + n * 4 + c]); }
        float q[4] = {0, 0, 0, 0}, k[4] = {0, 0, 0, 0}, v[4] = {0, 0, 0, 0};
#pragma unroll
        for (int c = 0; c < 4; ++c)
#pragma unroll
            for (int d = 0; d < 4; ++d) { q[d] += mc[c] * wq[n * 16 + c * 4 + d]; k[d] += mc[c] * wk[n * 16 + c * 4 + d]; v[d] += mx[c] * wv[n * 16 + c * 4 + d]; }
        st_bf4(MQ + (size_t)tok * MIXW + n * 4, make_float4(q[0], q[1], q[2], q[3]));
        st_bf4(MK + (size_t)tok * MIXW + n * 4, make_float4(k[0], k[1], k[2], k[3]));
        st_bf4(MV + (size_t)tok * MIXW + n * 4, make_float4(v[0], v[1], v[2], v[3]));
    }
}
__device__ void ph_ml_rec(const Params& p, int l) {
    const bf16_t* MQ = (const bf16_t*)((char*)p.out + DO_MQ); const bf16_t* MK = (const bf16_t*)((char*)p.out + DO_MK); const bf16_t* MV = (const bf16_t*)((char*)p.out + DO_MV);
    const float* IGF = (const float*)(p.ws + WS_IGF); float* MO = (float*)(p.ws + WS_MO);
    const float* bi = p.in[8] + l * 4; const float* bfg = p.in[9] + l * 4;
    for (int u = blockIdx.x; u < BATCH * 4; u += gridDim.x) {
        const int b = u >> 2, h = u & 3, e = threadIdx.x >> 2, dq = threadIdx.x & 3;
        float C[32], n[32];
#pragma unroll
        for (int d = 0; d < 32; ++d) { C[d] = 0.f; n[d] = 0.f; }
        for (int t = 0; t < SEQ; ++t) {
            const size_t tok = (size_t)b * SEQ + t;
            const float ip = IGF[tok * 8 + h] + bi[h], fp = IGF[tok * 8 + 4 + h] + bfg[h];
            const float ig = __expf(ip), fg = sigmoidf_(fp);
            const float v = bf2f(MV[tok * MIXW + h * 128 + e]);
            float num = 0.f, den = 0.f;
#pragma unroll
            for (int d4 = 0; d4 < 8; ++d4) {
                const float4 q = ld_bf4(MQ + tok * MIXW + h * 128 + dq * 32 + d4 * 4), k4 = ld_bf4(MK + tok * MIXW + h * 128 + dq * 32 + d4 * 4);
                const float qq[4] = {q.x, q.y, q.z, q.w}, kk[4] = {k4.x, k4.y, k4.z, k4.w};
#pragma unroll
                for (int j = 0; j < 4; ++j) { const float ks = kk[j] * 0.08838834764831845f * ig;
                    C[d4 * 4 + j] = fg * C[d4 * 4 + j] + ks * v; n[d4 * 4 + j] = fg * n[d4 * 4 + j] + ks;
                    num += qq[j] * C[d4 * 4 + j]; den += qq[j] * n[d4 * 4 + j]; }
            }
            num += __shfl_xor(num, 1); num += __shfl_xor(num, 2); den += __shfl_xor(den, 1); den += __shfl_xor(den, 2);
            if (dq == 0) MO[tok * MIXW + h * 128 + e] = num / fmaxf(fabsf(den), 1.0f);
        }
    }
}

__device__ void ph_att_naive(const Params& p, int l) {
    const bf16_t* P = (const bf16_t*)(p.ws + WS_P); bf16_t* YA = (bf16_t*)((char*)p.out + DO_YA);
    const int lane = threadIdx.x & 63, wv = threadIdx.x >> 6;
    for (int u = blockIdx.x * 8 + wv; u < T * 4; u += gridDim.x * 8) {
        const int tok = u >> 2, h = u & 3, t = tok % SEQ;
        float m = -INFINITY, lsum = 0.f, a0 = 0.f, a1 = 0.f;
        for (int g = 0; g < 3; ++g) {
            const int dil = g == 0 ? 1 : (g == 1 ? 4 : 16);
            const float slope = exp2f(-8.0f * (float)(g * 4 + h + 1) / 12.0f);
            const bf16_t* qp = P + (size_t)tok * NP + C_AQ + g * 256 + h * 64;
            for (int jb = 0; jb < 3; ++jb) {
                const int j = jb * 64 + lane; const bool valid = (j <= 128) && (t - j * dil >= 0);
                float s = -INFINITY;
                if (valid) { const bf16_t* kp = P + (size_t)(tok - j * dil) * NP + C_AK + g * 256 + h * 64; float acc = 0.f;
#pragma unroll
                    for (int d4 = 0; d4 < 16; ++d4) { const float4 q = ld_bf4(qp + d4 * 4), k = ld_bf4(kp + d4 * 4); acc += q.x * k.x + q.y * k.y + q.z * k.z + q.w * k.w; }
                    s = acc * 0.125f - slope * (float)(dil * j); }
                const float mt = wmax(s);
                if (mt == -INFINITY) continue;
                const float mn = fmaxf(m, mt), sc = __expf(m - mn), pj = valid ? __expf(s - mn) : 0.f;
                lsum = lsum * sc + wsum(pj); a0 *= sc; a1 *= sc; m = mn;
                for (int jj = 0; jj < 64; ++jj) { const float pp = __shfl(pj, jj); if (pp != 0.f) { const int jq = jb * 64 + jj;
                        const bf16_t* vp = P + (size_t)(tok - jq * dil) * NP + C_AV + g * 512 + h * 128; a0 += pp * bf2f(vp[lane]); a1 += pp * bf2f(vp[64 + lane]); } }
            }
        }
        const float inv = 1.0f / lsum;
        YA[(size_t)tok * MIXW + h * 128 + lane] = f2bf(a0 * inv); YA[(size_t)tok * MIXW + h * 128 + 64 + lane] = f2bf(a1 * inv);
    }
}

__device__ void ph_norm(const Params& p, int l) {
    const bf16_t* P = (const bf16_t*)(p.ws + WS_P); const float* RO = (const float*)(p.ws + WS_RO); const float* MO = (const float*)(p.ws + WS_MO);
    bf16_t* YR = (bf16_t*)(p.ws + WS_YR); bf16_t* YM = (bf16_t*)(p.ws + WS_YM);
    const float* rgn = p.in[2] + l * MIXW; const float* mgn = p.in[10] + l * MIXW; const float* msk = p.in[11] + l * MIXW;
    const int lane = threadIdx.x & 63, wv = threadIdx.x >> 6;
    for (int u = blockIdx.x * 8 + wv; u < T * 8; u += gridDim.x * 8) {
        const int tok = u >> 3, mix = (u >> 2) & 1, h = u & 3;
        const float* src = (mix ? MO : RO) + (size_t)tok * MIXW + h * 128;
        const float v0 = src[lane], v1 = src[64 + lane];
        const float mu = wsum(v0 + v1) * (1.0f / 128.0f), d0 = v0 - mu, d1 = v1 - mu;
        const float rstd = rsqrtf(wsum(d0 * d0 + d1 * d1) * (1.0f / 128.0f) + LN_EPS);
#pragma unroll
        for (int s = 0; s < 2; ++s) { const int c = h * 128 + s * 64 + lane; const float y = (s ? d1 : d0) * rstd;
            if (mix == 0) { const float g = bf2f(P[(size_t)tok * NP + C_RG + c]); YR[(size_t)tok * MIXW + c] = f2bf(y * rgn[c] * (g * sigmoidf_(g))); }
            else { const float o = bf2f(P[(size_t)tok * NP + C_MO + c]); YM[(size_t)tok * MIXW + c] = f2bf(sigmoidf_(o) * (y * mgn[c] + msk[c] * ml_conv(p, l, P, tok, c))); } }
    }
}

__device__ void ph_merge(const Params& p, int l, float* lds) {
    float* As = lds; float* Bs = lds + 16 * 132;
    const bf16_t* P = (const bf16_t*)(p.ws + WS_P); bf16_t* MG = (bf16_t*)((char*)p.out + DO_MG);
    const bf16_t* Y0 = (const bf16_t*)(p.ws + WS_YR); const bf16_t* Y1 = (const bf16_t*)(p.ws + WS_YM); const bf16_t* Y2 = (const bf16_t*)((char*)p.out + DO_YA);
    const float* WB = p.in[12] + (size_t)l * 3 * MIXW * D;
    for (int u = blockIdx.x; u < (T / 128) * (D / 128); u += gridDim.x) {
        const int pm = u >> 3, pn = u & 7;
        float4 tot[8];
#pragma unroll
        for (int i = 0; i < 8; ++i) tot[i] = make_float4(0.f, 0.f, 0.f, 0.f);
#pragma unroll 1
        for (int br = 0; br < 3; ++br) {
            const bf16_t* Y = br == 0 ? Y0 : (br == 1 ? Y1 : Y2); const float* W = WB + (size_t)br * MIXW * D;
            g32_tile<false>(As, Bs, MIXW,
                [&](int r, int k) { return ld_bf4(Y + (size_t)(pm * 128 + r) * MIXW + k); },
                [&](int, int k, int c) { return *(const float4*)(W + (size_t)k * D + pn * 128 + c); },
                [&](int i, int r, int c, float4 v, float4) { const float4 g = ld_bf4(P + (size_t)(pm * 128 + r) * NP + C_GT + br * D + pn * 128 + c);
                    tot[i].x += sigmoidf_(g.x) * v.x; tot[i].y += sigmoidf_(g.y) * v.y; tot[i].z += sigmoidf_(g.z) * v.z; tot[i].w += sigmoidf_(g.w) * v.w; });
        }
        const int tx = threadIdx.x & 31, ty = threadIdx.x >> 5;
#pragma unroll
        for (int i = 0; i < 8; ++i) st_bf4(MG + (size_t)(pm * 128 + ty * 8 + i) * D + pn * 128 + tx * 4, tot[i]);
    }
}
__device__ void ph_outproj(const Params& p, int l, float* lds) {
    float* As = lds; float* Bs = lds + 16 * 132;
    const bf16_t* MG = (const bf16_t*)((char*)p.out + DO_MG); const float* W = p.in[13] + (size_t)l * D * D;
    const float* XR = l == 0 ? p.in[0] : (const float*)(p.ws + WS_X); float* X = (float*)(p.ws + WS_X);
    for (int u = blockIdx.x; u < (T / 128) * (D / 128); u += gridDim.x) {
        const int pm = u >> 3, pn = u & 7;
        g32_tile<false>(As, Bs, D,
            [&](int r, int k) { return ld_bf4(MG + (size_t)(pm * 128 + r) * D + k); },
            [&](int, int k, int c) { return *(const float4*)(W + (size_t)k * D + pn * 128 + c); },
            [&](int, int r, int c, float4 v, float4) { const size_t o = (size_t)(pm * 128 + r) * D + pn * 128 + c; const float4 x = *(const float4*)(XR + o);
                *(float4*)(X + o) = make_float4(DN_ALPHA * x.x + v.x, DN_ALPHA * x.y + v.y, DN_ALPHA * x.z + v.z, DN_ALPHA * x.w + v.w); });
    }
}

__device__ __forceinline__ void ln_row(float4 (&v)[4], const float* g, const float* b, int lane) {
    float s = 0.f;
#pragma unroll
    for (int i = 0; i < 4; ++i) s += (v[i].x + v[i].y) + (v[i].z + v[i].w);
    const float mu = wsum(s) * (1.0f / D); float q = 0.f;
#pragma unroll
    for (int i = 0; i < 4; ++i) { v[i].x -= mu; v[i].y -= mu; v[i].z -= mu; v[i].w -= mu; q += (v[i].x * v[i].x + v[i].y * v[i].y) + (v[i].z * v[i].z + v[i].w * v[i].w); }
    const float rstd = rsqrtf(wsum(q) * (1.0f / D) + LN_EPS);
#pragma unroll
    for (int i = 0; i < 4; ++i) { const float4 gg = *(const float4*)(g + i * 256 + lane * 4), bb = *(const float4*)(b + i * 256 + lane * 4);
        v[i].x = v[i].x * rstd * gg.x + bb.x; v[i].y = v[i].y * rstd * gg.y + bb.y; v[i].z = v[i].z * rstd * gg.z + bb.z; v[i].w = v[i].w * rstd * gg.w + bb.w; }
}

__device__ void ph_ln1_router(const Params& p, int l, float* lds) {
    float* X = (float*)(p.ws + WS_X); bf16_t* XB = (bf16_t*)(p.ws + WS_XB);
    const float* g1 = p.in[14] + l * D; const float* b1 = p.in[15] + l * D;
    const float* wr = p.in[16] + (size_t)l * D * NE; const float* br = p.in[17] + l * NE;
    int* topi = (int*)(p.ws + WS_TOPI); float* topp = (float*)(p.ws + WS_TOPP);
    unsigned* ctl = (unsigned*)(p.ws + WS_CTL);
    const int lane = threadIdx.x & 63, wv = threadIdx.x >> 6;
    float* yrow = lds + wv * D;
    unsigned* cnt = (unsigned*)(lds + 8 * D);
    for (int ch = blockIdx.x; ch < T / 128; ch += gridDim.x) {
        if (threadIdx.x < NE) cnt[threadIdx.x] = 0u;
        __syncthreads();
        for (int it = 0; it < 16; ++it) {
            const int tok = ch * 128 + wv * 16 + it;
            float4 v[4];
#pragma unroll
            for (int i = 0; i < 4; ++i) v[i] = *(const float4*)(X + (size_t)tok * D + i * 256 + lane * 4);
            ln_row(v, g1, b1, lane);
#pragma unroll
            for (int i = 0; i < 4; ++i) { *(float4*)(X + (size_t)tok * D + i * 256 + lane * 4) = v[i]; st_bf4(XB + (size_t)tok * D + i * 256 + lane * 4, v[i]); *(float4*)(yrow + i * 256 + lane * 4) = v[i]; }
            const int e = lane & 31, hf = lane >> 5; float acc = 0.f;
            for (int c = 0; c < 512; c += 4) { const float4 y = *(const float4*)(yrow + hf * 512 + c); const float* w = wr + (size_t)(hf * 512 + c) * NE + e;
                acc += y.x * w[0]; acc += y.y * w[NE]; acc += y.z * w[2 * NE]; acc += y.w * w[3 * NE]; }
            acc += __shfl_xor(acc, 32); acc += br[e];
            float val = lane < 32 ? acc : -INFINITY; float tv[4]; int ti[4];
#pragma unroll
            for (int r = 0; r < 4; ++r) { const float mx = wmax(val); const unsigned long long bal = __ballot(val == mx); const int idx = __ffsll((long long)bal) - 1; tv[r] = mx; ti[r] = idx; if (lane == idx) val = -INFINITY; }
            const float e1 = __expf(tv[1] - tv[0]), e2 = __expf(tv[2] - tv[0]), e3 = __expf(tv[3] - tv[0]), inv = 1.0f / (1.0f + e1 + e2 + e3);
            if (lane == 0) { *(int4*)(topi + (size_t)tok * 4) = make_int4(ti[0], ti[1], ti[2], ti[3]); *(float4*)(topp + (size_t)tok * 4) = make_float4(inv, e1 * inv, e2 * inv, e3 * inv); }
            { const int myti = lane == 0 ? ti[0] : (lane == 1 ? ti[1] : (lane == 2 ? ti[2] : ti[3])); if (lane < 4) atomicAdd(&cnt[myti], 1u); }
        }
        __syncthreads();
        if (threadIdx.x < NE) ctl[CW_CHCNT + ch * NE + threadIdx.x] = cnt[threadIdx.x];
        __syncthreads();
    }
}
__device__ void ph_assign(const Params& p, int l, float* lds) {
    unsigned* ctl = (unsigned*)(p.ws + WS_CTL);
    const int* topi = (const int*)(p.ws + WS_TOPI); const float* topp = (const float*)(p.ws + WS_TOPP);
    int* tokrow = (int*)(p.ws + WS_TOKROW); int* rowtok = (int*)(p.ws + WS_ROWTOK); float* rowp = (float*)(p.ws + WS_ROWP);
    unsigned* base = (unsigned*)lds;
    unsigned* tot = base + 32;
    unsigned* pst = base + 64;
    for (int ch = blockIdx.x; ch < T / 128; ch += gridDim.x) {
        if (threadIdx.x < NE) { unsigned before = 0, all = 0; for (int c = 0; c < T / 128; ++c) { const unsigned v = ctl[CW_CHCNT + c * NE + threadIdx.x]; all += v; if (c < ch) before += v; } base[threadIdx.x] = before; tot[threadIdx.x] = all; }
        __syncthreads();
        if (threadIdx.x == 0) { unsigned s = 0; for (int e = 0; e < NE; ++e) { pst[e] = s; s += (tot[e] + 255u) / 256u * 256u; } pst[NE] = s; }
        __syncthreads();
        if (threadIdx.x < NE) base[threadIdx.x] += pst[threadIdx.x];
        __syncthreads();
        { const int tok = ch * 128 + (threadIdx.x >> 2), k = threadIdx.x & 3; const int e = topi[(size_t)tok * 4 + k];
          const unsigned row = atomicAdd(&base[e], 1u); tokrow[(size_t)tok * 4 + k] = (int)row; rowtok[row] = tok; rowp[row] = topp[(size_t)tok * 4 + k]; }
        if (ch == 0) {
            for (int e = 0; e < NE; ++e) { const unsigned s = pst[e] + tot[e], en = pst[e + 1]; for (unsigned r = s + threadIdx.x; r < en; r += NTHR) { rowtok[r] = 0; rowp[r] = 0.f; } }
            if (threadIdx.x < NE) { ctl[CW_PSTART + threadIdx.x] = pst[threadIdx.x]; for (unsigned tl = pst[threadIdx.x] / 256u; tl < pst[threadIdx.x + 1] / 256u; ++tl) ctl[CW_TILEE + tl] = threadIdx.x; }
            if (threadIdx.x == 0) ctl[CW_NTILES] = pst[NE] / 256u;
        }
        __syncthreads();
    }
}
__device__ void ph_moe1(const Params& p, int l, float* lds) {
    float* As = lds; float* Bs = lds + 16 * 132;
    const unsigned* ctl = (const unsigned*)(p.ws + WS_CTL); const int* rowtok = (const int*)(p.ws + WS_ROWTOK);
    const bf16_t* XB = (const bf16_t*)(p.ws + WS_XB); bf16_t* H = (bf16_t*)(p.ws + WS_H);
    const int nt = (int)ctl[CW_NTILES] * 2;
    for (int u = blockIdx.x; u < nt * 8; u += gridDim.x) {
        const int rt = u >> 3, pn = u & 7, e = (int)ctl[CW_TILEE + (rt >> 1)];
        const float* Wg = p.in[18] + ((size_t)l * NE + e) * D * D; const float* Wu = p.in[20] + ((size_t)l * NE + e) * D * D;
        const float* bg = p.in[19] + ((size_t)l * NE + e) * D; const float* bu = p.in[21] + ((size_t)l * NE + e) * D;
        g32_tile<true>(As, Bs, D,
            [&](int r, int k) { return ld_bf4(XB + (size_t)rowtok[rt * 128 + r] * D + k); },
            [&](int w, int k, int c) { return *(const float4*)((w ? Wu : Wg) + (size_t)k * D + pn * 128 + c); },
            [&](int, int r, int c, float4 gv, float4 uv) { const int col = pn * 128 + c; const float4 bgv = *(const float4*)(bg + col), buv = *(const float4*)(bu + col);
                const float g4[4] = {gv.x + bgv.x, gv.y + bgv.y, gv.z + bgv.z, gv.w + bgv.w}, u4[4] = {uv.x + buv.x, uv.y + buv.y, uv.z + buv.z, uv.w + buv.w}; float hh[4];
#pragma unroll
                for (int j = 0; j < 4; ++j) { const float g = fminf(g4[j], SWI_LIMIT), uu = fminf(fmaxf(u4[j], -SWI_LIMIT), SWI_LIMIT); hh[j] = (uu + 1.0f) * g * sigmoidf_(SWI_ALPHA * g); }
                st_bf4(H + (size_t)(rt * 128 + r) * D + col, make_float4(hh[0], hh[1], hh[2], hh[3])); });
    }
}
__device__ void ph_moe2(const Params& p, int l, float* lds) {
    float* As = lds; float* Bs = lds + 16 * 132;
    const unsigned* ctl = (const unsigned*)(p.ws + WS_CTL); const float* rowp = (const float*)(p.ws + WS_ROWP);
    const bf16_t* H = (const bf16_t*)(p.ws + WS_H); bf16_t* Y = (bf16_t*)(p.ws + WS_Y);
    const int nt = (int)ctl[CW_NTILES] * 2;
    for (int u = blockIdx.x; u < nt * 8; u += gridDim.x) {
        const int rt = u >> 3, pn = u & 7, e = (int)ctl[CW_TILEE + (rt >> 1)];
        const float* Wd = p.in[22] + ((size_t)l * NE + e) * D * D; const float* bd = p.in[23] + ((size_t)l * NE + e) * D;
        g32_tile<false>(As, Bs, D,
            [&](int r, int k) { return ld_bf4(H + (size_t)(rt * 128 + r) * D + k); },
            [&](int, int k, int c) { return *(const float4*)(Wd + (size_t)k * D + pn * 128 + c); },
            [&](int, int r, int c, float4 v, float4) { const int col = pn * 128 + c; const float4 b = *(const float4*)(bd + col); const float pr = rowp[rt * 128 + r];
                st_bf4(Y + (size_t)(rt * 128 + r) * D + col, make_float4((v.x + b.x) * pr, (v.y + b.y) * pr, (v.z + b.z) * pr, (v.w + b.w) * pr)); });
    }
}
__device__ void ph_ln2(const Params& p, int l) {
    float* X = (float*)(p.ws + WS_X); bf16_t* XB = (bf16_t*)(p.ws + WS_XB); const bf16_t* Y = (const bf16_t*)(p.ws + WS_Y);
    const int* tokrow = (const int*)(p.ws + WS_TOKROW);
    const float* g2 = p.in[24] + l * D; const float* b2 = p.in[25] + l * D;
    float* dst = l == DEPTH - 1 ? p.out : X;
    const int lane = threadIdx.x & 63, wv = threadIdx.x >> 6;
    for (int tok = blockIdx.x * 8 + wv; tok < T; tok += gridDim.x * 8) {
        const int4 rows = *(const int4*)(tokrow + (size_t)tok * 4); const int rr[4] = {rows.x, rows.y, rows.z, rows.w};
        float4 v[4];
#pragma unroll
        for (int i = 0; i < 4; ++i) { const float4 x = *(const float4*)(X + (size_t)tok * D + i * 256 + lane * 4); v[i] = make_float4(DN_ALPHA * x.x, DN_ALPHA * x.y, DN_ALPHA * x.z, DN_ALPHA * x.w);
#pragma unroll
            for (int k = 0; k < 4; ++k) { const float4 y = ld_bf4(Y + (size_t)rr[k] * D + i * 256 + lane * 4); v[i].x += y.x; v[i].y += y.y; v[i].z += y.z; v[i].w += y.w; } }
        ln_row(v, g2, b2, lane);
#pragma unroll
        for (int i = 0; i < 4; ++i) { *(float4*)(dst + (size_t)tok * D + i * 256 + lane * 4) = v[i]; if (l != DEPTH - 1) st_bf4(XB + (size_t)tok * D + i * 256 + lane * 4, v[i]); }
    }
}

enum { PH_IN, PH_RETREC, PH_MLPRE, PH_MLREC, PH_ATT, PH_NORM, PH_MERGE, PH_OUT, PH_LN1, PH_ASSIGN, PH_MOE1, PH_MOE2, PH_LN2 };
template <int PH> __global__ void __launch_bounds__(NTHR) k_phase(Params p, int l) {
    extern __shared__ __attribute__((aligned(16))) float lds[];
    if (PH == PH_IN) ph_inproj(p, l, lds);
    if (PH == PH_RETREC) ph_ret_rec(p, l);
    if (PH == PH_MLPRE) ph_ml_pre(p, l);
    if (PH == PH_MLREC) ph_ml_rec(p, l);
    if (PH == PH_ATT) ph_att_naive(p, l);
    if (PH == PH_NORM) ph_norm(p, l);
    if (PH == PH_MERGE) ph_merge(p, l, lds);
    if (PH == PH_OUT) ph_outproj(p, l, lds);
    if (PH == PH_LN1) ph_ln1_router(p, l, lds);
    if (PH == PH_ASSIGN) ph_assign(p, l, lds);
    if (PH == PH_MOE1) ph_moe1(p, l, lds);
    if (PH == PH_MOE2) ph_moe2(p, l, lds);
    if (PH == PH_LN2) ph_ln2(p, l);
}
}

extern "C" void kernel_launch(void* const* d_in, const int* in_sizes, int n_in, void* d_out, int out_size, void* d_ws, size_t ws_size, hipStream_t stream) {
    if (n_in != 26 || out_size != T * D || ws_size < WS_END) { fprintf(stderr, "kernel_launch: unexpected shapes (n_in %d out %d ws %zu need %zu)\n", n_in, out_size, ws_size, (size_t)WS_END); return; }
    Params p; memset(&p, 0, sizeof(p));
    for (int i = 0; i < 26; ++i) p.in[i] = (const float*)d_in[i];
    p.out = (float*)d_out; p.ws = (char*)d_ws;
    (void)hipMemsetAsync((char*)d_ws + WS_CTL, 0, CTL_BYTES, stream);
    const int G = 1024; const size_t L = 48 * 1024;
    for (int l = 0; l < DEPTH; ++l) {
        hipLaunchKernelGGL(k_phase<PH_IN>, dim3(G), dim3(NTHR), L, stream, p, l);
        hipLaunchKernelGGL(k_phase<PH_RETREC>, dim3(8), dim3(NTHR), L, stream, p, l);
        hipLaunchKernelGGL(k_phase<PH_MLPRE>, dim3(G), dim3(NTHR), L, stream, p, l);
        hipLaunchKernelGGL(k_phase<PH_MLREC>, dim3(8), dim3(NTHR), L, stream, p, l);
        hipLaunchKernelGGL(k_phase<PH_ATT>, dim3(G), dim3(NTHR), L, stream, p, l);
        hipLaunchKernelGGL(k_phase<PH_NORM>, dim3(G), dim3(NTHR), L, stream, p, l);
        hipLaunchKernelGGL(k_phase<PH_MERGE>, dim3(G), dim3(NTHR), L, stream, p, l);
        hipLaunchKernelGGL(k_phase<PH_OUT>, dim3(G), dim3(NTHR), L, stream, p, l);
        hipLaunchKernelGGL(k_phase<PH_LN1>, dim3(256), dim3(NTHR), L, stream, p, l);
        hipLaunchKernelGGL(k_phase<PH_ASSIGN>, dim3(256), dim3(NTHR), L, stream, p, l);
        hipLaunchKernelGGL(k_phase<PH_MOE1>, dim3(G), dim3(NTHR), L, stream, p, l);
        hipLaunchKernelGGL(k_phase<PH_MOE2>, dim3(G), dim3(NTHR), L, stream, p, l);
        hipLaunchKernelGGL(k_phase<PH_LN2>, dim3(G), dim3(NTHR), L, stream, p, l);
    }
}
```

```cpp
#include <hip/hip_runtime.h>
#include <type_traits>
#include <stdint.h>
#include <stdio.h>
#include <string.h>

namespace {
typedef unsigned short bf16_t;
typedef short bf16x8_t __attribute__((ext_vector_type(8)));
typedef short s16x4_t __attribute__((ext_vector_type(4)));
typedef float f32x4_t __attribute__((ext_vector_type(4)));
typedef float f32x2_t __attribute__((ext_vector_type(2)));
typedef unsigned u32x4_t __attribute__((ext_vector_type(4)));
typedef unsigned u32x2_t __attribute__((ext_vector_type(2)));
#define LDSP __attribute__((address_space(3)))
constexpr int D = 1024, BATCH = 2, SEQ = 16384, T = BATCH * SEQ, DEPTH = 2;
constexpr int MIXW = 512, DIN = 8712, NP = 8704, NPP = 5632;
constexpr int C_RQ = 0, C_RK = 256, C_RV = 512, C_RG = 1024, C_MX = 1536, C_MO = 2048, C_AQ = 2560, C_AK = 3328, C_AV = 4096, C_GT = 5632;
constexpr int NE = 32, TOPK = 4, RMAX = 139264  , MAXTILES = 544;
constexpr float DN_ALPHA = 1.41421356237f, LN_EPS = 1e-5f, SWI_LIMIT = 7.0f, SWI_ALPHA = 1.702f;
constexpr int NTHR = 512;
#define RC(i) ((((i) >> 1) * 512) + lane * 8 + (((i) & 1) * 4))
constexpr float WSC_IN = 32.0f;

constexpr size_t MiB = 1u << 20;
constexpr size_t WS_CTL = 0, CTL_BYTES = 1 * MiB;
constexpr size_t WS_P = WS_CTL + CTL_BYTES;
constexpr size_t P_BYTES = (size_t)T * NP * 2;
constexpr size_t WS_H = WS_P, WS_Y = WS_P + (size_t)RMAX * D * 2;
constexpr size_t WS_G = WS_P + (size_t)T * NPP * 2;
constexpr size_t WS_B = WS_P + P_BYTES;
constexpr size_t B_BYTES = (size_t)NE * 3 * D * D * 2;
constexpr size_t WS_S = WS_B;
constexpr size_t WS_MLC = WS_B + 32 * MiB, WS_MQ = WS_B + 96 * MiB, WS_MK = WS_B + 128 * MiB, WS_MV = WS_B + 160 * MiB;
constexpr size_t WS_X = WS_B + B_BYTES;
constexpr size_t WS_XB = WS_X + (size_t)T * D * 4;
constexpr size_t WS_YR = WS_X, WS_YM = WS_X + (size_t)T * MIXW * 2;
constexpr size_t WS_IGF = WS_XB + (size_t)T * D * 2;
constexpr size_t WS_TOPI = WS_IGF + (size_t)T * 8 * 4;
constexpr size_t WS_TOPP = WS_TOPI + (size_t)T * 4 * 4;
constexpr size_t WS_TOKROW = WS_TOPP + (size_t)T * 4 * 4;
constexpr size_t WS_ROWTOK = WS_TOKROW + (size_t)T * 4 * 4;
constexpr size_t WS_ROWP = WS_ROWTOK + (size_t)RMAX * 4;
constexpr size_t WS_WIN = WS_ROWP + (size_t)RMAX * 4;
constexpr size_t WS_WBT = WS_WIN + (size_t)NP * D * 2;
constexpr size_t WS_WOT = WS_WBT + (size_t)3 * D * MIXW * 2;
constexpr size_t WS_MC = WS_WOT + (size_t)D * D * 2;
constexpr size_t WS_MLN = WS_MC + (size_t)T * MIXW * 2;
constexpr size_t WS_MLS = WS_MLN + (size_t)128 * 8 * 128 * 4;
constexpr size_t WS_LSE = WS_MLS + (size_t)128 * 8 * 4 * 4;
constexpr size_t WS_XB8 = WS_LSE + (size_t)3 * T * 4 * 4;
constexpr size_t WS_GT = WS_XB8 + (size_t)T * D;
constexpr size_t WS_END = WS_GT + (size_t)256 * 4 * 384 * 4;
constexpr size_t DO_MG = 0;
constexpr size_t DO_YA = 3 * (size_t)T * MIXW * 2;
constexpr int CW_CHCNT = 1024;
constexpr int CW_PSTART = 16384;
constexpr int CW_NTILES = 16500;
constexpr int CW_TILEE = 16640;

struct Params {
    const float* in[26];
    float* out;
    char* ws;
};

__device__ __forceinline__ int lane_id() { return (int)__builtin_amdgcn_mbcnt_hi(~0u, __builtin_amdgcn_mbcnt_lo(~0u, 0u)); }
__device__ __forceinline__ int tid_of(int q_wave) { int t = q_wave * 64 + lane_id(); asm volatile("" : "+v"(t)); return t; }
__device__ __forceinline__ float4 ldnt_f4(const float* p) { const f32x4_t v = __builtin_nontemporal_load((const f32x4_t*)p); return make_float4(v[0], v[1], v[2], v[3]); }
__device__ __forceinline__ uint2 ldnt_u2(const void* p) { const u32x2_t v = __builtin_nontemporal_load((const u32x2_t*)p); return make_uint2(v[0], v[1]); }
__device__ __forceinline__ u32x4_t ldnt_u4(const void* p) { return __builtin_nontemporal_load((const u32x4_t*)p); }
__device__ __forceinline__ bf16x8_t ldnt_b8(const bf16_t* p) { return __builtin_nontemporal_load((const bf16x8_t*)p); }
__device__ __forceinline__ float4 ldnt_bf4(const bf16_t* p) { const u32x2_t u = __builtin_nontemporal_load((const u32x2_t*)p); return make_float4(__uint_as_float(u[0] << 16), __uint_as_float(u[0] & 0xffff0000u), __uint_as_float(u[1] << 16), __uint_as_float(u[1] & 0xffff0000u)); }
__device__ __forceinline__ float bf2f(bf16_t b) { return __uint_as_float(((unsigned)b) << 16); }
__device__ __forceinline__ unsigned cvtpk_bf16(float lo, float hi) { unsigned r; asm("v_cvt_pk_bf16_f32 %0, %1, %2" : "=v"(r) : "v"(lo), "v"(hi)); return r; }
__device__ __forceinline__ bf16_t f2bf(float f) { unsigned u = __float_as_uint(f); u += 0x7FFFu + ((u >> 16) & 1u); return (bf16_t)(u >> 16); }
__device__ __forceinline__ unsigned pk4_fp8(float a, float b, float c, float d) { int w = 0; w = __builtin_amdgcn_cvt_pk_fp8_f32(a, b, w, false); w = __builtin_amdgcn_cvt_pk_fp8_f32(c, d, w, true); return (unsigned)w; }
__device__ __forceinline__ float sigmoidf_(float x) { return __builtin_amdgcn_rcpf(1.0f + __expf(-x)); }
__device__ __forceinline__ float wsum(float v) {
#pragma unroll
    for (int o = 32; o > 0; o >>= 1) v += __shfl_xor(v, o);
    return v; }
__device__ __forceinline__ float wmax(float v) {
#pragma unroll
    for (int o = 32; o > 0; o >>= 1) v = fmaxf(v, __shfl_xor(v, o));
    return v; }

__device__ __forceinline__ float4 ld_bf4(const bf16_t* p) { const uint2 u = *(const uint2*)p; return make_float4(__uint_as_float(u.x << 16), __uint_as_float(u.x & 0xffff0000u), __uint_as_float(u.y << 16), __uint_as_float(u.y & 0xffff0000u)); }
__device__ __forceinline__ void st_bf4(bf16_t* p, float4 v) { uint2 u; u.x = cvtpk_bf16(v.x, v.y); u.y = cvtpk_bf16(v.z, v.w); *(uint2*)p = u; }

__device__ __forceinline__ char* uni_ptr(const void* p) { const unsigned long long v = (unsigned long long)p; unsigned lo = __builtin_amdgcn_readfirstlane((unsigned)v), hi = __builtin_amdgcn_readfirstlane((unsigned)(v >> 32)); asm volatile("" : "+s"(lo), "+s"(hi)); return (char*)(__attribute__((address_space(1))) char*)(((unsigned long long)hi << 32) | lo); }
#define PH_PROLOGUE int q_tid = tid_of(q_wave), q_bid = blockIdx.x; asm volatile("" : "+s"(q_bid)); char* q_ws = uni_ptr(p.ws); float* q_out = (float*)uni_ptr(p.out);
namespace pg8 {
#define PG8_LAS __attribute__((address_space(3)))
typedef short bf16x8 __attribute__((ext_vector_type(8)));
typedef float f32x4 __attribute__((ext_vector_type(4)));
typedef unsigned u32x4 __attribute__((ext_vector_type(4)));
constexpr int BM = 256, BK = 64, HALF = 128, HTB = HALF * BK * 2, STAGE_BYTES = 8 * HTB, NXCD = 8, WGM = 8;
__device__ __forceinline__ int lds_byte(int r, int c) { const int st = (r >> 4) * 2 + (c >> 5), rr = r & 15, cc = c & 31, ob = rr * 64 + cc * 2; return st * 1024 + (ob ^ (((ob >> 9) & 1) << 5)); }
__device__ __forceinline__ void stage_rc(int b, int& R, int& C) { const int st = b / 1024, sb = b % 1024, swz = sb ^ (((sb >> 9) & 1) << 5); R = (st >> 1) * 16 + swz / 64; C = (st & 1) * 32 + (swz % 64) / 2; }
__device__ __forceinline__ int perm32(int rho) { const int n = rho >> 4, i = rho & 15; return 8 * (i >> 2) + 4 * n + (i & 3); }
__device__ __forceinline__ unsigned cvt_pk_bf16(float lo, float hi) { unsigned r; asm volatile("v_cvt_pk_bf16_f32 %0, %1, %2" : "=v"(r) : "v"(lo), "v"(hi)); return r; }
typedef int i32x4 __attribute__((ext_vector_type(4)));
typedef int i32x8 __attribute__((ext_vector_type(8)));

struct Unit { const char* a0; const char* a1; const char* b0; const char* b1; int row0, col0, aux; };
template <bool GATHER, bool F8, class Epi, class Sched>
__device__ __forceinline__ void gemm_phase(const int tid, PG8_LAS unsigned char* lds, const int K, const int* __restrict__ rowidx, const Sched& S, const Epi& E) {
    const int wid = __builtin_amdgcn_readfirstlane(tid >> 6), lane = tid & 63, wr = wid >> 2, wc = wid & 3, fr = lane & 15, fq = lane >> 4;
    const int nt = K / BK;
    unsigned voffA[2], voffB[2]; int rA[2];
#pragma unroll
    for (int i = 0; i < 2; ++i) { int R, C; stage_rc(tid * 16 + i * 8192, R, C); const int Rb = Epi::PERM ? ((R & ~31) + perm32(R & 31)) : R;
        voffA[i] = GATHER ? (unsigned)(C * 2) : (unsigned)(R * K + C) * 2u; voffB[i] = (unsigned)(Rb * K + C) * 2u; rA[i] = R; }
    const size_t kstep = (size_t)(BK * 2);
    const unsigned ldsw = (unsigned)wid * 1024u;
    const int aoff = lds_byte(wr * 64 + fr, fq * 8), boff = lds_byte(wc * 32 + fr, fq * 8);
#define PG8_SA(b, h) (((b) * 2 + (h)) * HTB)
#define PG8_SB(b, h) ((4 + (b) * 2 + (h)) * HTB)
#define PG8_STAGE(bufoff, gbase, v0, v1) do { \
        __builtin_amdgcn_global_load_lds((const unsigned*)((const char*)(gbase) + (v0)), (PG8_LAS unsigned*)(lds + (bufoff) + ldsw), 16, 0, 0); \
        __builtin_amdgcn_global_load_lds((const unsigned*)((const char*)(gbase) + (v1)), (PG8_LAS unsigned*)(lds + (bufoff) + ldsw + 8192), 16, 0, 0); } while (0)
#define PG8_LDA(dst, b, h) do { _Pragma("unroll") for (int m = 0; m < 4; ++m) { const i32x4 lo_ = *(const PG8_LAS i32x4*)(lds + PG8_SA(b, h) + aoff + m * 2048), hi_ = *(const PG8_LAS i32x4*)(lds + PG8_SA(b, h) + aoff + m * 2048 + 1024); \
        dst[m] = __builtin_shufflevector(lo_, hi_, 0, 1, 2, 3, 4, 5, 6, 7); } } while (0)
#define PG8_LDB(dst, b, h) do { _Pragma("unroll") for (int n = 0; n < 2; ++n) { const i32x4 lo_ = *(const PG8_LAS i32x4*)(lds + PG8_SB(b, h) + boff + n * 2048), hi_ = *(const PG8_LAS i32x4*)(lds + PG8_SB(b, h) + boff + n * 2048 + 1024); \
        dst[n] = __builtin_shufflevector(lo_, hi_, 0, 1, 2, 3, 4, 5, 6, 7); } } while (0)
#define PG8_LO(v) __builtin_bit_cast(bf16x8, (i32x4)__builtin_shufflevector(v, v, 0, 1, 2, 3))
#define PG8_HI(v) __builtin_bit_cast(bf16x8, (i32x4)__builtin_shufflevector(v, v, 4, 5, 6, 7))
#define PG8_MMA(ai, bj, At, Bt) do { __builtin_amdgcn_s_setprio(1); \
        if constexpr (F8) { _Pragma("unroll") for (int m = 0; m < 4; ++m) _Pragma("unroll") for (int n = 0; n < 2; ++n) \
            asm volatile("v_mfma_scale_f32_16x16x128_f8f6f4 %0, %1, %2, %0, %3, %3 op_sel_hi:[0,0,0]" : "+v"(acc[ai][bj][m][n]) : "v"(Bt[n]), "v"(At[m]), "v"(sc1)); } \
        else { _Pragma("unroll") for (int m = 0; m < 4; ++m) _Pragma("unroll") for (int n = 0; n < 2; ++n) { \
            acc[ai][bj][m][n] = __builtin_amdgcn_mfma_f32_16x16x32_bf16(PG8_LO(Bt[n]), PG8_LO(At[m]), acc[ai][bj][m][n], 0, 0, 0); \
            acc[ai][bj][m][n] = __builtin_amdgcn_mfma_f32_16x16x32_bf16(PG8_HI(Bt[n]), PG8_HI(At[m]), acc[ai][bj][m][n], 0, 0, 0); } } \
        __builtin_amdgcn_s_setprio(0); } while (0)
#define PG8_WAIT_V(n) asm volatile("s_waitcnt vmcnt(" #n ")" ::: "memory")
#define PG8_WAIT_L(n) asm volatile("s_waitcnt lgkmcnt(" #n ")" ::: "memory")
#define PG8_BAR __builtin_amdgcn_s_barrier()
#define PG8_SCHED __builtin_amdgcn_sched_barrier(0)
    int sc1 = 0x7f7f7f7f; asm volatile("" : "+v"(sc1));
    Unit cur, nxt; int ui = 0;
    if (!S.next(0, cur)) return;
    f32x4 acc[2][2][4][2];
#pragma unroll
    for (int a = 0; a < 2; ++a)
#pragma unroll
        for (int b = 0; b < 2; ++b)
#pragma unroll
            for (int m = 0; m < 4; ++m)
#pragma unroll
                for (int n = 0; n < 2; ++n) acc[a][b][m][n] = (f32x4){0.f, 0.f, 0.f, 0.f};
    i32x8 At[4], B0[2], B1[2];
    unsigned cA00 = voffA[0], cA01 = voffA[1], cA10 = voffA[0], cA11 = voffA[1], nA00 = voffA[0], nA01 = voffA[1], nA10 = voffA[0], nA11 = voffA[1];
    if (GATHER) { const int* ix = rowidx + cur.row0;
        cA00 = (unsigned)ix[rA[0]] * (unsigned)(K * 2) + voffA[0]; cA01 = (unsigned)ix[rA[1]] * (unsigned)(K * 2) + voffA[1];
        cA10 = (unsigned)ix[128 + rA[0]] * (unsigned)(K * 2) + voffA[0]; cA11 = (unsigned)ix[128 + rA[1]] * (unsigned)(K * 2) + voffA[1]; }
    PG8_STAGE(PG8_SB(0, 0), cur.b0, voffB[0], voffB[1]); PG8_STAGE(PG8_SA(0, 0), cur.a0, cA00, cA01); PG8_STAGE(PG8_SB(0, 1), cur.b1, voffB[0], voffB[1]); PG8_STAGE(PG8_SA(0, 1), cur.a1, cA10, cA11);
    if (wr == 1) PG8_BAR;
    PG8_WAIT_V(4); PG8_BAR;
    PG8_STAGE(PG8_SB(1, 0), cur.b0 + kstep, voffB[0], voffB[1]); PG8_STAGE(PG8_SA(1, 0), cur.a0 + kstep, cA00, cA01); PG8_STAGE(PG8_SB(1, 1), cur.b1 + kstep, voffB[0], voffB[1]);
    PG8_WAIT_V(6); PG8_BAR;
    for (;;) {
        const bool has_next = S.next(ui + 1, nxt);
        if (!has_next) nxt = cur;
        if (GATHER) { const int* ix = rowidx + nxt.row0;
            nA00 = (unsigned)ix[rA[0]] * (unsigned)(K * 2) + voffA[0]; nA01 = (unsigned)ix[rA[1]] * (unsigned)(K * 2) + voffA[1];
            nA10 = (unsigned)ix[128 + rA[0]] * (unsigned)(K * 2) + voffA[0]; nA11 = (unsigned)ix[128 + rA[1]] * (unsigned)(K * 2) + voffA[1]; }
#pragma unroll 1
        for (int t = 0; t < nt; t += 2) {
            const bool last = (t == nt - 2);
            const char* a1h1 = cur.a1 + (size_t)(t + 1) * kstep;
            const char* a2h0 = last ? nxt.a0 : cur.a0 + (size_t)(t + 2) * kstep; const char* a2h1 = last ? nxt.a1 : cur.a1 + (size_t)(t + 2) * kstep;
            const char* b2h0 = last ? nxt.b0 : cur.b0 + (size_t)(t + 2) * kstep; const char* b2h1 = last ? nxt.b1 : cur.b1 + (size_t)(t + 2) * kstep;
            const unsigned x00 = (GATHER && last) ? nA00 : cA00, x01 = (GATHER && last) ? nA01 : cA01, x10 = (GATHER && last) ? nA10 : cA10, x11 = (GATHER && last) ? nA11 : cA11;
            PG8_LDB(B0, 0, 0); PG8_SCHED; PG8_LDA(At, 0, 0); PG8_STAGE(PG8_SA(1, 1), a1h1, cA10, cA11);
            PG8_WAIT_L(8); PG8_BAR; PG8_WAIT_L(0); PG8_MMA(0, 0, At, B0); PG8_BAR; PG8_SCHED;
            PG8_LDB(B1, 0, 1); PG8_STAGE(PG8_SB(0, 0), b2h0, voffB[0], voffB[1]);
            PG8_BAR; PG8_WAIT_L(0); PG8_MMA(0, 1, At, B1); PG8_BAR;
            PG8_LDA(At, 0, 1); PG8_STAGE(PG8_SA(0, 0), a2h0, x00, x01);
            PG8_BAR; PG8_WAIT_L(0); PG8_MMA(1, 0, At, B0); PG8_BAR; PG8_SCHED;
            PG8_STAGE(PG8_SB(0, 1), b2h1, voffB[0], voffB[1]);
            PG8_WAIT_V(6); PG8_BAR; PG8_MMA(1, 1, At, B1); PG8_BAR;
            PG8_LDB(B0, 1, 0); PG8_SCHED; PG8_LDA(At, 1, 0); PG8_STAGE(PG8_SA(0, 1), a2h1, x10, x11);
            PG8_WAIT_L(8); PG8_BAR; PG8_WAIT_L(0); PG8_MMA(0, 0, At, B0); PG8_BAR; PG8_SCHED;
            PG8_LDB(B1, 1, 1); PG8_STAGE(PG8_SB(1, 0), b2h0 + kstep, voffB[0], voffB[1]);
            PG8_BAR; PG8_WAIT_L(0); PG8_MMA(0, 1, At, B1); PG8_BAR;
            PG8_LDA(At, 1, 1); PG8_STAGE(PG8_SA(1, 0), a2h0 + kstep, x00, x01);
            PG8_BAR; PG8_WAIT_L(0); PG8_MMA(1, 0, At, B0); PG8_BAR; PG8_SCHED;
            PG8_STAGE(PG8_SB(1, 1), b2h1 + kstep, voffB[0], voffB[1]);
            PG8_WAIT_V(6); PG8_BAR; PG8_MMA(1, 1, At, B1); PG8_BAR;
        }
        if constexpr (F8) asm volatile("s_nop 15\n\ts_nop 15" ::: "memory");
        E(acc, cur, wr, wc, fr, fq);
        if (!has_next) break;
#pragma unroll
        for (int a = 0; a < 2; ++a)
#pragma unroll
            for (int b = 0; b < 2; ++b)
#pragma unroll
                for (int m = 0; m < 4; ++m)
#pragma unroll
                    for (int n = 0; n < 2; ++n) acc[a][b][m][n] = (f32x4){0.f, 0.f, 0.f, 0.f};
        cur = nxt; cA00 = nA00; cA01 = nA01; cA10 = nA10; cA11 = nA11; ++ui;
    }
    PG8_WAIT_V(0);
    if (wr == 0) PG8_BAR;
    PG8_BAR;
#undef PG8_SA
#undef PG8_SB
#undef PG8_STAGE
#undef PG8_LDA
#undef PG8_LDB
#undef PG8_LO
#undef PG8_HI
#undef PG8_MMA
#undef PG8_WAIT_V
#undef PG8_WAIT_L
#undef PG8_BAR
#undef PG8_SCHED
}
struct GridOrder {
    int nM, nN, nwg, G, c;
    __device__ __forceinline__ bool locate(int i, int& pm, int& pn) const {
        const long L = (long)i * G + c; if (L >= nwg) return false;
        int wgid = (int)L; { const int q = nwg / NXCD, r = nwg % NXCD, xcd = wgid % NXCD, off = wgid / NXCD; wgid = (xcd < r ? xcd * (q + 1) : r * (q + 1) + (xcd - r) * q) + off; }
        const int nig = WGM * nN, gid = wgid / nig, fm = gid * WGM, gsz = (nM - fm) < WGM ? (nM - fm) : WGM;
        pm = fm + ((wgid % nig) % gsz); pn = (wgid % nig) / gsz; return true;
    }
};
}

__device__ __forceinline__ void cvt_load(int q_tid, const float* src, int ldn, float4& va, float4& vb) {
    const int k = q_tid >> 4, n4 = (q_tid & 15) * 4; va = ldnt_f4(src + (size_t)k * ldn + n4); vb = ldnt_f4(src + (size_t)(k + 32) * ldn + n4); }
__device__ __forceinline__ void cvt_tile(int q_tid, LDSP bf16_t* tl, const float4 va, const float4 vb, bf16_t* dst, int K, int k0) {
    __syncthreads();
#pragma unroll
    for (int h = 0; h < 2; ++h) { const int k = (q_tid >> 4) + h * 32, nq = q_tid & 15, n4 = nq * 4; const float4 v = h ? vb : va;
        const int ko = ((((k >> 3) ^ (nq & 7)) << 3) | (k & 7));
        tl[(n4 + 0) * 64 + ko] = f2bf(v.x); tl[(n4 + 1) * 64 + ko] = f2bf(v.y); tl[(n4 + 2) * 64 + ko] = f2bf(v.z); tl[(n4 + 3) * 64 + ko] = f2bf(v.w); }
    __syncthreads();
    { const int n = q_tid >> 3, kc = q_tid & 7; *(u32x4_t*)(dst + (size_t)n * K + k0 + kc * 8) = *(const LDSP u32x4_t*)(tl + n * 64 + ((kc ^ ((n >> 2) & 7)) << 3)); }
}

__device__ __forceinline__ void cvt_tile8(int q_tid, LDSP unsigned char* tl, const float4 va, const float4 vb, unsigned char* dst, int K, int k0, float sc) {
    const int k = q_tid >> 4, nq = q_tid & 15, n4 = nq * 4;
    __syncthreads();
    { const unsigned wa = pk4_fp8(va.x * sc, va.y * sc, va.z * sc, va.w * sc), wb = pk4_fp8(vb.x * sc, vb.y * sc, vb.z * sc, vb.w * sc);
      const int ko = ((((k >> 4) ^ (nq & 3)) << 4) | (k & 15)), ko2 = (((((k + 32) >> 4) ^ (nq & 3)) << 4) | (k & 15));
#pragma unroll
      for (int j = 0; j < 4; ++j) { tl[(n4 + j) * 64 + ko] = (unsigned char)(wa >> (8 * j)); tl[(n4 + j) * 64 + ko2] = (unsigned char)(wb >> (8 * j)); } }
    __syncthreads();
    if (q_tid < 256) { const int n = q_tid >> 2, kc = q_tid & 3; *(u32x4_t*)(dst + (size_t)n * K + k0 + kc * 16) = *(const LDSP u32x4_t*)(tl + n * 64 + ((kc ^ ((n >> 2) & 3)) << 4)); }
}
__device__ __forceinline__ void pre_weights(const Params& p, char* q_ws, int l, float* lds, int q_tid, int q_bid) {
    LDSP bf16_t* tl = (LDSP bf16_t*)lds;
    const float* W = p.in[1] + (size_t)l * D * DIN; const float* WB = p.in[12] + (size_t)l * 3 * MIXW * D; const float* WO = p.in[13] + (size_t)l * D * D;
    bf16_t* WBT = (bf16_t*)(q_ws + WS_WBT); bf16_t* WOT = (bf16_t*)(q_ws + WS_WOT);
    for (int ub = q_bid; ub < 2816; ub += 4 * gridDim.x) {
        float4 va[4], vb[4];
#pragma unroll
        for (int j = 0; j < 4; ++j) { const int u = ub + j * gridDim.x;
            if (u < 2176) { const int n0 = (u >> 4) * 64, kt = u & 15; cvt_load(q_tid, W + n0 + (n0 >= 2048 ? 8 : 0) + (size_t)(kt * 64) * DIN, DIN, va[j], vb[j]); }
            else if (u < 2560) { const int v = u - 2176, br = v >> 7, r = v & 127, n0 = (r >> 3) * 64, kt = r & 7; cvt_load(q_tid, WB + (size_t)br * MIXW * D + n0 + (size_t)(kt * 64) * D, D, va[j], vb[j]); }
            else if (u < 2816) { const int v = u - 2560, n0 = (v >> 4) * 64, kt = v & 15; cvt_load(q_tid, WO + n0 + (size_t)(kt * 64) * D, D, va[j], vb[j]); } }
#pragma unroll
        for (int j = 0; j < 4; ++j) { const int u = ub + j * gridDim.x;
            if (u < 2176) { const int n0 = (u >> 4) * 64, kt = u & 15; cvt_tile8(q_tid, (LDSP unsigned char*)lds, va[j], vb[j], (unsigned char*)(q_ws + WS_WIN) + (size_t)n0 * D, D, kt * 64, WSC_IN); }
            else if (u < 2560) { const int v = u - 2176, br = v >> 7, r = v & 127, n0 = (r >> 3) * 64, kt = r & 7; cvt_tile(q_tid, tl, va[j], vb[j], WBT + (size_t)br * D * MIXW + (size_t)n0 * MIXW, MIXW, kt * 64); }
            else if (u < 2816) { const int v = u - 2560, n0 = (v >> 4) * 64, kt = v & 15; cvt_tile(q_tid, tl, va[j], vb[j], WOT + (size_t)n0 * D, D, kt * 64); } }
    }
    __syncthreads();
}
__device__ __forceinline__ void ph_prew(const Params& p, int q_wave, int l, float* lds) { PH_PROLOGUE pre_weights(p, q_ws, l, lds, q_tid, q_bid); }
__device__ __forceinline__ void stage_wig(const float* W, LDSP float* wig, int q_tid) {
    float4 t[2][2];
#pragma unroll
    for (int j = 0; j < 2; ++j) { const float* src = W + (size_t)(q_tid + j * NTHR) * DIN + 2048; t[j][0] = *(const float4*)src; t[j][1] = *(const float4*)(src + 4); }
#pragma unroll
    for (int j = 0; j < 2; ++j) { const int c = q_tid + j * NTHR; wig[c] = t[j][0].x; wig[1024 + c] = t[j][0].y; wig[2048 + c] = t[j][0].z; wig[3072 + c] = t[j][0].w; wig[4096 + c] = t[j][1].x; wig[5120 + c] = t[j][1].y; wig[6144 + c] = t[j][1].z; wig[7168 + c] = t[j][1].w; }
}
__device__ __forceinline__ void igf_calc(const float4 (&v)[4], const LDSP float* wig, int lane, float (&a8)[8]) {
#pragma unroll
    for (int k = 0; k < 8; ++k) a8[k] = 0.f;
#pragma unroll
    for (int i = 0; i < 4; ++i)
#pragma unroll
        for (int k = 0; k < 8; ++k) { const f32x4_t w = *(const LDSP f32x4_t*)(wig + k * 1024 + RC(i)); a8[k] += v[i].x * w[0] + v[i].y * w[1] + v[i].z * w[2] + v[i].w * w[3]; }
#pragma unroll
    for (int k = 0; k < 8; ++k) a8[k] = wsum(a8[k]);
}
__device__ __forceinline__ void igf_store(const float (&a8)[8], float* IGF, int tok, int lane) {
    if (lane == 0) { *(float4*)(IGF + (size_t)tok * 8) = make_float4(a8[0], a8[1], a8[2], a8[3]); *(float4*)(IGF + (size_t)tok * 8 + 4) = make_float4(a8[4], a8[5], a8[6], a8[7]); }
}
__device__ __forceinline__ void igf_row(const float4 (&v)[4], const LDSP float* wig, float* IGF, int tok, int lane) {
    float a8[8];
#pragma unroll
    for (int k = 0; k < 8; ++k) a8[k] = 0.f;
#pragma unroll
    for (int i = 0; i < 4; ++i)
#pragma unroll
        for (int k = 0; k < 8; ++k) { const f32x4_t w = *(const LDSP f32x4_t*)(wig + k * 1024 + RC(i)); a8[k] += v[i].x * w[0] + v[i].y * w[1] + v[i].z * w[2] + v[i].w * w[3]; }
#pragma unroll
    for (int k = 0; k < 8; ++k) a8[k] = wsum(a8[k]);
    if (lane == 0) { *(float4*)(IGF + (size_t)tok * 8) = make_float4(a8[0], a8[1], a8[2], a8[3]); *(float4*)(IGF + (size_t)tok * 8 + 4) = make_float4(a8[4], a8[5], a8[6], a8[7]); }
}
__device__ __forceinline__ void ph_pre(const Params& p, int q_wave, int l, float* lds) {
    PH_PROLOGUE
    LDSP float* wig = (LDSP float*)lds + 4096;
    stage_wig(p.in[1] + (size_t)l * D * DIN, wig, q_tid);
    pre_weights(p, q_ws, l, lds, q_tid, q_bid);
    __syncthreads();
    const float* X = p.in[0]; unsigned char* XB8 = (unsigned char*)(q_ws + WS_XB8); float* IGF = (float*)(q_ws + WS_IGF);
    const int lane = q_tid & 63, wv = q_tid >> 6;
    float4 v[4], vn[4];
    { const int tok0 = q_bid * 8 + wv;
#pragma unroll
      for (int i = 0; i < 4; ++i) v[i] = ldnt_f4(X + (size_t)tok0 * D + RC(i)); }
    int tprev = -1; unsigned h8[4] = {}; float hg[8] = {};
#define PRE_FLUSH() do { _Pragma("unroll") for (int i = 0; i < 4; ++i) *(unsigned*)(XB8 + (size_t)tprev * D + RC(i)) = h8[i]; igf_store(hg, IGF, tprev, lane); } while (0)
    for (int tok = q_bid * 8 + wv; tok < T; tok += gridDim.x * 8) {
        const int tn = tok + gridDim.x * 8 < T ? tok + gridDim.x * 8 : tok;
        asm volatile("" : "+v"(v[0].x), "+v"(v[1].x), "+v"(v[2].x), "+v"(v[3].x) :: "memory");
        if (tprev >= 0) PRE_FLUSH();
#pragma unroll
        for (int i = 0; i < 4; ++i) vn[i] = ldnt_f4(X + (size_t)tn * D + RC(i));
#pragma unroll
        for (int i = 0; i < 4; ++i) h8[i] = pk4_fp8(v[i].x, v[i].y, v[i].z, v[i].w);
        igf_calc(v, wig, lane, hg);
        tprev = tok;
#pragma unroll
        for (int i = 0; i < 4; ++i) v[i] = vn[i];
    }
    if (tprev >= 0) PRE_FLUSH();
#undef PRE_FLUSH
}

struct EpiStoreBf16 {
    static constexpr bool PERM = true;
    bf16_t* O; bf16_t* G; int ldc; float sc;
    __device__ __forceinline__ void operator()(const pg8::f32x4 (&acc)[2][2][4][2], const pg8::Unit& u, int wr, int wc, int fr, int fq) const {
        const bool gate = u.col0 >= C_GT; const int j = (u.col0 - C_GT) >> 8;
        unsigned char* gt = (unsigned char*)G + ((size_t)((u.row0 >> 8) * 12 + j) << 16) + (size_t)(wr * 4 + wc) * 8192 + (fq * 16 + fr) * 16;
        const int lane = fq * 16 + fr, pr = lane >> 2, pq = lane & 3, srcl = (pq * 16 + pr) * 4;
        bf16_t* prow = O + (size_t)(u.row0 + wr * 64 + pr) * ldc + u.col0 + wc * 32 + 8 * pq;
        if (gate) {
#pragma unroll
            for (int ai = 0; ai < 2; ++ai)
#pragma unroll
                for (int m = 0; m < 4; ++m) { pg8::u32x4 w;
                    { const pg8::f32x4 v0 = acc[ai][0][m][0] * sc, v1 = acc[ai][0][m][1] * sc; w.x = pk4_fp8(v0[0], v0[1], v0[2], v0[3]); w.y = pk4_fp8(v1[0], v1[1], v1[2], v1[3]); }
                    { const pg8::f32x4 v0 = acc[ai][1][m][0] * sc, v1 = acc[ai][1][m][1] * sc; w.z = pk4_fp8(v0[0], v0[1], v0[2], v0[3]); w.w = pk4_fp8(v1[0], v1[1], v1[2], v1[3]); }
                    __builtin_nontemporal_store(w, (pg8::u32x4*)(gt + (ai * 4 + m) * 1024)); }
            return; }
#pragma unroll
        for (int ai = 0; ai < 2; ++ai)
#pragma unroll
            for (int m = 0; m < 4; ++m) {
#pragma unroll
                for (int bj = 0; bj < 2; ++bj) { const pg8::f32x4 v0 = acc[ai][bj][m][0] * sc, v1 = acc[ai][bj][m][1] * sc;
                    pg8::u32x4 w; w.x = pg8::cvt_pk_bf16(v0[0], v0[1]); w.y = pg8::cvt_pk_bf16(v0[2], v0[3]); w.z = pg8::cvt_pk_bf16(v1[0], v1[1]); w.w = pg8::cvt_pk_bf16(v1[2], v1[3]);
                    pg8::u32x4 x; x.x = (unsigned)__builtin_amdgcn_ds_bpermute(srcl, (int)w.x); x.y = (unsigned)__builtin_amdgcn_ds_bpermute(srcl, (int)w.y); x.z = (unsigned)__builtin_amdgcn_ds_bpermute(srcl, (int)w.z); x.w = (unsigned)__builtin_amdgcn_ds_bpermute(srcl, (int)w.w);
                    *(pg8::u32x4*)(prow + (size_t)(ai * 128 + m * 16) * ldc + bj * 128) = x; } }
    }
};
struct SchedGrid {
    pg8::GridOrder g; const char* A; const char* B; int K;
    __device__ __forceinline__ bool next(int i, pg8::Unit& u) const { int pm, pn; if (!g.locate(i, pm, pn)) return false;
        u.a0 = A + (size_t)pm * 256 * K * 2; u.a1 = u.a0 + (size_t)128 * K * 2; u.b0 = B + (size_t)pn * 256 * K * 2; u.b1 = u.b0 + (size_t)128 * K * 2; u.row0 = pm * 256; u.col0 = pn * 256; u.aux = 0; return true; }
};
__device__ __forceinline__ void ph_inproj_mfma(const Params& p, int q_wave, int l, float* lds) {
    PH_PROLOGUE
    SchedGrid S; S.g.nM = T / 256; S.g.nN = NP / 256; S.g.nwg = S.g.nM * S.g.nN; S.g.G = gridDim.x; S.g.c = q_bid; S.A = q_ws + WS_XB8; S.B = q_ws + WS_WIN; S.K = D / 2;
    EpiStoreBf16 E; E.O = (bf16_t*)(q_ws + WS_P); E.ldc = NPP; E.G = (bf16_t*)(q_ws + WS_G); E.sc = 1.0f / WSC_IN;
    pg8::gemm_phase<false, true>(q_tid, (PG8_LAS unsigned char*)lds, D / 2, nullptr, S, E);
}

struct SchedMerge {
    pg8::GridOrder g; const char* Y0; const char* Y1; const char* Y2; const char* B;
    __device__ __forceinline__ bool next(int i, pg8::Unit& u) const { const int j = i / 3, br = i - 3 * j; int pm, pn; if (!g.locate(j, pm, pn)) return false;
        const char* Y = Y0 + (size_t)br * ((size_t)T * MIXW * 2); if (br == 2) Y = Y2;
        u.a0 = Y + (size_t)pm * 256 * MIXW * 2; u.a1 = u.a0 + (size_t)128 * MIXW * 2; u.b0 = B + ((size_t)br * D + (size_t)pn * 256) * MIXW * 2; u.b1 = u.b0 + (size_t)128 * MIXW * 2;
        u.row0 = pm * 256; u.col0 = pn * 256; u.aux = br; return true; }
};
__device__ __forceinline__ void unpack8(const pg8::u32x4 w, float (&f)[8]) {
    f[0] = __uint_as_float(w.x << 16); f[1] = __uint_as_float(w.x & 0xffff0000u); f[2] = __uint_as_float(w.y << 16); f[3] = __uint_as_float(w.y & 0xffff0000u);
    f[4] = __uint_as_float(w.z << 16); f[5] = __uint_as_float(w.z & 0xffff0000u); f[6] = __uint_as_float(w.w << 16); f[7] = __uint_as_float(w.w & 0xffff0000u); }
struct EpiMerge {
    static constexpr bool PERM = true;
    const bf16_t* G; bf16_t* S; bf16_t* MG;
    __device__ __forceinline__ void operator()(const pg8::f32x4 (&acc)[2][2][4][2], const pg8::Unit& u, int wr, int wc, int fr, int fq) const {
        const int row0 = u.row0 + wr * 64 + fr, col0 = u.col0 + wc * 32 + 8 * fq, br = u.aux, pm = u.row0 >> 8, pn = u.col0 >> 8;
        const size_t lo = (size_t)(wr * 4 + wc) * 8192 + (fq * 16 + fr) * 8;
        const unsigned char* gp = (const unsigned char*)G + ((size_t)(pm * 12 + br * 4 + pn) << 16) + (size_t)(wr * 4 + wc) * 8192 + (fq * 16 + fr) * 16; bf16_t* sp = S + ((size_t)(pm * 4 + pn) << 16) + lo; bf16_t* mp = MG + (size_t)row0 * D + col0;
        pg8::u32x4 gq[4], mq[4][2];
#define MERGE_LOAD(k, s) do { gq[s] = __builtin_nontemporal_load((const pg8::u32x4*)(gp + (k) * 1024)); \
            if (br > 0) { mq[s][0] = __builtin_nontemporal_load((const pg8::u32x4*)(sp + (k) * 1024)); mq[s][1] = __builtin_nontemporal_load((const pg8::u32x4*)(sp + (k) * 1024 + 512)); } } while (0)
        MERGE_LOAD(0, 0); MERGE_LOAD(1, 1); MERGE_LOAD(2, 2);
#pragma unroll
        for (int k = 0; k < 8; ++k) { const int ai = k >> 2, m = k & 3, sl = k & 3;
            if (k < 5) { if (((k + 3) & 3) == 0) MERGE_LOAD(k + 3, 0); else if (((k + 3) & 3) == 1) MERGE_LOAD(k + 3, 1); else if (((k + 3) & 3) == 2) MERGE_LOAD(k + 3, 2); else MERGE_LOAD(k + 3, 3); }
            asm volatile("" ::: "memory");
#pragma unroll
            for (int bj = 0; bj < 2; ++bj) { float g[8], o[8]; { const unsigned w0 = bj ? gq[sl].z : gq[sl].x, w1 = bj ? gq[sl].w : gq[sl].y;
                    const f32x2_t a0 = __builtin_amdgcn_cvt_pk_f32_fp8((int)w0, false), a1 = __builtin_amdgcn_cvt_pk_f32_fp8((int)w0, true), a2 = __builtin_amdgcn_cvt_pk_f32_fp8((int)w1, false), a3 = __builtin_amdgcn_cvt_pk_f32_fp8((int)w1, true);
                    g[0] = a0[0]; g[1] = a0[1]; g[2] = a1[0]; g[3] = a1[1]; g[4] = a2[0]; g[5] = a2[1]; g[6] = a3[0]; g[7] = a3[1]; }
                if (br > 0) unpack8(mq[sl][bj], o); else {
#pragma unroll
                    for (int j = 0; j < 8; ++j) o[j] = 0.f; }
                const pg8::f32x4 v0 = acc[ai][bj][m][0], v1 = acc[ai][bj][m][1];
#pragma unroll
                for (int j = 0; j < 4; ++j) { o[j] += sigmoidf_(g[j]) * v0[j]; o[4 + j] += sigmoidf_(g[4 + j]) * v1[j]; }
                pg8::u32x4 w; w.x = pg8::cvt_pk_bf16(o[0], o[1]); w.y = pg8::cvt_pk_bf16(o[2], o[3]); w.z = pg8::cvt_pk_bf16(o[4], o[5]); w.w = pg8::cvt_pk_bf16(o[6], o[7]);
                if (br < 2) *(pg8::u32x4*)(sp + k * 1024 + bj * 512) = w; else *(pg8::u32x4*)(mp + (size_t)(ai * 128 + m * 16) * D + bj * 128) = w; }
            asm volatile("" ::: "memory"); }
#undef MERGE_LOAD
    }
};
__device__ __forceinline__ void ph_merge_mfma(const Params& p, int q_wave, int l, float* lds) {
    PH_PROLOGUE
    SchedMerge S; S.g.nM = T / 256; S.g.nN = D / 256; S.g.nwg = S.g.nM * S.g.nN; S.g.G = gridDim.x; S.g.c = q_bid;
    S.Y0 = q_ws + WS_YR; S.Y1 = q_ws + WS_YM; S.Y2 = (const char*)q_out + DO_YA; S.B = q_ws + WS_WBT;
    EpiMerge E; E.G = (const bf16_t*)(q_ws + WS_G); E.S = (bf16_t*)(q_ws + WS_S); E.MG = (bf16_t*)((char*)q_out + DO_MG);
    pg8::gemm_phase<false, false>(q_tid, (PG8_LAS unsigned char*)lds, MIXW, nullptr, S, E);
}
template <bool RESBF> struct EpiOut {
    static constexpr bool PERM = false;
    const float* XR; const bf16_t* XRB; float* X;
    typedef typename std::conditional<RESBF, u32x2_t, pg8::f32x4>::type raw_t;
    static constexpr int NST = RESBF ? 8 : 4;
    __device__ __forceinline__ raw_t ldraw(size_t o) const { if constexpr (RESBF) return *(const u32x2_t*)(XRB + o); else return __builtin_nontemporal_load((const pg8::f32x4*)(XR + o)); }
    static __device__ __forceinline__ pg8::f32x4 cvres(const raw_t w) { if constexpr (RESBF) return (pg8::f32x4){__uint_as_float(w.x << 16), __uint_as_float(w.x & 0xffff0000u), __uint_as_float(w.y << 16), __uint_as_float(w.y & 0xffff0000u)}; else return w; }
    __device__ __forceinline__ void operator()(const pg8::f32x4 (&acc)[2][2][4][2], const pg8::Unit& u, int wr, int wc, int fr, int fq) const {
        const int row0 = u.row0 + wr * 64 + fr, col0 = u.col0 + wc * 32 + 4 * fq;
        const size_t base = (size_t)row0 * D + col0; float* op = X + base;
        raw_t xq[NST][4];
#define OUT_LOAD(k, s) do { const size_t ro = base + (size_t)(((k) >> 2) * 128 + ((k) & 3) * 16) * D; \
            xq[s][0] = ldraw(ro); xq[s][1] = ldraw(ro + 16); xq[s][2] = ldraw(ro + 128); xq[s][3] = ldraw(ro + 144); } while (0)
#pragma unroll
        for (int k = 0; k < NST - 1; ++k) OUT_LOAD(k, k);
#pragma unroll
        for (int k = 0; k < 8; ++k) { const int ai = k >> 2, m = k & 3, sl = k % NST; const size_t ro = (size_t)(ai * 128 + m * 16) * D;
            if (k + NST - 1 < 8) OUT_LOAD(k + NST - 1, (k + NST - 1) % NST);
            asm volatile("" ::: "memory");
#pragma unroll
            for (int bj = 0; bj < 2; ++bj)
#pragma unroll
                for (int n = 0; n < 2; ++n) *(pg8::f32x4*)(op + ro + bj * 128 + n * 16) = cvres(xq[sl][bj * 2 + n]) * DN_ALPHA + acc[ai][bj][m][n];
            asm volatile("" ::: "memory"); }
#undef OUT_LOAD
    }
};
constexpr float WSC_GU = 32.0f, WSC_DN = 64.0f;
__device__ __forceinline__ void moe_weight_convert(const Params& p, char* q_ws, int l, float* lds, int q_tid, int q_bid, int u_lo, int u_hi) {
    LDSP unsigned char* tl = (LDSP unsigned char*)lds; unsigned char* WM = (unsigned char*)(q_ws + WS_B);
    const int k = q_tid >> 4, nq = q_tid & 15, n4 = nq * 4;
    float4 v[8];
#define MWC_SRC(u_) (p.in[((u_) >> 6) % 3 == 0 ? 18 : (((u_) >> 6) % 3 == 1 ? 20 : 22)] + ((size_t)l * NE + ((u_) >> 6) / 3) * D * D + (size_t)(((u_) & 3) * 256) * D + (((u_) >> 2) & 15) * 64)
#define MWC_LOAD(u_) do { const float* src_ = MWC_SRC(u_) + (size_t)k * D + n4; _Pragma("unroll") for (int i = 0; i < 8; ++i) v[i] = ldnt_f4(src_ + (size_t)(32 * i) * D); } while (0)
#define MWC_STORE(u_, b_) do { _Pragma("unroll") for (int s2 = 0; s2 < 2; ++s2) { const int idx = q_tid + s2 * NTHR, n = idx >> 4, c16 = idx & 15, blk = c16 >> 2, kc = c16 & 3; \
            unsigned char* dst = WM + (size_t)((u_) >> 6) * D * D + (size_t)((((u_) >> 2) & 15) * 64 + n) * D + ((u_) & 3) * 256 + c16 * 16; \
            *(u32x4_t*)dst = *(const LDSP u32x4_t*)(tl + (b_) * 16384 + blk * 4096 + n * 64 + ((kc ^ ((n >> 2) & 3)) << 4)); } } while (0)
    int uprev = -1, par = 0;
    if (u_lo + q_bid < u_hi) MWC_LOAD(u_lo + q_bid);
    for (int u = u_lo + q_bid; u < u_hi; u += gridDim.x) {
        const float sc = ((u >> 6) % 3 == 2) ? WSC_DN : WSC_GU;
        unsigned w[8];
#pragma unroll
        for (int i = 0; i < 8; ++i) w[i] = pk4_fp8(v[i].x * sc, v[i].y * sc, v[i].z * sc, v[i].w * sc);
        asm volatile("" : "+v"(w[7]) :: "memory");
        if (uprev >= 0) MWC_STORE(uprev, par ^ 1);
        const int un = u + gridDim.x;
        if (un < u_hi) MWC_LOAD(un);
#pragma unroll
        for (int i = 0; i < 8; ++i) { const int kk = k + 32 * (i & 1), ko = ((((kk >> 4) ^ (nq & 3)) << 4) | (kk & 15));
#pragma unroll
            for (int j = 0; j < 4; ++j) tl[par * 16384 + (i >> 1) * 4096 + (n4 + j) * 64 + ko] = (unsigned char)(w[i] >> (8 * j)); }
        __syncthreads();
        uprev = u; par ^= 1;
    }
    if (uprev >= 0) MWC_STORE(uprev, par ^ 1);
#undef MWC_STORE
#undef MWC_LOAD
#undef MWC_SRC
    __syncthreads();
}
constexpr int MWC_NU = NE * 3 * 64, MWC_SPLIT = MWC_NU * 2 / 3;
__device__ __forceinline__ void ph_outproj_mfma(const Params& p, int q_wave, int l, float* lds) {
    PH_PROLOGUE
    SchedGrid S; S.g.nM = T / 256; S.g.nN = D / 256; S.g.nwg = S.g.nM * S.g.nN; S.g.G = gridDim.x; S.g.c = q_bid; S.A = (const char*)q_out + DO_MG; S.B = q_ws + WS_WOT; S.K = D;
    const bool conv_first = (q_bid >> 3) & 1;
    if (conv_first) moe_weight_convert(p, q_ws, l, lds, q_tid, q_bid, 0, MWC_SPLIT);
    if (l == 0) { EpiOut<false> E; E.XR = p.in[0]; E.XRB = nullptr; E.X = (float*)(q_ws + WS_X); pg8::gemm_phase<false, false>(q_tid, (PG8_LAS unsigned char*)lds, D, nullptr, S, E); }
    else { EpiOut<true> E; E.XR = nullptr; E.XRB = (const bf16_t*)(q_ws + WS_XB); E.X = (float*)(q_ws + WS_X); pg8::gemm_phase<false, false>(q_tid, (PG8_LAS unsigned char*)lds, D, nullptr, S, E); }
    __syncthreads();
    if (!conv_first) moe_weight_convert(p, q_ws, l, lds, q_tid, q_bid, 0, MWC_SPLIT);
}
__device__ __forceinline__ void ph_mwc_tail(const Params& p, int q_wave, int l, float* lds) {
    PH_PROLOGUE
    __syncthreads();
    moe_weight_convert(p, q_ws, l, lds, q_tid, q_bid, MWC_SPLIT, MWC_NU);
}
struct SchedMoe1 {
    const unsigned* ctl; const char* XB8; const char* WM; int nun, G, c;
    __device__ __forceinline__ bool next(int i, pg8::Unit& u) const {
        const int li = i * (G >> 3) + (c >> 3), tile = (li >> 3) * 8 + (c & 7), pn = li & 7; if (tile * 8 >= nun) return false;
        const int e = __builtin_amdgcn_readfirstlane((int)ctl[CW_TILEE + tile]);
        u.a0 = XB8; u.a1 = XB8; u.b0 = WM + ((size_t)(e * 3 + 0) * D + (size_t)pn * 128) * D; u.b1 = WM + ((size_t)(e * 3 + 1) * D + (size_t)pn * 128) * D;
        u.row0 = tile * 256; u.col0 = pn * 128; u.aux = e; return true; }
};
struct EpiMoe1 {
    static constexpr bool PERM = true;
    const float* bg; const float* bu; unsigned char* H;
    __device__ __forceinline__ void operator()(const pg8::f32x4 (&acc)[2][2][4][2], const pg8::Unit& u, int wr, int wc, int fr, int fq) const {
        const int row0 = u.row0 + wr * 64 + fr, col0 = u.col0 + wc * 32 + 8 * fq;
        const pg8::f32x4 g0 = *(const pg8::f32x4*)(bg + u.aux * D + col0), g1 = *(const pg8::f32x4*)(bg + u.aux * D + col0 + 4), u0 = *(const pg8::f32x4*)(bu + u.aux * D + col0), u1 = *(const pg8::f32x4*)(bu + u.aux * D + col0 + 4);
#pragma unroll
        for (int ai = 0; ai < 2; ++ai)
#pragma unroll
            for (int m = 0; m < 4; ++m) { float hh[8];
#pragma unroll
                for (int n = 0; n < 2; ++n) { const pg8::f32x4 gv = acc[ai][0][m][n] * (1.0f / WSC_GU) + (n ? g1 : g0), uv = acc[ai][1][m][n] * (1.0f / WSC_GU) + (n ? u1 : u0);
#pragma unroll
                    for (int j = 0; j < 4; ++j) { const float g = fminf(gv[j], SWI_LIMIT), uu = fminf(fmaxf(uv[j], -SWI_LIMIT), SWI_LIMIT); hh[n * 4 + j] = (uu + 1.0f) * g * sigmoidf_(SWI_ALPHA * g); } }
                *(u32x2_t*)(H + (size_t)(row0 + ai * 128 + m * 16) * D + col0) = (u32x2_t){pk4_fp8(hh[0], hh[1], hh[2], hh[3]), pk4_fp8(hh[4], hh[5], hh[6], hh[7])}; }
    }
};
__device__ __forceinline__ void ph_moe1_mfma(const Params& p, int q_wave, int l, float* lds) {
    PH_PROLOGUE
    const unsigned* ctl = (const unsigned*)(q_ws + WS_CTL);
    SchedMoe1 S; S.ctl = ctl; S.XB8 = q_ws + WS_XB8; S.WM = q_ws + WS_B; S.nun = __builtin_amdgcn_readfirstlane((int)ctl[CW_NTILES]) * 8; S.G = gridDim.x; S.c = q_bid;
    EpiMoe1 E; E.bg = p.in[19] + (size_t)l * NE * D; E.bu = p.in[21] + (size_t)l * NE * D; E.H = (unsigned char*)(q_ws + WS_H);
    pg8::gemm_phase<true, true>(q_tid, (PG8_LAS unsigned char*)lds, D / 2, (const int*)(q_ws + WS_ROWTOK), S, E);
}
struct SchedMoe2 {
    const unsigned* ctl; const char* H; const char* WM; int nun, G, c;
    __device__ __forceinline__ bool next(int i, pg8::Unit& u) const {
        const int li = i * (G >> 3) + (c >> 3), tile = (li >> 2) * 8 + (c & 7), pn = li & 3; if (tile * 4 >= nun) return false;
        const int e = __builtin_amdgcn_readfirstlane((int)ctl[CW_TILEE + tile]);
        u.a0 = H + (size_t)tile * 256 * D; u.a1 = u.a0 + (size_t)128 * D; u.b0 = WM + ((size_t)(e * 3 + 2) * D + (size_t)pn * 256) * D; u.b1 = u.b0 + (size_t)128 * D;
        u.row0 = tile * 256; u.col0 = pn * 256; u.aux = e; return true; }
};
constexpr float YSC = 16.0f;
template <bool Y8> struct EpiMoe2 {
    static constexpr bool PERM = true;
    const float* bd; const float* rowp; bf16_t* Y;
    __device__ __forceinline__ void operator()(const pg8::f32x4 (&acc)[2][2][4][2], const pg8::Unit& u, int wr, int wc, int fr, int fq) const {
        const int row0 = u.row0 + wr * 64 + fr, col0 = u.col0 + wc * 32 + 8 * fq;
        float pr[8]; pg8::f32x4 bb[2][2];
#pragma unroll
        for (int k = 0; k < 8; ++k) pr[k] = rowp[row0 + (k >> 2) * 128 + (k & 3) * 16] * (Y8 ? YSC : 1.0f);
#pragma unroll
        for (int bj = 0; bj < 2; ++bj) { bb[bj][0] = *(const pg8::f32x4*)(bd + u.aux * D + col0 + bj * 128); bb[bj][1] = *(const pg8::f32x4*)(bd + u.aux * D + col0 + bj * 128 + 4); }
#pragma unroll
        for (int ai = 0; ai < 2; ++ai)
#pragma unroll
            for (int m = 0; m < 4; ++m) { const int row = row0 + ai * 128 + m * 16; const float p1 = pr[ai * 4 + m];
#pragma unroll
                for (int bj = 0; bj < 2; ++bj) { const pg8::f32x4 v0 = (acc[ai][bj][m][0] * (1.0f / WSC_DN) + bb[bj][0]) * p1, v1 = (acc[ai][bj][m][1] * (1.0f / WSC_DN) + bb[bj][1]) * p1;
                    if (Y8) *(u32x2_t*)((unsigned char*)Y + (size_t)row * D + col0 + bj * 128) = (u32x2_t){pk4_fp8(v0[0], v0[1], v0[2], v0[3]), pk4_fp8(v1[0], v1[1], v1[2], v1[3])};
                    else { pg8::u32x4 w; w.x = pg8::cvt_pk_bf16(v0[0], v0[1]); w.y = pg8::cvt_pk_bf16(v0[2], v0[3]); w.z = pg8::cvt_pk_bf16(v1[0], v1[1]); w.w = pg8::cvt_pk_bf16(v1[2], v1[3]);
                        *(pg8::u32x4*)(Y + (size_t)row * D + col0 + bj * 128) = w; } } }
    }
};
__device__ __forceinline__ void ph_moe2_mfma(const Params& p, int q_wave, int l, float* lds) {
    PH_PROLOGUE
    const unsigned* ctl = (const unsigned*)(q_ws + WS_CTL);
    SchedMoe2 S; S.ctl = ctl; S.H = q_ws + WS_H; S.WM = q_ws + WS_B; S.nun = __builtin_amdgcn_readfirstlane((int)ctl[CW_NTILES]) * 4; S.G = gridDim.x; S.c = q_bid;
    if (l == DEPTH - 1) { EpiMoe2<true> E; E.bd = p.in[23] + (size_t)l * NE * D; E.rowp = (const float*)(q_ws + WS_ROWP); E.Y = (bf16_t*)(q_ws + WS_Y); pg8::gemm_phase<false, true>(q_tid, (PG8_LAS unsigned char*)lds, D / 2, nullptr, S, E); }
    else { EpiMoe2<false> E; E.bd = p.in[23] + (size_t)l * NE * D; E.rowp = (const float*)(q_ws + WS_ROWP); E.Y = (bf16_t*)(q_ws + WS_Y); pg8::gemm_phase<false, true>(q_tid, (PG8_LAS unsigned char*)lds, D / 2, nullptr, S, E); }
}

__device__ __forceinline__ bf16x8_t frag_row(const LDSP bf16_t* M, int ld, int row0, int k0, int r, int g) { return *(const LDSP bf16x8_t*)(M + (row0 + r) * ld + k0 + 8 * g); }
__device__ __forceinline__ bf16x8_t frag_tr(const LDSP bf16_t* M, int ld, int k0, int n0, int r, int g) {
    const LDSP bf16_t* a = M + (k0 + 8 * g + (r >> 2)) * ld + n0 + 4 * (r & 3);
    const s16x4_t lo = __builtin_amdgcn_ds_read_tr16_b64_v4i16((LDSP s16x4_t*)a), hi = __builtin_amdgcn_ds_read_tr16_b64_v4i16((LDSP s16x4_t*)(a + 4 * ld));
    return (bf16x8_t){lo[0], lo[1], lo[2], lo[3], hi[0], hi[1], hi[2], hi[3]};
}
__device__ __forceinline__ f32x4_t mma(f32x4_t acc, bf16x8_t X, bf16x8_t Y) { return __builtin_amdgcn_mfma_f32_16x16x32_bf16(X, Y, acc, 0, 0, 0); }
__device__ __forceinline__ unsigned pk2(float lo, float hi) { return cvtpk_bf16(lo, hi); }
__device__ __forceinline__ void unpack8u(const u32x4_t w, float (&f)[8]) {
    f[0] = __uint_as_float(w.x << 16); f[1] = __uint_as_float(w.x & 0xffff0000u); f[2] = __uint_as_float(w.y << 16); f[3] = __uint_as_float(w.y & 0xffff0000u);
    f[4] = __uint_as_float(w.z << 16); f[5] = __uint_as_float(w.z & 0xffff0000u); f[6] = __uint_as_float(w.w << 16); f[7] = __uint_as_float(w.w & 0xffff0000u); }
__device__ __forceinline__ u32x4_t pack8u(const float (&f)[8]) { return (u32x4_t){pk2(f[0], f[1]), pk2(f[2], f[3]), pk2(f[4], f[5]), pk2(f[6], f[7])}; }
__device__ __forceinline__ bf16x8_t scale_frag(bf16x8_t q, float s) { const u32x4_t w = __builtin_bit_cast(u32x4_t, q); float f[8]; unpack8u(w, f);
#pragma unroll
    for (int j = 0; j < 8; ++j) f[j] *= s;
    return __builtin_bit_cast(bf16x8_t, pack8u(f)); }

constexpr size_t WS_RKV = WS_B;
__device__ __forceinline__ float ret_lg(int h) { return log1pf(-exp2f(-5.0f - (float)h)); }
__device__ __forceinline__ void ret1_load(const bf16_t* P, int u, int q_tid, u32x4_t (&kr)[2], u32x4_t (&vr)[4]) {
    const int ch = u >> 2, h = u & 3, tok0 = ch * 128;
#pragma unroll
    for (int i = 0; i < 2; ++i) { const int c = q_tid + i * NTHR; kr[i] = *(const u32x4_t*)(P + (size_t)(tok0 + (c >> 3)) * NPP + C_RK + h * 64 + (c & 7) * 8); }
#pragma unroll
    for (int i = 0; i < 4; ++i) { const int c = q_tid + i * NTHR; vr[i] = *(const u32x4_t*)(P + (size_t)(tok0 + (c >> 4)) * NPP + C_RV + h * 128 + (c & 15) * 8); }
}
__device__ __forceinline__ void ph_ret1(const Params& p, int q_wave, int l, float* lds) {
    PH_PROLOGUE
    LDSP bf16_t* Ks = (LDSP bf16_t*)lds; LDSP bf16_t* Vs = Ks + 128 * 72;
    const bf16_t* P = (const bf16_t*)(q_ws + WS_P); bf16_t* RKV = (bf16_t*)(q_ws + WS_RKV);
    const int lane = q_tid & 63, r = lane & 15, g = lane >> 4;
    for (int ub = q_bid; ub < (T / 128) * 4; ub += 4 * gridDim.x) {
    u32x4_t kr4[4][2], vr4[4][4];
#pragma unroll
    for (int s = 0; s < 4; ++s) if (ub + s * (int)gridDim.x < (T / 128) * 4) ret1_load(P, ub + s * gridDim.x, q_tid, kr4[s], vr4[s]);
#pragma unroll
    for (int s = 0; s < 4; ++s) { const int u = ub + s * gridDim.x; if (u >= (T / 128) * 4) break;
        const u32x4_t (&kr)[2] = kr4[s]; const u32x4_t (&vr)[4] = vr4[s];
        const int ch = u >> 2, h = u & 3, b = ch >> 7, n = ch & 127; const float lg = ret_lg(h);
        __syncthreads();
#pragma unroll
        for (int i = 0; i < 2; ++i) { const int c = q_tid + i * NTHR, j = c >> 3; float f[8]; unpack8u(kr[i], f);
            const float sc = __expf(lg * (float)(127 - j)) * 0.125f;
#pragma unroll
            for (int q = 0; q < 8; ++q) f[q] *= sc;
            *(LDSP u32x4_t*)(Ks + j * 72 + (c & 7) * 8) = pack8u(f); }
#pragma unroll
        for (int i = 0; i < 4; ++i) { const int c = q_tid + i * NTHR; *(LDSP u32x4_t*)(Vs + (c >> 4) * 136 + (c & 15) * 8) = vr[i]; }
        __syncthreads();
        f32x4_t acc[4];
#pragma unroll
        for (int dt = 0; dt < 4; ++dt) acc[dt] = (f32x4_t){0.f, 0.f, 0.f, 0.f};
#pragma unroll
        for (int j0 = 0; j0 < 128; j0 += 32) { const bf16x8_t vy = frag_tr(Vs, 136, j0, q_wave * 16, r, g);
#pragma unroll
            for (int dt = 0; dt < 4; ++dt) acc[dt] = mma(acc[dt], frag_tr(Ks, 72, j0, dt * 16, r, g), vy); }
        LDSP float* ob = (LDSP float*)(Vs + 128 * 136) + q_wave * (16 * 68);
#pragma unroll
        for (int dt = 0; dt < 4; ++dt) *(LDSP f32x4_t*)(ob + r * 68 + dt * 16 + 4 * g) = acc[dt];
        bf16_t* dst = RKV + ((((size_t)n * 2 + b) * 4 + h) * 128 + q_wave * 16) * 64;
#pragma unroll
        for (int k = 0; k < 2; ++k) { const int rw = (lane >> 3) + 8 * k, ck = lane & 7; const f32x4_t lo = *(const LDSP f32x4_t*)(ob + rw * 68 + ck * 8), hi = *(const LDSP f32x4_t*)(ob + rw * 68 + ck * 8 + 4);
            *(u32x4_t*)(dst + rw * 64 + ck * 8) = (u32x4_t){pk2(lo[0], lo[1]), pk2(lo[2], lo[3]), pk2(hi[0], hi[1]), pk2(hi[2], hi[3])}; }
    }
    }
}
__device__ __forceinline__ void ph_ret2(const Params& p, int q_wave, int l) {
    PH_PROLOGUE
    bf16_t* RKV = (bf16_t*)(q_ws + WS_RKV);
    for (int idx = q_bid * NTHR + q_tid; idx < 32768; idx += gridDim.x * NTHR) {
        const float cd = __expf(ret_lg((idx >> 12) & 3) * 128.0f); float2 st = make_float2(0.f, 0.f);
#pragma unroll 64
        for (int n = 0; n < 128; ++n) { unsigned* q = (unsigned*)(RKV + (size_t)n * 65536) + idx; const unsigned kv = *q; *q = pk2(st.x, st.y); st.x = cd * st.x + __uint_as_float(kv << 16); st.y = cd * st.y + __uint_as_float(kv & 0xffff0000u); }
    }
}
__device__ __forceinline__ void ret3_load(const bf16_t* P, const bf16_t* RKV, int u, int q_tid, u32x4_t (&kr)[2], u32x4_t (&vr)[4], u32x4_t (&pr)[2]) {
    const int ch = u >> 2, h = u & 3, b = ch >> 7, n = ch & 127, tok0 = ch * 128;
#pragma unroll
    for (int i = 0; i < 2; ++i) { const int c = q_tid + i * NTHR; kr[i] = ldnt_u4(P + (size_t)(tok0 + (c >> 3)) * NPP + C_RK + h * 64 + (c & 7) * 8); }
#pragma unroll
    for (int i = 0; i < 4; ++i) { const int c = q_tid + i * NTHR; vr[i] = ldnt_u4(P + (size_t)(tok0 + (c >> 4)) * NPP + C_RV + h * 128 + (c & 15) * 8); }
    const bf16_t* src = RKV + (((size_t)n * 2 + b) * 4 + h) * 8192;
#pragma unroll
    for (int i = 0; i < 2; ++i) pr[i] = ldnt_u4(src + (q_tid + i * NTHR) * 8);
}
__device__ __forceinline__ void ph_ret3(const Params& p, int q_wave, int l, float* lds) {
    PH_PROLOGUE
    LDSP bf16_t* Ks = (LDSP bf16_t*)lds; LDSP bf16_t* Vs = Ks + 128 * 72; LDSP bf16_t* Pt = Vs + 128 * 136; LDSP bf16_t* Sw = Pt + 128 * 72 + q_wave * (16 * 136);
    const bf16_t* P = (const bf16_t*)(q_ws + WS_P); const bf16_t* RKV = (const bf16_t*)(q_ws + WS_RKV); bf16_t* YR = (bf16_t*)(q_ws + WS_YR);
    const float* rgn = p.in[2] + l * MIXW;
    LDSP float* gw = (LDSP float*)(Pt + 128 * 72 + 8 * 16 * 136);
    __syncthreads(); gw[q_tid] = rgn[q_tid];
    const int lane = q_tid & 63, r = lane & 15, g = lane >> 4, i0 = q_wave * 16;
    u32x4_t kr[2], vr[4], pr[2]; bf16x8_t qn[2];
#define RET3_QLOAD(u_) do { const bf16_t* qr_ = P + (size_t)(((u_) >> 2) * 128 + i0 + r) * NPP + C_RQ + ((u_) & 3) * 64 + 8 * g; qn[0] = ldnt_b8(qr_); qn[1] = ldnt_b8(qr_ + 32); } while (0)
    if (q_bid < (T / 128) * 4) { ret3_load(P, RKV, q_bid, q_tid, kr, vr, pr); RET3_QLOAD(q_bid); }
    int uprev = -1;
#define RET3_FLUSH() do { _Pragma("unroll") for (int k = 0; k < 4; ++k) { const int rw = (lane >> 4) + 4 * k, ck = lane & 15; \
        *(u32x4_t*)(YR + (size_t)((uprev >> 2) * 128 + i0 + rw) * MIXW + (uprev & 3) * 128 + ck * 8) = *(const LDSP u32x4_t*)(Sw + rw * 136 + ck * 8); } } while (0)
    for (int u = q_bid; u < (T / 128) * 4; u += gridDim.x) {
        const int ch = u >> 2, h = u & 3, tok0 = ch * 128; const float lg = ret_lg(h);
        __syncthreads();
#pragma unroll
        for (int i = 0; i < 2; ++i) { const int c = q_tid + i * NTHR; *(LDSP u32x4_t*)(Ks + (c >> 3) * 72 + (c & 7) * 8) = kr[i]; }
#pragma unroll
        for (int i = 0; i < 4; ++i) { const int c = q_tid + i * NTHR; *(LDSP u32x4_t*)(Vs + (c >> 4) * 136 + (c & 15) * 8) = vr[i]; }
#pragma unroll
        for (int i = 0; i < 2; ++i) { const int c = q_tid + i * NTHR, e = c >> 3, d = (c & 7) * 8; *(LDSP u32x4_t*)(Pt + e * 72 + d) = pr[i]; }
        bf16x8_t qf[2]; qf[0] = qn[0]; qf[1] = qn[1];
        __syncthreads();
        asm volatile("" : "+v"(qf[0]), "+v"(qf[1]));
        if (uprev >= 0) RET3_FLUSH();
        u32x2_t rgq[8];
#pragma unroll
        for (int et = 0; et < 8; ++et) rgq[et] = *(const u32x2_t*)(P + (size_t)(tok0 + i0 + r) * NPP + C_RG + h * 128 + et * 16 + 4 * g);
        if (u + (int)gridDim.x < (T / 128) * 4) { ret3_load(P, RKV, u + gridDim.x, q_tid, kr, vr, pr); RET3_QLOAD(u + gridDim.x); }
        const int ntile = q_wave + 1, nt2 = (ntile + 1) & ~1;
        for (int jt = 0; jt < nt2; ++jt) { f32x4_t a = (f32x4_t){0.f, 0.f, 0.f, 0.f};
            if (jt < ntile) { a = mma(a, frag_row(Ks, 72, jt * 16, 0, r, g), qf[0]); a = mma(a, frag_row(Ks, 72, jt * 16, 32, r, g), qf[1]); }
            float sv[4];
#pragma unroll
            for (int ii = 0; ii < 4; ++ii) { const int dij = (i0 + r) - (jt * 16 + 4 * g + ii); sv[ii] = dij >= 0 ? a[ii] * 0.125f * __expf(lg * (float)dij) : 0.f; }
            *(LDSP u32x2_t*)(Sw + r * 136 + jt * 16 + 4 * g) = (u32x2_t){pk2(sv[0], sv[1]), pk2(sv[2], sv[3])}; }
        f32x4_t o[8];
#pragma unroll
        for (int et = 0; et < 8; ++et) o[et] = (f32x4_t){0.f, 0.f, 0.f, 0.f};
        for (int j0 = 0; j0 < nt2 * 16; j0 += 32) { const bf16x8_t sy = frag_row(Sw, 136, 0, j0, r, g);
#pragma unroll
            for (int et = 0; et < 8; ++et) o[et] = mma(o[et], frag_tr(Vs, 136, j0, et * 16, r, g), sy); }
        { const float qd = __expf(lg * (float)(i0 + r + 1)); const bf16x8_t q0 = scale_frag(qf[0], qd), q1 = scale_frag(qf[1], qd);
#pragma unroll
          for (int et = 0; et < 8; ++et) { o[et] = mma(o[et], frag_row(Pt, 72, et * 16, 0, r, g), q0); o[et] = mma(o[et], frag_row(Pt, 72, et * 16, 32, r, g), q1); } }
        float s1 = 0.f;
#pragma unroll
        for (int et = 0; et < 8; ++et) s1 += (o[et][0] + o[et][1]) + (o[et][2] + o[et][3]);
        s1 += __shfl_xor(s1, 16); s1 += __shfl_xor(s1, 32);
        const float mu = s1 * (1.0f / 128.0f); float s2 = 0.f;
#pragma unroll
        for (int et = 0; et < 8; ++et) { o[et] -= mu; s2 += (o[et][0] * o[et][0] + o[et][1] * o[et][1]) + (o[et][2] * o[et][2] + o[et][3] * o[et][3]); }
        s2 += __shfl_xor(s2, 16); s2 += __shfl_xor(s2, 32);
        const float rstd = rsqrtf(s2 * (1.0f / 128.0f) + LN_EPS);
        const size_t tok = (size_t)(tok0 + i0 + r);
#pragma unroll
        for (int et = 0; et < 8; ++et) { const int c = h * 128 + et * 16 + 4 * g; const f32x4_t gn_ = *(const LDSP f32x4_t*)(gw + c); const float4 gn = make_float4(gn_[0], gn_[1], gn_[2], gn_[3]); const float4 rg = make_float4(__uint_as_float(rgq[et].x << 16), __uint_as_float(rgq[et].x & 0xffff0000u), __uint_as_float(rgq[et].y << 16), __uint_as_float(rgq[et].y & 0xffff0000u));
            *(LDSP u32x2_t*)(Sw + r * 136 + et * 16 + 4 * g) = (u32x2_t){pk2(o[et][0] * rstd * gn.x * (rg.x * sigmoidf_(rg.x)), o[et][1] * rstd * gn.y * (rg.y * sigmoidf_(rg.y))), pk2(o[et][2] * rstd * gn.z * (rg.z * sigmoidf_(rg.z)), o[et][3] * rstd * gn.w * (rg.w * sigmoidf_(rg.w)))}; }
        uprev = u;
    }
    if (uprev >= 0) RET3_FLUSH();
#undef RET3_FLUSH
}

__device__ __forceinline__ float wscan_add(float v, int lane) {
#pragma unroll
    for (int o = 1; o < 64; o <<= 1) { const float t = __shfl_up(v, o); if (lane >= o) v += t; }
    return v; }
__device__ __forceinline__ float wscan_max(float v, int lane) {
#pragma unroll
    for (int o = 1; o < 64; o <<= 1) { const float t = __shfl_up(v, o); if (lane >= o) v = fmaxf(v, t); }
    return v; }
__device__ __forceinline__ float logsigmoidf_(float x) { return fminf(x, 0.f) - log1pf(__expf(-fabsf(x))); }
__device__ __forceinline__ void ml_gates(const float* IGF, const float* bi, const float* bfg, int tok0, int h, int lane, LDSP float* cum, LDSP float* ig, LDSP float* pm, float& tot, float& amax) {
    const float i0 = IGF[(size_t)(tok0 + lane) * 8 + h] + bi[h], i1 = IGF[(size_t)(tok0 + 64 + lane) * 8 + h] + bi[h];
    const float l0 = logsigmoidf_(IGF[(size_t)(tok0 + lane) * 8 + 4 + h] + bfg[h]), l1 = logsigmoidf_(IGF[(size_t)(tok0 + 64 + lane) * 8 + 4 + h] + bfg[h]);
    const float c0 = wscan_add(l0, lane), c1 = wscan_add(l1, lane) + __shfl(c0, 63);
    tot = __shfl(c1, 63);
    const float p0 = wscan_max(i0 - c0, lane), p1 = fmaxf(wscan_max(i1 - c1, lane), __shfl(p0, 63));
    amax = wmax(fmaxf(tot - c0 + i0, tot - c1 + i1));
    cum[lane] = c0; cum[64 + lane] = c1; ig[lane] = i0; ig[64 + lane] = i1; pm[lane] = p0; pm[64 + lane] = p1;
}
__device__ __forceinline__ void ph_ml1(const Params& p, int q_wave, int l, float* lds) {
    PH_PROLOGUE
    LDSP bf16_t* Ks = (LDSP bf16_t*)lds; LDSP bf16_t* Vs = Ks + 128 * 136; LDSP float* gt = (LDSP float*)(Vs + 128 * 136); LDSP bf16_t* Xs = (LDSP bf16_t*)(gt + 2048);
    const bf16_t* P = (const bf16_t*)(q_ws + WS_P); const float* IGF = (const float*)(q_ws + WS_IGF);
    bf16_t* MQ = (bf16_t*)(q_ws + WS_MQ); bf16_t* MK = (bf16_t*)(q_ws + WS_MK); bf16_t* MV = (bf16_t*)(q_ws + WS_MV); bf16_t* MC = (bf16_t*)(q_ws + WS_MC);
    bf16_t* MLC = (bf16_t*)(q_ws + WS_MLC); float* MLN = (float*)(q_ws + WS_MLN); float* MLS = (float*)(q_ws + WS_MLS);
    const float* wq = p.in[5] + (size_t)l * 128 * 16; const float* wk = p.in[6] + (size_t)l * 128 * 16; const float* wv = p.in[7] + (size_t)l * 128 * 16;
    const float* bi = p.in[8] + l * 4; const float* bfg = p.in[9] + l * 4; const float* cw = p.in[3] + (size_t)l * 4 * MIXW; const float* cb = p.in[4] + (size_t)l * MIXW;
    const int lane = q_tid & 63, r = lane & 15, g = lane >> 4;
    for (int ch = q_bid; ch < T / 128; ch += gridDim.x) {
        const int b = ch >> 7, n = ch & 127, tok0 = ch * 128;
        u32x4_t xr[5];
#define ML1_XLOAD(h_) do { _Pragma("unroll") for (int i = 0; i < 5; ++i) { const int c = q_tid + i * NTHR, jr = c >> 4, cc = c & 15; xr[i] = (u32x4_t){0u, 0u, 0u, 0u}; \
            if (c < 131 * 16 && (n > 0 || jr >= 3)) xr[i] = ldnt_u4(P + (size_t)(tok0 + jr - 3) * NPP + C_MX + (h_) * 128 + cc * 8); } } while (0)
        ML1_XLOAD(0);
        __syncthreads();
        if (q_wave < 4) { const int h = q_wave; float tot, amax; ml_gates(IGF, bi, bfg, tok0, h, lane, gt + h * 512, gt + h * 512 + 128, gt + h * 512 + 256, tot, amax);
            gt[h * 512 + 384 + lane] = __expf(tot - gt[h * 512 + lane] + gt[h * 512 + 128 + lane] - amax); gt[h * 512 + 384 + 64 + lane] = __expf(tot - gt[h * 512 + 64 + lane] + gt[h * 512 + 128 + 64 + lane] - amax);
            if (lane == 0) { float* ms = MLS + (((size_t)n * 2 + b) * 4 + h) * 4; ms[0] = tot; ms[1] = amax; }
            float* gtg = (float*)(q_ws + WS_GT) + (size_t)(ch * 4 + h) * 384;
#pragma unroll
            for (int q = 0; q < 3; ++q) { gtg[q * 128 + lane] = gt[h * 512 + q * 128 + lane]; gtg[q * 128 + 64 + lane] = gt[h * 512 + q * 128 + 64 + lane]; } }
        __syncthreads();
        for (int h = 0; h < 4; ++h) {
#pragma unroll
            for (int i = 0; i < 5; ++i) { const int c = q_tid + i * NTHR, jr = c >> 4, cc = c & 15; if (c < 131 * 16) *(LDSP u32x4_t*)(Xs + jr * 136 + cc * 8) = xr[i]; }
            if (h < 3) ML1_XLOAD(h + 1);
            const int nb = q_tid & 31, n4 = h * 32 + nb, jr0 = q_tid >> 5;
            float cwr[4][4], cbr[4], wqr[16], wkr[16], wvr[16];
#pragma unroll
            for (int i = 0; i < 4; ++i) { const float4 t4 = *(const float4*)(cw + i * MIXW + n4 * 4); cwr[i][0] = t4.x; cwr[i][1] = t4.y; cwr[i][2] = t4.z; cwr[i][3] = t4.w; }
            { const float4 t4 = *(const float4*)(cb + n4 * 4); cbr[0] = t4.x; cbr[1] = t4.y; cbr[2] = t4.z; cbr[3] = t4.w; }
#pragma unroll
            for (int i = 0; i < 4; ++i) { const float4 a4 = *(const float4*)(wq + n4 * 16 + i * 4), b4 = *(const float4*)(wk + n4 * 16 + i * 4), c4 = *(const float4*)(wv + n4 * 16 + i * 4);
                wqr[i * 4] = a4.x; wqr[i * 4 + 1] = a4.y; wqr[i * 4 + 2] = a4.z; wqr[i * 4 + 3] = a4.w; wkr[i * 4] = b4.x; wkr[i * 4 + 1] = b4.y; wkr[i * 4 + 2] = b4.z; wkr[i * 4 + 3] = b4.w;
                wvr[i * 4] = c4.x; wvr[i * 4 + 1] = c4.y; wvr[i * 4 + 2] = c4.z; wvr[i * 4 + 3] = c4.w; }
            __syncthreads();
#pragma unroll 2
            for (int it = 0; it < 8; ++it) { const int j = jr0 + 16 * it, tok = tok0 + j;
                float xv[4][4];
#pragma unroll
                for (int i = 0; i < 4; ++i) { const u32x2_t w = *(const LDSP u32x2_t*)(Xs + (j + i) * 136 + nb * 4);
                    xv[i][0] = __uint_as_float(w.x << 16); xv[i][1] = __uint_as_float(w.x & 0xffff0000u); xv[i][2] = __uint_as_float(w.y << 16); xv[i][3] = __uint_as_float(w.y & 0xffff0000u); }
                float mc[4], q[4] = {0, 0, 0, 0}, k[4] = {0, 0, 0, 0}, v[4] = {0, 0, 0, 0};
#pragma unroll
                for (int c = 0; c < 4; ++c) { float a = cbr[c];
#pragma unroll
                    for (int i = 0; i < 4; ++i) a += cwr[i][c] * xv[i][c];
                    mc[c] = a * sigmoidf_(a); }
#pragma unroll
                for (int c = 0; c < 4; ++c)
#pragma unroll
                    for (int d = 0; d < 4; ++d) { q[d] += mc[c] * wqr[c * 4 + d]; k[d] += mc[c] * wkr[c * 4 + d]; v[d] += xv[3][c] * wvr[c * 4 + d]; }
#pragma unroll
                for (int d = 0; d < 4; ++d) k[d] *= 0.08838834764831845f;
                const size_t o = (size_t)tok * MIXW + n4 * 4;
                st_bf4(MQ + o, make_float4(q[0], q[1], q[2], q[3])); st_bf4(MK + o, make_float4(k[0], k[1], k[2], k[3])); st_bf4(MV + o, make_float4(v[0], v[1], v[2], v[3])); st_bf4(MC + o, make_float4(mc[0], mc[1], mc[2], mc[3]));
                const float wa = gt[h * 512 + 384 + j];
                *(LDSP u32x2_t*)(Ks + j * 136 + nb * 4) = (u32x2_t){pk2(k[0] * wa, k[1] * wa), pk2(k[2] * wa, k[3] * wa)};
                *(LDSP u32x2_t*)(Vs + j * 136 + nb * 4) = (u32x2_t){pk2(v[0], v[1]), pk2(v[2], v[3])}; }
            __syncthreads();
            f32x4_t acc[8];
#pragma unroll
            for (int dt = 0; dt < 8; ++dt) acc[dt] = (f32x4_t){0.f, 0.f, 0.f, 0.f};
#pragma unroll
            for (int j0 = 0; j0 < 128; j0 += 32) { const bf16x8_t vy = frag_tr(Vs, 136, j0, q_wave * 16, r, g);
#pragma unroll
                for (int dt = 0; dt < 8; ++dt) acc[dt] = mma(acc[dt], frag_tr(Ks, 136, j0, dt * 16, r, g), vy); }
            const size_t sb = ((size_t)n * 2 + b) * 4 + h;
            { LDSP float* ob = (LDSP float*)(Xs + 131 * 136) + q_wave * (16 * 68);
              bf16_t* dst = MLC + (sb * 128 + q_wave * 16) * 128;
#pragma unroll
              for (int hf = 0; hf < 2; ++hf) {
#pragma unroll
                  for (int dt = 0; dt < 4; ++dt) *(LDSP f32x4_t*)(ob + r * 68 + dt * 16 + 4 * g) = acc[hf * 4 + dt];
#pragma unroll
                  for (int k = 0; k < 2; ++k) { const int rw = (lane >> 3) + 8 * k, ck = lane & 7; const f32x4_t lo = *(const LDSP f32x4_t*)(ob + rw * 68 + ck * 8), hi = *(const LDSP f32x4_t*)(ob + rw * 68 + ck * 8 + 4);
                      *(u32x4_t*)(dst + rw * 128 + hf * 64 + ck * 8) = (u32x4_t){pk2(lo[0], lo[1]), pk2(lo[2], lo[3]), pk2(hi[0], hi[1]), pk2(hi[2], hi[3])}; } } }
            if (q_tid < 128) { float sm = 0.f; for (int j = 0; j < 128; ++j) sm += bf2f(Ks[j * 136 + q_tid]); MLN[sb * 128 + q_tid] = sm; }
            __syncthreads();
        }
    }
}
#undef ML1_XLOAD
__device__ __forceinline__ void ph_ml2(const Params& p, int q_wave, int l, float* lds) {
    PH_PROLOGUE
    bf16_t* MLC = (bf16_t*)(q_ws + WS_MLC); float* MLN = (float*)(q_ws + WS_MLN); float* MLS = (float*)(q_ws + WS_MLS);
    LDSP float* co = (LDSP float*)lds;
    const int vb = gridDim.x - 1 - q_bid;
    if (vb * NTHR >= 8 * 16512 / 2) return;
    __syncthreads();
    for (int i = q_tid; i < 1024; i += NTHR) { const int n = i >> 3, bh = i & 7; const float4 ms = *(const float4*)(MLS + ((size_t)n * 8 + bh) * 4); co[(bh * 128 + n) * 2] = ms.x; co[(bh * 128 + n) * 2 + 1] = ms.y; }
    __syncthreads();
    if (q_tid < 8) { const int bh = q_tid; float m = 0.f;
        for (int n = 0; n < 128; ++n) { const float gs = co[(bh * 128 + n) * 2], am = co[(bh * 128 + n) * 2 + 1]; const float mn = fmaxf(gs + m, am);
            co[(bh * 128 + n) * 2] = __expf(gs + m - mn); co[(bh * 128 + n) * 2 + 1] = __expf(am - mn);
            if (vb == 0) MLS[((size_t)n * 8 + bh) * 4 + 2] = m;
            m = mn; } }
    __syncthreads();
    for (int idx = vb * NTHR + q_tid; idx < 8 * 16512 / 2; idx += gridDim.x * NTHR) {
        if (idx < 65536) { const int bh = idx >> 13; unsigned* base = (unsigned*)(MLC + (size_t)bh * 16384) + (idx & 8191); float2 st = make_float2(0.f, 0.f);
#pragma unroll 64
            for (int n = 0; n < 128; ++n) { const float so = co[(bh * 128 + n) * 2], sn = co[(bh * 128 + n) * 2 + 1];
                unsigned* q = base + (size_t)n * (8 * 16384 / 2); const unsigned cv = *q; *q = pk2(st.x, st.y); st.x = so * st.x + sn * __uint_as_float(cv << 16); st.y = so * st.y + sn * __uint_as_float(cv & 0xffff0000u); } }
        else { const int j = idx - 65536, bh = j >> 6; float* base = MLN + (size_t)bh * 128 + (j & 63) * 2; float2 st = make_float2(0.f, 0.f);
#pragma unroll 64
            for (int n = 0; n < 128; ++n) { const float so = co[(bh * 128 + n) * 2], sn = co[(bh * 128 + n) * 2 + 1];
                float2* q = (float2*)(base + (size_t)n * (8 * 128)); const float2 cv = *q; *q = st; st.x = so * st.x + sn * cv.x; st.y = so * st.y + sn * cv.y; } }
    }
}
__device__ __forceinline__ void ml3_load(const bf16_t* MK, const bf16_t* MV, const bf16_t* MLC, const float* GT, const float* MLN, int u, int q_tid, u32x4_t (&kr)[4], u32x4_t (&vr)[4], u32x4_t (&cr)[4], float& gv) {
    const int ch = u >> 2, h = u & 3, b = ch >> 7, n = ch & 127, tok0 = ch * 128; const size_t sb = ((size_t)n * 2 + b) * 4 + h;
#pragma unroll
    for (int i = 0; i < 4; ++i) { const int c = q_tid + i * NTHR; const size_t o = (size_t)(tok0 + (c >> 4)) * MIXW + h * 128 + (c & 15) * 8; kr[i] = ldnt_u4(MK + o); vr[i] = ldnt_u4(MV + o); }
#pragma unroll
    for (int i = 0; i < 4; ++i) cr[i] = ldnt_u4(MLC + sb * 16384 + (size_t)(q_tid + i * NTHR) * 8);
    gv = q_tid < 384 ? GT[(size_t)u * 384 + q_tid] : MLN[sb * 128 + (q_tid - 384)];
}
__device__ __forceinline__ void ph_ml3(const Params& p, int q_wave, int l, float* lds) {
    PH_PROLOGUE
    LDSP bf16_t* Ks = (LDSP bf16_t*)lds; LDSP bf16_t* Vs = Ks + 128 * 136; LDSP bf16_t* Ct = Vs + 128 * 136; LDSP bf16_t* Sw = Ct + 128 * 136 + q_wave * (16 * 136);
    LDSP float* gt = (LDSP float*)(Ct + 128 * 136 + 8 * 16 * 136);
    LDSP float* gw = gt + 512;
    const bf16_t* P = (const bf16_t*)(q_ws + WS_P); const float* IGF = (const float*)(q_ws + WS_IGF);
    const bf16_t* MQ = (const bf16_t*)(q_ws + WS_MQ); const bf16_t* MK = (const bf16_t*)(q_ws + WS_MK); const bf16_t* MV = (const bf16_t*)(q_ws + WS_MV); const bf16_t* MC = (const bf16_t*)(q_ws + WS_MC);
    const bf16_t* MLC = (const bf16_t*)(q_ws + WS_MLC); const float* MLN = (const float*)(q_ws + WS_MLN); const float* MLS = (const float*)(q_ws + WS_MLS);
    bf16_t* YM = (bf16_t*)(q_ws + WS_YM);
    const float* bi = p.in[8] + l * 4; const float* bfg = p.in[9] + l * 4; const float* mgn = p.in[10] + l * MIXW; const float* msk = p.in[11] + l * MIXW;
    const int lane = q_tid & 63, r = lane & 15, g = lane >> 4, i0 = q_wave * 16;
    u32x4_t kr[4], vr[4], cr[4]; float gv = 0.f; const float* GT = (const float*)(q_ws + WS_GT);
    __syncthreads(); gw[q_tid] = mgn[q_tid]; gw[512 + q_tid] = msk[q_tid];
    bf16x8_t qn[4];
#define ML3_QLOAD(u_) do { const bf16_t* qr_ = MQ + (size_t)(((u_) >> 2) * 128 + i0 + r) * MIXW + ((u_) & 3) * 128 + 8 * g; _Pragma("unroll") for (int ks_ = 0; ks_ < 4; ++ks_) qn[ks_] = ldnt_b8(qr_ + 32 * ks_); } while (0)
#define ML3_SB(u_) ((((size_t)(((u_) >> 2) & 127)) * 2 + ((u_) >> 9)) * 4 + ((u_) & 3))
    float mprev_n = 0.f;
    if (q_bid < (T / 128) * 4) { ml3_load(MK, MV, MLC, GT, MLN, q_bid, q_tid, kr, vr, cr, gv); ML3_QLOAD(q_bid); mprev_n = MLS[ML3_SB(q_bid) * 4 + 2]; }
    int uprev = -1;
#define ML3_FLUSH() do { _Pragma("unroll") for (int k = 0; k < 4; ++k) { const int rw = (lane >> 4) + 4 * k, ck = lane & 15; \
        *(u32x4_t*)(YM + (size_t)((uprev >> 2) * 128 + i0 + rw) * MIXW + (uprev & 3) * 128 + ck * 8) = *(const LDSP u32x4_t*)(Sw + rw * 136 + ck * 8); } } while (0)
    for (int u = q_bid; u < (T / 128) * 4; u += gridDim.x) {
        const int ch = u >> 2, h = u & 3, tok0 = ch * 128;
        __syncthreads();
#pragma unroll
        for (int i = 0; i < 4; ++i) { const int c = q_tid + i * NTHR; *(LDSP u32x4_t*)(Ks + (c >> 4) * 136 + (c & 15) * 8) = kr[i]; *(LDSP u32x4_t*)(Vs + (c >> 4) * 136 + (c & 15) * 8) = vr[i]; }
#pragma unroll
        for (int i = 0; i < 4; ++i) { const int c = q_tid + i * NTHR, e = c >> 4, d = (c & 15) * 8; *(LDSP u32x4_t*)(Ct + e * 136 + d) = cr[i]; }
        gt[q_tid] = gv;
        bf16x8_t qf[4];
#pragma unroll
        for (int ks = 0; ks < 4; ++ks) qf[ks] = qn[ks];
        const float mprev = mprev_n;
        __syncthreads();
        asm volatile("" : "+v"(qf[0]), "+v"(qf[1]), "+v"(qf[2]), "+v"(qf[3]));
        if (uprev >= 0) ML3_FLUSH();
        u32x2_t ogq[8], mcq[8];
#pragma unroll
        for (int et = 0; et < 8; ++et) { const int c = h * 128 + et * 16 + 4 * g; ogq[et] = *(const u32x2_t*)(P + (size_t)(tok0 + i0 + r) * NPP + C_MO + c); mcq[et] = *(const u32x2_t*)(MC + (size_t)(tok0 + i0 + r) * MIXW + c); }
        if (u + (int)gridDim.x < (T / 128) * 4) { ml3_load(MK, MV, MLC, GT, MLN, u + gridDim.x, q_tid, kr, vr, cr, gv); ML3_QLOAD(u + gridDim.x); mprev_n = MLS[ML3_SB(u + gridDim.x) * 4 + 2]; }
        const float cum_i = gt[i0 + r], mq = cum_i + fmaxf(mprev, gt[256 + i0 + r]), inter = __expf(cum_i + mprev - mq);
        const int ntile = q_wave + 1, nt2 = (ntile + 1) & ~1;
        float den = 0.f;
        for (int jt = 0; jt < nt2; ++jt) { f32x4_t a = (f32x4_t){0.f, 0.f, 0.f, 0.f};
            if (jt < ntile) {
#pragma unroll
                for (int ks = 0; ks < 4; ++ks) a = mma(a, frag_row(Ks, 136, jt * 16, 32 * ks, r, g), qf[ks]); }
            float sv[4];
#pragma unroll
            for (int ii = 0; ii < 4; ++ii) { const int sj = jt * 16 + 4 * g + ii; sv[ii] = sj <= i0 + r ? a[ii] * __expf(cum_i - gt[sj] + gt[128 + sj] - mq) : 0.f; den += sv[ii]; }
            *(LDSP u32x2_t*)(Sw + r * 136 + jt * 16 + 4 * g) = (u32x2_t){pk2(sv[0], sv[1]), pk2(sv[2], sv[3])}; }
        f32x4_t o[8];
#pragma unroll
        for (int et = 0; et < 8; ++et) o[et] = (f32x4_t){0.f, 0.f, 0.f, 0.f};
        for (int j0 = 0; j0 < nt2 * 16; j0 += 32) { const bf16x8_t sy = frag_row(Sw, 136, 0, j0, r, g);
#pragma unroll
            for (int et = 0; et < 8; ++et) o[et] = mma(o[et], frag_tr(Vs, 136, j0, et * 16, r, g), sy); }
        float qn = 0.f;
#pragma unroll
        for (int ks = 0; ks < 4; ++ks) { float f[8]; unpack8u(__builtin_bit_cast(u32x4_t, qf[ks]), f);
#pragma unroll
            for (int jj = 0; jj < 8; ++jj) qn += f[jj] * gt[384 + 32 * ks + 8 * g + jj];
            qf[ks] = scale_frag(qf[ks], inter); }
#pragma unroll
        for (int et = 0; et < 8; ++et)
#pragma unroll
            for (int ks = 0; ks < 4; ++ks) o[et] = mma(o[et], frag_row(Ct, 136, et * 16, 32 * ks, r, g), qf[ks]);
        den += inter * qn; den += __shfl_xor(den, 16); den += __shfl_xor(den, 32);
        const float dinv = 1.0f / fmaxf(fabsf(den), __expf(-mq));
        float s1 = 0.f;
#pragma unroll
        for (int et = 0; et < 8; ++et) { o[et] *= dinv; s1 += (o[et][0] + o[et][1]) + (o[et][2] + o[et][3]); }
        s1 += __shfl_xor(s1, 16); s1 += __shfl_xor(s1, 32);
        const float mu = s1 * (1.0f / 128.0f); float s2 = 0.f;
#pragma unroll
        for (int et = 0; et < 8; ++et) { o[et] -= mu; s2 += (o[et][0] * o[et][0] + o[et][1] * o[et][1]) + (o[et][2] * o[et][2] + o[et][3] * o[et][3]); }
        s2 += __shfl_xor(s2, 16); s2 += __shfl_xor(s2, 32);
        const float rstd = rsqrtf(s2 * (1.0f / 128.0f) + LN_EPS);
        const size_t tok = (size_t)(tok0 + i0 + r);
#pragma unroll
        for (int et = 0; et < 8; ++et) { const int c = h * 128 + et * 16 + 4 * g; const f32x4_t gn_ = *(const LDSP f32x4_t*)(gw + c), sk_ = *(const LDSP f32x4_t*)(gw + 512 + c); const float4 gn = make_float4(gn_[0], gn_[1], gn_[2], gn_[3]), sk = make_float4(sk_[0], sk_[1], sk_[2], sk_[3]); const float4 og = make_float4(__uint_as_float(ogq[et].x << 16), __uint_as_float(ogq[et].x & 0xffff0000u), __uint_as_float(ogq[et].y << 16), __uint_as_float(ogq[et].y & 0xffff0000u)), mc = make_float4(__uint_as_float(mcq[et].x << 16), __uint_as_float(mcq[et].x & 0xffff0000u), __uint_as_float(mcq[et].y << 16), __uint_as_float(mcq[et].y & 0xffff0000u));
            *(LDSP u32x2_t*)(Sw + r * 136 + et * 16 + 4 * g) = (u32x2_t){pk2(sigmoidf_(og.x) * (o[et][0] * rstd * gn.x + sk.x * mc.x), sigmoidf_(og.y) * (o[et][1] * rstd * gn.y + sk.y * mc.y)), pk2(sigmoidf_(og.z) * (o[et][2] * rstd * gn.z + sk.z * mc.z), sigmoidf_(og.w) * (o[et][3] * rstd * gn.w + sk.w * mc.w))}; }
        uprev = u;
    }
    if (uprev >= 0) ML3_FLUSH();
#undef ML3_FLUSH
}


constexpr size_t DO_ATT = 0;
struct AttU { size_t tokb; int grp, h, dil, rr, nb; };
__device__ __forceinline__ AttU att_decode(int u) { AttU a; a.grp = u >> 10; const int v = u & 1023, blk = v >> 2, b = blk >> 7, bi = blk & 127; a.h = v & 3;
    a.dil = a.grp == 0 ? 1 : (a.grp == 1 ? 4 : 16); a.rr = bi % a.dil; a.nb = bi / a.dil; a.tokb = (size_t)b * SEQ; return a; }
__device__ __forceinline__ void att_load(const bf16_t* P, const AttU& a, int q_tid, u32x4_t (&kreg)[4], u32x4_t (&vreg)[8]) {
#pragma unroll
    for (int i = 0; i < 4; ++i) { const int c = q_tid + i * NTHR, j = c >> 3, cc = c & 7, u0 = (a.nb - 1) * 128 + j, uu = u0 < 0 ? u0 + 128 : u0;
        kreg[i] = *(const u32x4_t*)(P + (a.tokb + (size_t)uu * a.dil + a.rr) * NPP + C_AK + a.grp * 256 + a.h * 64 + cc * 8); }
#pragma unroll
    for (int i = 0; i < 8; ++i) { const int c = q_tid + i * NTHR, j = c >> 4, cc = c & 15, u0 = (a.nb - 1) * 128 + j, uu = u0 < 0 ? u0 + 128 : u0;
        vreg[i] = *(const u32x4_t*)(P + (a.tokb + (size_t)uu * a.dil + a.rr) * NPP + C_AV + a.grp * 512 + a.h * 128 + cc * 8); }
}
__device__ __forceinline__ void ph_att(const Params& p, int q_wave, int l, float* lds) {
    PH_PROLOGUE
    LDSP bf16_t* Ks = (LDSP bf16_t*)lds; LDSP bf16_t* Vs = Ks + 256 * 72; LDSP bf16_t* Pw = Vs + 272 * 136 + q_wave * (16 * 168);
    const bf16_t* P = (const bf16_t*)(q_ws + WS_P); bf16_t* ATT = (bf16_t*)((char*)q_out + DO_ATT); float* LSE = (float*)(q_ws + WS_LSE);
    const int lane = q_tid & 63, r = lane & 15, g = lane >> 4, i0 = q_wave * 16;
    __syncthreads();
    if (q_tid < 256) *(LDSP u32x4_t*)(Vs + (256 + (q_tid >> 4)) * 136 + (q_tid & 15) * 8) = (u32x4_t){0u, 0u, 0u, 0u};
    u32x4_t kreg[4], vreg[8]; bf16x8_t qn[2];
#define ATT_QLOAD(a_) do { const bf16_t* qr_ = P + ((a_).tokb + (size_t)((a_).nb * 128 + i0 + r) * (a_).dil + (a_).rr) * NPP + C_AQ + (a_).grp * 256 + (a_).h * 64 + 8 * g; qn[0] = ldnt_b8(qr_); qn[1] = ldnt_b8(qr_ + 32); } while (0)
    if (q_bid < 3072) { const AttU a0 = att_decode(q_bid); att_load(P, a0, q_tid, kreg, vreg); ATT_QLOAD(a0); }
    float lse_prev = 0.f; int uprev = -1;
#define ATT_FLUSH() do { const AttU ap = att_decode(uprev); _Pragma("unroll") for (int k = 0; k < 4; ++k) { const int rw = (lane >> 4) + 4 * k, ck = lane & 15; \
            const size_t tk = ap.tokb + (size_t)(ap.nb * 128 + i0 + rw) * ap.dil + ap.rr; \
            *(u32x4_t*)(ATT + ((size_t)ap.grp * T + tk) * MIXW + ap.h * 128 + ck * 8) = *(const LDSP u32x4_t*)(Pw + rw * 168 + ck * 8); } \
        if (g == 0) LSE[((size_t)ap.grp * T + ap.tokb + (size_t)(ap.nb * 128 + i0 + r) * ap.dil + ap.rr) * 4 + ap.h] = lse_prev; } while (0)
    for (int u = q_bid; u < 3072; u += gridDim.x) {
        const AttU a = att_decode(u); const int grp = a.grp, h = a.h, dil = a.dil, nb = a.nb;
        const float slope = exp2f(-8.0f * (float)(grp * 4 + h + 1) / 12.0f) * (float)dil;
        __syncthreads();
#pragma unroll
        for (int i = 0; i < 4; ++i) { const int c = q_tid + i * NTHR; *(LDSP u32x4_t*)(Ks + (c >> 3) * 72 + (c & 7) * 8) = kreg[i]; }
#pragma unroll
        for (int i = 0; i < 8; ++i) { const int c = q_tid + i * NTHR; *(LDSP u32x4_t*)(Vs + (c >> 4) * 136 + (c & 15) * 8) = vreg[i]; }
        const size_t tokq = a.tokb + (size_t)(nb * 128 + i0 + r) * dil + a.rr;
        bf16x8_t qf[2]; qf[0] = qn[0]; qf[1] = qn[1];
        __syncthreads();
        asm volatile("" : "+v"(qf[0]), "+v"(qf[1]));
        if (uprev >= 0) ATT_FLUSH();
        if (u + (int)gridDim.x < 3072) { const AttU an = att_decode(u + gridDim.x); att_load(P, an, q_tid, kreg, vreg); ATT_QLOAD(an); }
        f32x4_t sc[9]; float mx = -INFINITY;
#pragma unroll
        for (int tt = 0; tt < 9; ++tt) { f32x4_t a4 = (f32x4_t){0.f, 0.f, 0.f, 0.f}; const int j0 = (q_wave + tt) * 16;
            a4 = mma(a4, frag_row(Ks, 72, j0, 0, r, g), qf[0]); a4 = mma(a4, frag_row(Ks, 72, j0, 32, r, g), qf[1]);
#pragma unroll
            for (int ii = 0; ii < 4; ++ii) { const int delta = r + 128 - 16 * tt - 4 * g - ii, j = j0 + 4 * g + ii; const bool ok = delta >= 0 && delta <= 128 && (nb > 0 || j >= 128);
                a4[ii] = ok ? a4[ii] * 0.125f - slope * (float)delta : -INFINITY; mx = fmaxf(mx, a4[ii]); }
            sc[tt] = a4; }
        mx = fmaxf(mx, __shfl_xor(mx, 16)); mx = fmaxf(mx, __shfl_xor(mx, 32));
        float ls = 0.f;
#pragma unroll
        for (int tt = 0; tt < 9; ++tt) { float pv[4];
#pragma unroll
            for (int ii = 0; ii < 4; ++ii) { pv[ii] = __expf(sc[tt][ii] - mx); ls += pv[ii]; }
            *(LDSP u32x2_t*)(Pw + r * 168 + tt * 16 + 4 * g) = (u32x2_t){pk2(pv[0], pv[1]), pk2(pv[2], pv[3])}; }
        *(LDSP u32x2_t*)(Pw + r * 168 + 144 + 4 * g) = (u32x2_t){0u, 0u};
        ls += __shfl_xor(ls, 16); ls += __shfl_xor(ls, 32);
        f32x4_t o[8];
#pragma unroll
        for (int et = 0; et < 8; ++et) o[et] = (f32x4_t){0.f, 0.f, 0.f, 0.f};
#pragma unroll
        for (int jj0 = 0; jj0 < 160; jj0 += 32) { const bf16x8_t sy = frag_row(Pw, 168, 0, jj0, r, g);
#pragma unroll
            for (int et = 0; et < 8; ++et) o[et] = mma(o[et], frag_tr(Vs, 136, i0 + jj0, et * 16, r, g), sy); }
        const float inv = 1.0f / ls;
#pragma unroll
        for (int et = 0; et < 8; ++et) *(LDSP u32x2_t*)(Pw + r * 168 + et * 16 + 4 * g) = (u32x2_t){pk2(o[et][0] * inv, o[et][1] * inv), pk2(o[et][2] * inv, o[et][3] * inv)};
        lse_prev = mx + __logf(ls); uprev = u;
    }
    if (uprev >= 0) ATT_FLUSH();
#undef ATT_FLUSH
#undef ATT_QLOAD
}
__device__ __forceinline__ void ph_att_combine(const Params& p, int q_wave, int l) {
    PH_PROLOGUE
    const bf16_t* ATT = (const bf16_t*)((char*)q_out + DO_ATT); const float* LSE = (const float*)(q_ws + WS_LSE); bf16_t* YA = (bf16_t*)((char*)q_out + DO_YA);
    const size_t step = (size_t)gridDim.x * NTHR;
    for (size_t i0 = (size_t)q_bid * NTHR + q_tid; i0 < (size_t)T * 64; i0 += 4 * step) {
        u32x4_t qa[4], qb[4], qc[4]; float l0[4], l1[4], l2[4];
#pragma unroll
        for (int j = 0; j < 4; ++j) { const size_t i = i0 + j * step < (size_t)T * 64 ? i0 + j * step : i0; const size_t tok = i >> 6; const int c8 = (int)(i & 63) * 8, h = c8 >> 7;
            l0[j] = LSE[tok * 4 + h]; l1[j] = LSE[((size_t)T + tok) * 4 + h]; l2[j] = LSE[((size_t)2 * T + tok) * 4 + h];
            qa[j] = ldnt_u4(ATT + tok * MIXW + c8); qb[j] = ldnt_u4(ATT + ((size_t)T + tok) * MIXW + c8); qc[j] = ldnt_u4(ATT + ((size_t)2 * T + tok) * MIXW + c8); }
        asm volatile("" ::: "memory");
#pragma unroll
        for (int j = 0; j < 4; ++j) { const size_t i = i0 + j * step; if (i < (size_t)T * 64) { const size_t tok = i >> 6; const int c8 = (int)(i & 63) * 8;
            const float m = fmaxf(l0[j], fmaxf(l1[j], l2[j])), e0 = __expf(l0[j] - m), e1 = __expf(l1[j] - m), e2 = __expf(l2[j] - m), inv = 1.0f / (e0 + e1 + e2);
            float a[8], b8[8], c[8]; unpack8u(qa[j], a); unpack8u(qb[j], b8); unpack8u(qc[j], c);
#pragma unroll
            for (int jj = 0; jj < 8; ++jj) a[jj] = (a[jj] * e0 + b8[jj] * e1 + c[jj] * e2) * inv;
            *(u32x4_t*)(YA + tok * MIXW + c8) = pack8u(a); } }
    }
}


__device__ __forceinline__ void ln_row(float4 (&v)[4], const float* g, const float* b, int lane) {
    float s = 0.f;
#pragma unroll
    for (int i = 0; i < 4; ++i) s += (v[i].x + v[i].y) + (v[i].z + v[i].w);
    const float mu = wsum(s) * (1.0f / D); float q = 0.f;
#pragma unroll
    for (int i = 0; i < 4; ++i) { v[i].x -= mu; v[i].y -= mu; v[i].z -= mu; v[i].w -= mu; q += (v[i].x * v[i].x + v[i].y * v[i].y) + (v[i].z * v[i].z + v[i].w * v[i].w); }
    const float rstd = rsqrtf(wsum(q) * (1.0f / D) + LN_EPS);
#pragma unroll
    for (int i = 0; i < 4; ++i) { const float4 gg = *(const float4*)(g + RC(i)), bb = *(const float4*)(b + RC(i));
        v[i].x = v[i].x * rstd * gg.x + bb.x; v[i].y = v[i].y * rstd * gg.y + bb.y; v[i].z = v[i].z * rstd * gg.z + bb.z; v[i].w = v[i].w * rstd * gg.w + bb.w; }
}

__device__ __forceinline__ void ph_ln1_router(const Params& p, int q_wave, int l, float* lds) {
    PH_PROLOGUE
    float* X = (float*)(q_ws + WS_X); bf16_t* XB = (bf16_t*)(q_ws + WS_XB); unsigned char* XB8 = (unsigned char*)(q_ws + WS_XB8);
    const float* g1 = p.in[14] + l * D; const float* b1 = p.in[15] + l * D;
    const float* wr = p.in[16] + (size_t)l * D * NE; const float* br = p.in[17] + l * NE;
    int* topi = (int*)(q_ws + WS_TOPI); float* topp = (float*)(q_ws + WS_TOPP);
    unsigned* ctl = (unsigned*)(q_ws + WS_CTL);
    const int lane = q_tid & 63, wv = q_tid >> 6;
    LDSP float* ybuf = (LDSP float*)lds + wv * (4 * D);
    LDSP unsigned* cnt = (LDSP unsigned*)((LDSP float*)lds + 8 * 4 * D);
    for (int ch = q_bid; ch < T / 128; ch += gridDim.x) {
        if (q_tid < NE) cnt[q_tid] = 0u;
        __syncthreads();
        float4 nx[4];
#pragma unroll
        for (int i = 0; i < 4; ++i) nx[i] = ldnt_f4(X + (size_t)(ch * 128 + wv * 16) * D + RC(i));
        int tprev = -1, gprev = -1; u32x4_t hb[2] = {}; u32x2_t h8[2] = {}; int4 pti[4] = {}; float4 ptp[4] = {};
#define LN1_FLUSH() do { if (tprev >= 0) { _Pragma("unroll") for (int c = 0; c < 2; ++c) { *(u32x4_t*)(XB + (size_t)tprev * D + c * 512 + lane * 8) = hb[c]; *(u32x2_t*)(XB8 + (size_t)tprev * D + c * 512 + lane * 8) = h8[c]; } tprev = -1; } \
            if (gprev >= 0) { if (lane == 0) { _Pragma("unroll") for (int t4 = 0; t4 < 4; ++t4) { *(int4*)(topi + (size_t)(gprev + t4) * 4) = pti[t4]; *(float4*)(topp + (size_t)(gprev + t4) * 4) = ptp[t4]; } } gprev = -1; } } while (0)
        for (int grp = 0; grp < 4; ++grp) {
#pragma unroll
            for (int tt = 0; tt < 4; ++tt) {
                const int it = grp * 4 + tt, tok = ch * 128 + wv * 16 + it;
                float4 v[4];
#pragma unroll
                for (int i = 0; i < 4; ++i) v[i] = nx[i];
                asm volatile("" : "+v"(v[0].x), "+v"(v[1].x), "+v"(v[2].x), "+v"(v[3].x) :: "memory");
                LN1_FLUSH();
                if (it < 15) {
#pragma unroll
                    for (int i = 0; i < 4; ++i) nx[i] = ldnt_f4(X + (size_t)(tok + 1) * D + RC(i)); }
                ln_row(v, g1, b1, lane);
#pragma unroll
                for (int i = 0; i < 4; ++i) { const int cb = RC(i), sw = lane & 7;
                    ybuf[((cb + 0) ^ sw) * 4 + tt] = v[i].x; ybuf[((cb + 1) ^ sw) * 4 + tt] = v[i].y; ybuf[((cb + 2) ^ sw) * 4 + tt] = v[i].z; ybuf[((cb + 3) ^ sw) * 4 + tt] = v[i].w; }
#pragma unroll
                for (int c = 0; c < 2; ++c) { const float f8[8] = {v[2 * c].x, v[2 * c].y, v[2 * c].z, v[2 * c].w, v[2 * c + 1].x, v[2 * c + 1].y, v[2 * c + 1].z, v[2 * c + 1].w};
                    hb[c] = pack8u(f8); h8[c] = (u32x2_t){pk4_fp8(f8[0], f8[1], f8[2], f8[3]), pk4_fp8(f8[4], f8[5], f8[6], f8[7])}; }
                tprev = tok;
            }
            const int e = lane & 31, hf = lane >> 5; f32x2_t a01 = (f32x2_t){0.f, 0.f}, a23 = (f32x2_t){0.f, 0.f};
            const float* wp = wr + (size_t)(hf * 512) * NE + e; const LDSP float* yq = ybuf + hf * 512 * 4;
#pragma unroll 8
            for (int c = 0; c < 512; ++c) { const f32x4_t y = *(const LDSP f32x4_t*)(yq + c * 4); const float w = wp[(size_t)(c ^ ((c >> 3) & 7)) * NE];     const f32x2_t w2 = (f32x2_t){w, w};
                a01 = __builtin_elementwise_fma((f32x2_t){y[0], y[1]}, w2, a01); a23 = __builtin_elementwise_fma((f32x2_t){y[2], y[3]}, w2, a23); }
            float lg4[4] = {a01[0], a01[1], a23[0], a23[1]};
#pragma unroll
            for (int tt = 0; tt < 4; ++tt) { const int tok = ch * 128 + wv * 16 + grp * 4 + tt;
                float acc = lg4[tt]; acc += __shfl_xor(acc, 32); acc += br[e];
                float val = lane < 32 ? acc : -INFINITY; float tv[4]; int ti[4];
#pragma unroll
                for (int r = 0; r < 4; ++r) { const float mx = wmax(val); const unsigned long long bal = __ballot(val == mx); const int idx = __ffsll((long long)bal) - 1; tv[r] = mx; ti[r] = idx; if (lane == idx) val = -INFINITY; }
                const float e1 = __expf(tv[1] - tv[0]), e2 = __expf(tv[2] - tv[0]), e3 = __expf(tv[3] - tv[0]), inv = 1.0f / (1.0f + e1 + e2 + e3);
                pti[tt] = make_int4(ti[0], ti[1], ti[2], ti[3]); ptp[tt] = make_float4(inv, e1 * inv, e2 * inv, e3 * inv);
                { const int myti = lane == 0 ? ti[0] : (lane == 1 ? ti[1] : (lane == 2 ? ti[2] : ti[3])); if (lane < 4) __hip_atomic_fetch_add(&cnt[myti], 1u, __ATOMIC_RELAXED, __HIP_MEMORY_SCOPE_WORKGROUP); } }
            gprev = ch * 128 + wv * 16 + grp * 4;
        }
        LN1_FLUSH();
        __syncthreads();
        if (q_tid < NE) ctl[CW_CHCNT + ch * NE + q_tid] = cnt[q_tid];
        __syncthreads();
    }
#undef LN1_FLUSH
}
__device__ __forceinline__ void ph_assign(const Params& p, int q_wave, int l, float* lds) {
    PH_PROLOGUE
    unsigned* ctl = (unsigned*)(q_ws + WS_CTL);
    const int* topi = (const int*)(q_ws + WS_TOPI); const float* topp = (const float*)(q_ws + WS_TOPP);
    int* tokrow = (int*)(q_ws + WS_TOKROW); int* rowtok = (int*)(q_ws + WS_ROWTOK); float* rowp = (float*)(q_ws + WS_ROWP);
    LDSP unsigned* base = (LDSP unsigned*)lds;
    LDSP unsigned* tot = base + 32;
    LDSP unsigned* pst = base + 64;
    LDSP unsigned* red = base + 128;
    for (int ch = q_bid; ch < T / 128; ch += gridDim.x) {
        { const int e = q_tid & 31, part = q_tid >> 5; unsigned before = 0, all = 0;
#pragma unroll
          for (int k = 0; k < 16; ++k) { const int c = part * 16 + k; const unsigned v = ctl[CW_CHCNT + c * NE + e]; all += v; before += c < ch ? v : 0u; }
          red[q_tid] = before; red[512 + q_tid] = all; }
        __syncthreads();
        if (q_tid < NE) { unsigned before = 0, all = 0;
#pragma unroll
          for (int k = 0; k < 16; ++k) { before += red[k * 32 + q_tid]; all += red[512 + k * 32 + q_tid]; }
          base[q_tid] = before; tot[q_tid] = all; }
        __syncthreads();
        if (q_tid == 0) { unsigned s = 0; for (int e = 0; e < NE; ++e) { pst[e] = s; s += (tot[e] + 255u) / 256u * 256u; } pst[NE] = s; }
        __syncthreads();
        if (q_tid < NE) base[q_tid] += pst[q_tid];
        __syncthreads();
        { const int tok = ch * 128 + (q_tid >> 2), k = q_tid & 3; const int e = topi[(size_t)tok * 4 + k];
          const unsigned row = __hip_atomic_fetch_add(&base[e], 1u, __ATOMIC_RELAXED, __HIP_MEMORY_SCOPE_WORKGROUP); tokrow[(size_t)tok * 4 + k] = (int)row; rowtok[row] = tok; rowp[row] = topp[(size_t)tok * 4 + k]; }
        if (ch == 0) {
            for (int e = 0; e < NE; ++e) { const unsigned s = pst[e] + tot[e], en = pst[e + 1]; for (unsigned r = s + q_tid; r < en; r += NTHR) { rowtok[r] = 0; rowp[r] = 0.f; } }
            if (q_tid < NE) { ctl[CW_PSTART + q_tid] = pst[q_tid]; for (unsigned tl = pst[q_tid] / 256u; tl < pst[q_tid + 1] / 256u; ++tl) ctl[CW_TILEE + tl] = q_tid; }
            if (q_tid == 0) ctl[CW_NTILES] = pst[NE] / 256u;
        }
        __syncthreads();
    }
}
__device__ __forceinline__ void ph_ln2(const Params& p, int q_wave, int l, float* lds) {
    PH_PROLOGUE
    LDSP float* wig = (LDSP float*)lds; float* IGF = (float*)(q_ws + WS_IGF); unsigned char* XB8 = (unsigned char*)(q_ws + WS_XB8);
    if (l != DEPTH - 1) { __syncthreads(); stage_wig(p.in[1] + (size_t)(l + 1) * D * DIN, wig, q_tid); __syncthreads(); }
    float* X = (float*)(q_ws + WS_X); bf16_t* XB = (bf16_t*)(q_ws + WS_XB); const bf16_t* Y = (const bf16_t*)(q_ws + WS_Y);
    const int* tokrow = (const int*)(q_ws + WS_TOKROW);
    const float* g2 = p.in[24] + l * D; const float* b2 = p.in[25] + l * D;
    const int lane = q_tid & 63, wv = q_tid >> 6;
    const int tstep = gridDim.x * 8; int tok = q_bid * 8 + wv;
    int4 r1 = make_int4(0, 0, 0, 0); u32x4_t xq[2], yq[2][4];
    const bool y8 = l == DEPTH - 1;
#define LN2_LOAD(t_, r_) do { const int rr_[4] = {(r_).x, (r_).y, (r_).z, (r_).w}; _Pragma("unroll") for (int c = 0; c < 2; ++c) { xq[c] = ldnt_u4(XB + (size_t)(t_) * D + c * 512 + lane * 8); \
        _Pragma("unroll") for (int k = 0; k < 4; ++k) { if (y8) { const uint2 t8_ = ldnt_u2((const unsigned char*)Y + (size_t)rr_[k] * D + c * 512 + lane * 8); yq[c][k] = (u32x4_t){t8_.x, t8_.y, 0u, 0u}; } \
            else yq[c][k] = ldnt_u4(Y + (size_t)rr_[k] * D + c * 512 + lane * 8); } } } while (0)
    if (tok < T) { const int4 r0 = *(const int4*)(tokrow + (size_t)tok * 4); if (tok + tstep < T) r1 = *(const int4*)(tokrow + (size_t)(tok + tstep) * 4); LN2_LOAD(tok, r0); }
    int tprev = -1; u32x4_t hb[2] = {}; u32x2_t h8[2] = {}; float hg[8] = {}; f32x4_t ho[4] = {};
#define LN2_FLUSH() do { if (l == DEPTH - 1) { _Pragma("unroll") for (int i = 0; i < 4; ++i) __builtin_nontemporal_store(ho[i], (f32x4_t*)(q_out + (size_t)tprev * D + RC(i))); } \
        else { _Pragma("unroll") for (int c = 0; c < 2; ++c) { *(u32x4_t*)(XB + (size_t)tprev * D + c * 512 + lane * 8) = hb[c]; *(u32x2_t*)(XB8 + (size_t)tprev * D + c * 512 + lane * 8) = h8[c]; } igf_store(hg, IGF, tprev, lane); } } while (0)
    for (; tok < T; tok += tstep) {
        float4 v[4];
#pragma unroll
        for (int c = 0; c < 2; ++c) { float xa[8]; unpack8u(xq[c], xa);
#pragma unroll
            for (int j = 0; j < 8; ++j) xa[j] *= DN_ALPHA;
#pragma unroll
            for (int k = 0; k < 4; ++k) { float ya[8];
                if (y8) { const f32x2_t a0 = __builtin_amdgcn_cvt_pk_f32_fp8((int)yq[c][k][0], false), a1 = __builtin_amdgcn_cvt_pk_f32_fp8((int)yq[c][k][0], true), a2 = __builtin_amdgcn_cvt_pk_f32_fp8((int)yq[c][k][1], false), a3 = __builtin_amdgcn_cvt_pk_f32_fp8((int)yq[c][k][1], true);
                    ya[0] = a0[0] * (1.0f / YSC); ya[1] = a0[1] * (1.0f / YSC); ya[2] = a1[0] * (1.0f / YSC); ya[3] = a1[1] * (1.0f / YSC); ya[4] = a2[0] * (1.0f / YSC); ya[5] = a2[1] * (1.0f / YSC); ya[6] = a3[0] * (1.0f / YSC); ya[7] = a3[1] * (1.0f / YSC); }
                else unpack8u(yq[c][k], ya);
#pragma unroll
                for (int j = 0; j < 8; ++j) xa[j] += ya[j]; }
            v[2 * c] = make_float4(xa[0], xa[1], xa[2], xa[3]); v[2 * c + 1] = make_float4(xa[4], xa[5], xa[6], xa[7]); }
        asm volatile("" : "+v"(v[0].x), "+v"(v[1].x), "+v"(v[2].x), "+v"(v[3].x));
        if (tprev >= 0) LN2_FLUSH();
        if (tok + tstep < T) { const int4 rc = r1; if (tok + 2 * tstep < T) r1 = *(const int4*)(tokrow + (size_t)(tok + 2 * tstep) * 4); LN2_LOAD(tok + tstep, rc); }
        ln_row(v, g2, b2, lane);
        if (l == DEPTH - 1) {
#pragma unroll
            for (int i = 0; i < 4; ++i) ho[i] = (f32x4_t){v[i].x, v[i].y, v[i].z, v[i].w};
        } else {
#pragma unroll
            for (int c = 0; c < 2; ++c) { const float f8[8] = {v[2 * c].x, v[2 * c].y, v[2 * c].z, v[2 * c].w, v[2 * c + 1].x, v[2 * c + 1].y, v[2 * c + 1].z, v[2 * c + 1].w};
                hb[c] = pack8u(f8); h8[c] = (u32x2_t){pk4_fp8(f8[0], f8[1], f8[2], f8[3]), pk4_fp8(f8[4], f8[5], f8[6], f8[7])}; }
            igf_calc(v, wig, lane, hg);
        }
        tprev = tok;
    }
    if (tprev >= 0) LN2_FLUSH();
#undef LN2_FLUSH
#undef LN2_LOAD
}

#define XB_TMO      128
#define XB_XCNT(j)  (256  + 64 * (j))
#define XB_XSUB(j)  (1280 + 64 * (j))
#define XB_XGEN(j)  (2304 + 64 * (j))
#define XB_TOP      3328
#define XB_TOPGEN   3392
#define XCD_BAR_WORDS 3456
#define XB_SPIN_CAP (1u << 22)
#define LAS __attribute__((address_space(3)))
__device__ __forceinline__ unsigned xb_ld(unsigned* p)              { return __hip_atomic_load(p, __ATOMIC_RELAXED, __HIP_MEMORY_SCOPE_AGENT); }
__device__ __forceinline__ unsigned xb_add(unsigned* p, unsigned v) { return __hip_atomic_fetch_add(p, v, __ATOMIC_RELAXED, __HIP_MEMORY_SCOPE_AGENT); }
__device__ __forceinline__ unsigned xb_xcc_id() { return (unsigned)__builtin_amdgcn_s_getreg((3 << 11) | 20) & 0xFu; }
#define XB_SPIN(cond, bar) do { unsigned _sp = 0; while (cond) { __builtin_amdgcn_s_sleep(1); \
    if ((++_sp & 255u) == 0u) { if (xb_ld(&(bar)[XB_TMO])) break; if (_sp > XB_SPIN_CAP) { atomicAdd(&(bar)[XB_TMO], 1u); break; } } } } while (0)
struct XcdBarrier { unsigned* bar; unsigned x; volatile LAS unsigned* st; int wave; };
__device__ __forceinline__ XcdBarrier xcd_barrier_post(unsigned* bar, volatile LAS unsigned* st, int wave) {
    XcdBarrier b; b.bar = bar; b.x = xb_xcc_id(); b.st = st; b.wave = wave;
    if (wave == 0 && lane_id() == 0) (void)xb_add(&bar[XB_XCNT(b.x)], 1u);
    return b;
}
__device__ __forceinline__ void xcd_barrier_complete(unsigned* bar, unsigned x, unsigned& nloc, unsigned& nx) {
    const unsigned G = gridDim.x * gridDim.y * gridDim.z;
    unsigned sum, cnt, mine, sp = 0u;
    for (;;) {
        sum = 0u; cnt = 0u; mine = 0u;
#pragma unroll
        for (unsigned j = 0; j < 16; ++j) { const unsigned c = xb_ld(&bar[XB_XCNT(j)]); sum += c; cnt += (c > 0u) ? 1u : 0u; mine = (j == x) ? c : mine; }
        if (sum == G) break;
        __builtin_amdgcn_s_sleep(1);
        if ((++sp & 255u) == 0u) { if (xb_ld(&bar[XB_TMO])) break; if (sp > XB_SPIN_CAP) { atomicAdd(&bar[XB_TMO], 1u); break; } }
    }
    nloc = mine > 0u ? mine : 1u; nx = cnt > 0u ? cnt : 1u;
}
__device__ __forceinline__ void xcd_barrier(const XcdBarrier& b) {
    asm volatile("s_waitcnt vmcnt(0)" ::: "memory");
    __syncthreads();
    if (b.wave == 0 && lane_id() == 0) {
        unsigned* bar = b.bar;
        __builtin_amdgcn_s_waitcnt(0);
        unsigned nloc = b.st[0], nx = b.st[1];
        if (nloc == 0u) { xcd_barrier_complete(bar, b.x, nloc, nx); b.st[0] = nloc; b.st[1] = nx; }
        const unsigned old = xb_add(&bar[XB_XSUB(b.x)], 1u);
        const unsigned gen = old / nloc;
        if (old + 1u == (gen + 1u) * nloc) {
            __builtin_amdgcn_fence(__ATOMIC_RELEASE, "agent");
            asm volatile("s_waitcnt vmcnt(0)" ::: "memory");
            const unsigned og = xb_add(&bar[XB_TOP], 1u);
            const unsigned tg = og / nx;
            if (og + 1u == (tg + 1u) * nx) xb_add(&bar[XB_TOPGEN], 1u);
            else XB_SPIN(xb_ld(&bar[XB_TOPGEN]) == tg, bar);
            __builtin_amdgcn_fence(__ATOMIC_ACQUIRE, "agent");
            xb_add(&bar[XB_XGEN(b.x)], 1u);
            asm volatile("s_waitcnt vmcnt(0)" ::: "memory");
        } else {
            XB_SPIN(xb_ld(&bar[XB_XGEN(b.x)]) == gen, bar);
            __builtin_amdgcn_fence(__ATOMIC_ACQUIRE, "agent");
            asm volatile("s_waitcnt vmcnt(0)" ::: "memory");
        }
    }
    __syncthreads();
}
constexpr int CW_BAR = 65536;
constexpr int LDS_BYTES = 154112;

__global__ void __launch_bounds__(NTHR, 2) k_mega(Params pk) {
    extern __shared__ __attribute__((aligned(16))) float lds[];
    volatile LAS unsigned* xbw = (volatile LAS unsigned*)((LAS char*)lds + LDS_BYTES - 16);
    const int q_wave = __builtin_amdgcn_readfirstlane((int)(threadIdx.x >> 6));
    if (threadIdx.x == 0) { xbw[0] = 0u; xbw[1] = 0u; xbw[2] = 0u; xbw[3] = 0u; }
    __syncthreads();
    const Params& p = pk;
    (void)xcd_barrier_post((unsigned*)(uni_ptr(pk.ws) + WS_CTL) + CW_BAR, xbw, q_wave);
#define GRID_SYNC() do { XcdBarrier bar_; bar_.bar = (unsigned*)(uni_ptr(pk.ws) + WS_CTL) + CW_BAR; bar_.x = xb_xcc_id(); bar_.st = xbw; bar_.wave = q_wave; xcd_barrier(bar_); } while (0)
#define LAYER_BODY(l) do { \
        if (l == 0) { ph_pre(p, q_wave, l, lds);               GRID_SYNC(); } \
        ph_inproj_mfma(p, q_wave, l, lds);       GRID_SYNC(); \
        ph_ret1(p, q_wave, l, lds); ph_ml1(p, q_wave, l, lds); ph_att(p, q_wave, l, lds);   GRID_SYNC(); \
        ph_ret2(p, q_wave, l); ph_ml2(p, q_wave, l, lds);   GRID_SYNC(); \
        ph_ret3(p, q_wave, l, lds); ph_ml3(p, q_wave, l, lds); ph_att_combine(p, q_wave, l);   GRID_SYNC(); \
        ph_merge_mfma(p, q_wave, l, lds);        GRID_SYNC(); \
        ph_outproj_mfma(p, q_wave, l, lds);      GRID_SYNC(); \
        ph_ln1_router(p, q_wave, l, lds);        GRID_SYNC(); \
        ph_assign(p, q_wave, l, lds); if (l + 1 < DEPTH) ph_prew(p, q_wave, l + 1, lds); ph_mwc_tail(p, q_wave, l, lds);   GRID_SYNC(); \
        ph_moe1_mfma(p, q_wave, l, lds);         GRID_SYNC(); \
        ph_moe2_mfma(p, q_wave, l, lds);         GRID_SYNC(); \
        ph_ln2(p, q_wave, l, lds);               GRID_SYNC(); \
    } while (0)
    LAYER_BODY(0);
    LAYER_BODY(1);
#undef LAYER_BODY
}

}

extern "C" void kernel_launch(void* const* d_in, const int* in_sizes, int n_in, void* d_out, int out_size, void* d_ws, size_t ws_size, hipStream_t stream) {
    if (n_in != 26 || out_size != T * D || ws_size < WS_END) { fprintf(stderr, "kernel_launch: unexpected shapes (n_in %d out %d ws %zu need %zu)\n", n_in, out_size, ws_size, (size_t)WS_END); return; }
    Params p; memset(&p, 0, sizeof(p));
    for (int i = 0; i < 26; ++i) p.in[i] = (const float*)d_in[i];
    p.out = (float*)d_out; p.ws = (char*)d_ws;
    (void)hipMemsetAsync((char*)d_ws + WS_CTL, 0, CTL_BYTES, stream);
    static int grid = 0;
    if (!grid) {
        int dev = 0, cus = 0, per_cu = 0;
        if (hipGetDevice(&dev) != hipSuccess || hipDeviceGetAttribute(&cus, hipDeviceAttributeMultiprocessorCount, dev) != hipSuccess) { fprintf(stderr, "kernel_launch: device query failed\n"); grid = -1; return; }
        (void)hipFuncSetAttribute((const void*)k_mega, hipFuncAttributeMaxDynamicSharedMemorySize, LDS_BYTES);
        if (hipOccupancyMaxActiveBlocksPerMultiprocessor(&per_cu, (const void*)k_mega, NTHR, LDS_BYTES) != hipSuccess || per_cu < 1) { fprintf(stderr, "kernel_launch: occupancy query says %d\n", per_cu); grid = -1; return; }
        grid = cus;
    }
    if (grid < 0) return;
    hipLaunchKernelGGL(k_mega, dim3(grid), dim3(NTHR), LDS_BYTES, stream, p);
}
```

```cpp
#include <hip/hip_runtime.h>
#include <type_traits>
#include <stdint.h>
#include <stdio.h>
#include <string.h>

namespace {
typedef unsigned short bf16_t;
typedef short bf16x8_t __attribute__((ext_vector_type(8)));
typedef short s16x4_t __attribute__((ext_vector_type(4)));
typedef float f32x4_t __attribute__((ext_vector_type(4)));
typedef float f32x2_t __attribute__((ext_vector_type(2)));
typedef unsigned u32x4_t __attribute__((ext_vector_type(4)));
typedef unsigned u32x2_t __attribute__((ext_vector_type(2)));
#define LDSP __attribute__((address_space(3)))
constexpr int D = 1024, BATCH = 2, SEQ = 16384, T = BATCH * SEQ, DEPTH = 2;
constexpr int MIXW = 512, DIN = 8712, NP = 8704, NPP = 5632;
constexpr int C_RQ = 0, C_RK = 256, C_RV = 512, C_RG = 1024, C_MX = 1536, C_MO = 2048, C_AQ = 2560, C_AK = 3328, C_AV = 4096, C_GT = 5632;
constexpr int NE = 32, TOPK = 4, RMAX = 139264  , MAXTILES = 544;
constexpr float DN_ALPHA = 1.41421356237f, LN_EPS = 1e-5f, SWI_LIMIT = 7.0f, SWI_ALPHA = 1.702f;
constexpr int NTHR = 512;
#define RC(i) ((((i) >> 1) * 512) + lane * 8 + (((i) & 1) * 4))
constexpr float WSC_IN = 32.0f;

constexpr size_t MiB = 1u << 20;
constexpr size_t WS_CTL = 0, CTL_BYTES = 1 * MiB;
constexpr size_t WS_P = WS_CTL + CTL_BYTES;
constexpr size_t P_BYTES = (size_t)T * NP * 2;
constexpr size_t WS_H = WS_P, WS_Y = WS_P + (size_t)RMAX * D * 2;
constexpr size_t WS_G = WS_P + (size_t)T * NPP * 2;
constexpr size_t WS_B = WS_P + P_BYTES;
constexpr size_t B_BYTES = (size_t)NE * 3 * D * D * 2;
constexpr size_t WS_S = WS_B;
constexpr size_t WS_MLC = WS_B + 32 * MiB, WS_MQ = WS_B + 96 * MiB, WS_MK = WS_B + 128 * MiB, WS_MV = WS_B + 160 * MiB;
constexpr size_t WS_X = WS_B + B_BYTES;
constexpr size_t WS_XB = WS_X + (size_t)T * D * 4;
constexpr size_t WS_YR = WS_X, WS_YM = WS_X + (size_t)T * MIXW * 2;
constexpr size_t WS_IGF = WS_XB + (size_t)T * D * 2;
constexpr size_t WS_TOPI = WS_IGF + (size_t)T * 8 * 4;
constexpr size_t WS_TOPP = WS_TOPI + (size_t)T * 4 * 4;
constexpr size_t WS_TOKROW = WS_TOPP + (size_t)T * 4 * 4;
constexpr size_t WS_ROWTOK = WS_TOKROW + (size_t)T * 4 * 4;
constexpr size_t WS_ROWP = WS_ROWTOK + (size_t)RMAX * 4;
constexpr size_t WS_WIN = WS_ROWP + (size_t)RMAX * 4;
constexpr size_t WS_WBT = WS_WIN + (size_t)NP * D * 2;
constexpr size_t WS_WOT = WS_WBT + (size_t)3 * D * MIXW * 2;
constexpr size_t WS_MC = WS_WOT + (size_t)D * D * 2;
constexpr size_t WS_MLN = WS_MC + (size_t)T * MIXW * 2;
constexpr size_t WS_MLS = WS_MLN + (size_t)128 * 8 * 128 * 4;
constexpr size_t WS_LSE = WS_MLS + (size_t)128 * 8 * 4 * 4;
constexpr size_t WS_XB8 = WS_LSE + (size_t)3 * T * 4 * 4;
constexpr size_t WS_GT = WS_XB8 + (size_t)T * D;
constexpr size_t WS_END = WS_GT + (size_t)256 * 4 * 384 * 4;
constexpr size_t DO_MG = 0;
constexpr size_t DO_YA = 3 * (size_t)T * MIXW * 2;
constexpr int CW_CHCNT = 1024;
constexpr int CW_PSTART = 16384;
constexpr int CW_NTILES = 16500;
constexpr int CW_TILEE = 16640;

struct Params {
    const float* in[26];
    float* out;
    char* ws;
};

__device__ __forceinline__ int lane_id() { return (int)__builtin_amdgcn_mbcnt_hi(~0u, __builtin_amdgcn_mbcnt_lo(~0u, 0u)); }
__device__ __forceinline__ int tid_of(int q_wave) { int t = q_wave * 64 + lane_id(); asm volatile("" : "+v"(t)); return t; }
__device__ __forceinline__ float4 ldnt_f4(const float* p) { const f32x4_t v = __builtin_nontemporal_load((const f32x4_t*)p); return make_float4(v[0], v[1], v[2], v[3]); }
__device__ __forceinline__ uint2 ldnt_u2(const void* p) { const u32x2_t v = __builtin_nontemporal_load((const u32x2_t*)p); return make_uint2(v[0], v[1]); }
__device__ __forceinline__ u32x4_t ldnt_u4(const void* p) { return __builtin_nontemporal_load((const u32x4_t*)p); }
__device__ __forceinline__ bf16x8_t ldnt_b8(const bf16_t* p) { return __builtin_nontemporal_load((const bf16x8_t*)p); }
__device__ __forceinline__ float4 ldnt_bf4(const bf16_t* p) { const u32x2_t u = __builtin_nontemporal_load((const u32x2_t*)p); return make_float4(__uint_as_float(u[0] << 16), __uint_as_float(u[0] & 0xffff0000u), __uint_as_float(u[1] << 16), __uint_as_float(u[1] & 0xffff0000u)); }
__device__ __forceinline__ float bf2f(bf16_t b) { return __uint_as_float(((unsigned)b) << 16); }
__device__ __forceinline__ unsigned cvtpk_bf16(float lo, float hi) { unsigned r; asm("v_cvt_pk_bf16_f32 %0, %1, %2" : "=v"(r) : "v"(lo), "v"(hi)); return r; }
__device__ __forceinline__ bf16_t f2bf(float f) { unsigned u = __float_as_uint(f); u += 0x7FFFu + ((u >> 16) & 1u); return (bf16_t)(u >> 16); }
__device__ __forceinline__ unsigned pk4_fp8(float a, float b, float c, float d) { int w = 0; w = __builtin_amdgcn_cvt_pk_fp8_f32(a, b, w, false); w = __builtin_amdgcn_cvt_pk_fp8_f32(c, d, w, true); return (unsigned)w; }
__device__ __forceinline__ float sigmoidf_(float x) { return __builtin_amdgcn_rcpf(1.0f + __expf(-x)); }
__device__ __forceinline__ float wsum(float v) {
#pragma unroll
    for (int o = 32; o > 0; o >>= 1) v += __shfl_xor(v, o);
    return v; }
__device__ __forceinline__ float wmax(float v) {
#pragma unroll
    for (int o = 32; o > 0; o >>= 1) v = fmaxf(v, __shfl_xor(v, o));
    return v; }

__device__ __forceinline__ float4 ld_bf4(const bf16_t* p) { const uint2 u = *(const uint2*)p; return make_float4(__uint_as_float(u.x << 16), __uint_as_float(u.x & 0xffff0000u), __uint_as_float(u.y << 16), __uint_as_float(u.y & 0xffff0000u)); }
__device__ __forceinline__ void st_bf4(bf16_t* p, float4 v) { uint2 u; u.x = cvtpk_bf16(v.x, v.y); u.y = cvtpk_bf16(v.z, v.w); *(uint2*)p = u; }

__device__ __forceinline__ char* uni_ptr(const void* p) { const unsigned long long v = (unsigned long long)p; unsigned lo = __builtin_amdgcn_readfirstlane((unsigned)v), hi = __builtin_amdgcn_readfirstlane((unsigned)(v >> 32)); asm volatile("" : "+s"(lo), "+s"(hi)); return (char*)(__attribute__((address_space(1))) char*)(((unsigned long long)hi << 32) | lo); }
#define PH_PROLOGUE int q_tid = tid_of(q_wave), q_bid = blockIdx.x; asm volatile("" : "+s"(q_bid)); char* q_ws = uni_ptr(p.ws); float* q_out = (float*)uni_ptr(p.out);
namespace pg8 {
#define PG8_LAS __attribute__((address_space(3)))
typedef short bf16x8 __attribute__((ext_vector_type(8)));
typedef float f32x4 __attribute__((ext_vector_type(4)));
typedef unsigned u32x4 __attribute__((ext_vector_type(4)));
constexpr int BM = 256, BK = 64, HALF = 128, HTB = HALF * BK * 2, STAGE_BYTES = 8 * HTB, NXCD = 8, WGM = 8;
__device__ __forceinline__ int lds_byte(int r, int c) { const int st = (r >> 4) * 2 + (c >> 5), rr = r & 15, cc = c & 31, ob = rr * 64 + cc * 2; return st * 1024 + (ob ^ (((ob >> 9) & 1) << 5)); }
__device__ __forceinline__ void stage_rc(int b, int& R, int& C) { const int st = b / 1024, sb = b % 1024, swz = sb ^ (((sb >> 9) & 1) << 5); R = (st >> 1) * 16 + swz / 64; C = (st & 1) * 32 + (swz % 64) / 2; }
__device__ __forceinline__ int perm32(int rho) { const int n = rho >> 4, i = rho & 15; return 8 * (i >> 2) + 4 * n + (i & 3); }
__device__ __forceinline__ unsigned cvt_pk_bf16(float lo, float hi) { unsigned r; asm volatile("v_cvt_pk_bf16_f32 %0, %1, %2" : "=v"(r) : "v"(lo), "v"(hi)); return r; }
typedef int i32x4 __attribute__((ext_vector_type(4)));
typedef int i32x8 __attribute__((ext_vector_type(8)));

struct Unit { const char* a0; const char* a1; const char* b0; const char* b1; int row0, col0, aux; };
template <bool GATHER, bool F8, class Epi, class Sched>
__device__ __forceinline__ void gemm_phase(const int tid, PG8_LAS unsigned char* lds, const int K, const int* __restrict__ rowidx, const Sched& S, const Epi& E) {
    const int wid = __builtin_amdgcn_readfirstlane(tid >> 6), lane = tid & 63, wr = wid >> 2, wc = wid & 3, fr = lane & 15, fq = lane >> 4;
    const int nt = K / BK;
    unsigned voffA[2], voffB[2]; int rA[2];
#pragma unroll
    for (int i = 0; i < 2; ++i) { int R, C; stage_rc(tid * 16 + i * 8192, R, C); const int Rb = Epi::PERM ? ((R & ~31) + perm32(R & 31)) : R;
        voffA[i] = GATHER ? (unsigned)(C * 2) : (unsigned)(R * K + C) * 2u; voffB[i] = (unsigned)(Rb * K + C) * 2u; rA[i] = R; }
    const size_t kstep = (size_t)(BK * 2);
    const unsigned ldsw = (unsigned)wid * 1024u;
    const int aoff = lds_byte(wr * 64 + fr, fq * 8), boff = lds_byte(wc * 32 + fr, fq * 8);
#define PG8_SA(b, h) (((b) * 2 + (h)) * HTB)
#define PG8_SB(b, h) ((4 + (b) * 2 + (h)) * HTB)
#define PG8_STAGE(bufoff, gbase, v0, v1) do { \
        __builtin_amdgcn_global_load_lds((const unsigned*)((const char*)(gbase) + (v0)), (PG8_LAS unsigned*)(lds + (bufoff) + ldsw), 16, 0, 0); \
        __builtin_amdgcn_global_load_lds((const unsigned*)((const char*)(gbase) + (v1)), (PG8_LAS unsigned*)(lds + (bufoff) + ldsw + 8192), 16, 0, 0); } while (0)
#define PG8_LDA(dst, b, h) do { _Pragma("unroll") for (int m = 0; m < 4; ++m) { const i32x4 lo_ = *(const PG8_LAS i32x4*)(lds + PG8_SA(b, h) + aoff + m * 2048), hi_ = *(const PG8_LAS i32x4*)(lds + PG8_SA(b, h) + aoff + m * 2048 + 1024); \
        dst[m] = __builtin_shufflevector(lo_, hi_, 0, 1, 2, 3, 4, 5, 6, 7); } } while (0)
#define PG8_LDB(dst, b, h) do { _Pragma("unroll") for (int n = 0; n < 2; ++n) { const i32x4 lo_ = *(const PG8_LAS i32x4*)(lds + PG8_SB(b, h) + boff + n * 2048), hi_ = *(const PG8_LAS i32x4*)(lds + PG8_SB(b, h) + boff + n * 2048 + 1024); \
        dst[n] = __builtin_shufflevector(lo_, hi_, 0, 1, 2, 3, 4, 5, 6, 7); } } while (0)
#define PG8_LO(v) __builtin_bit_cast(bf16x8, (i32x4)__builtin_shufflevector(v, v, 0, 1, 2, 3))
#define PG8_HI(v) __builtin_bit_cast(bf16x8, (i32x4)__builtin_shufflevector(v, v, 4, 5, 6, 7))
#define PG8_MMA(ai, bj, At, Bt) do { __builtin_amdgcn_s_setprio(1); \
        if constexpr (F8) { _Pragma("unroll") for (int m = 0; m < 4; ++m) _Pragma("unroll") for (int n = 0; n < 2; ++n) \
            asm volatile("v_mfma_scale_f32_16x16x128_f8f6f4 %0, %1, %2, %0, %3, %3 op_sel_hi:[0,0,0]" : "+v"(acc[ai][bj][m][n]) : "v"(Bt[n]), "v"(At[m]), "v"(sc1)); } \
        else { _Pragma("unroll") for (int m = 0; m < 4; ++m) _Pragma("unroll") for (int n = 0; n < 2; ++n) { \
            acc[ai][bj][m][n] = __builtin_amdgcn_mfma_f32_16x16x32_bf16(PG8_LO(Bt[n]), PG8_LO(At[m]), acc[ai][bj][m][n], 0, 0, 0); \
            acc[ai][bj][m][n] = __builtin_amdgcn_mfma_f32_16x16x32_bf16(PG8_HI(Bt[n]), PG8_HI(At[m]), acc[ai][bj][m][n], 0, 0, 0); } } \
        __builtin_amdgcn_s_setprio(0); } while (0)
#define PG8_WAIT_V(n) asm volatile("s_waitcnt vmcnt(" #n ")" ::: "memory")
#define PG8_WAIT_L(n) asm volatile("s_waitcnt lgkmcnt(" #n ")" ::: "memory")
#define PG8_BAR __builtin_amdgcn_s_barrier()
#define PG8_SCHED __builtin_amdgcn_sched_barrier(0)
    int sc1 = 0x7f7f7f7f; asm volatile("" : "+v"(sc1));
    Unit cur, nxt; int ui = 0;
    if (!S.next(0, cur)) return;
    f32x4 acc[2][2][4][2];
#pragma unroll
    for (int a = 0; a < 2; ++a)
#pragma unroll
        for (int b = 0; b < 2; ++b)
#pragma unroll
            for (int m = 0; m < 4; ++m)
#pragma unroll
                for (int n = 0; n < 2; ++n) acc[a][b][m][n] = (f32x4){0.f, 0.f, 0.f, 0.f};
    i32x8 At[4], B0[2], B1[2];
    unsigned cA00 = voffA[0], cA01 = voffA[1], cA10 = voffA[0], cA11 = voffA[1], nA00 = voffA[0], nA01 = voffA[1], nA10 = voffA[0], nA11 = voffA[1];
    if (GATHER) { const int* ix = rowidx + cur.row0;
        cA00 = (unsigned)ix[rA[0]] * (unsigned)(K * 2) + voffA[0]; cA01 = (unsigned)ix[rA[1]] * (unsigned)(K * 2) + voffA[1];
        cA10 = (unsigned)ix[128 + rA[0]] * (unsigned)(K * 2) + voffA[0]; cA11 = (unsigned)ix[128 + rA[1]] * (unsigned)(K * 2) + voffA[1]; }
    PG8_STAGE(PG8_SB(0, 0), cur.b0, voffB[0], voffB[1]); PG8_STAGE(PG8_SA(0, 0), cur.a0, cA00, cA01); PG8_STAGE(PG8_SB(0, 1), cur.b1, voffB[0], voffB[1]); PG8_STAGE(PG8_SA(0, 1), cur.a1, cA10, cA11);
    if (wr == 1) PG8_BAR;
    PG8_WAIT_V(4); PG8_BAR;
    PG8_STAGE(PG8_SB(1, 0), cur.b0 + kstep, voffB[0], voffB[1]); PG8_STAGE(PG8_SA(1, 0), cur.a0 + kstep, cA00, cA01); PG8_STAGE(PG8_SB(1, 1), cur.b1 + kstep, voffB[0], voffB[1]);
    PG8_WAIT_V(6); PG8_BAR;
    for (;;) {
        const bool has_next = S.next(ui + 1, nxt);
        if (!has_next) nxt = cur;
        if (GATHER) { const int* ix = rowidx + nxt.row0;
            nA00 = (unsigned)ix[rA[0]] * (unsigned)(K * 2) + voffA[0]; nA01 = (unsigned)ix[rA[1]] * (unsigned)(K * 2) + voffA[1];
            nA10 = (unsigned)ix[128 + rA[0]] * (unsigned)(K * 2) + voffA[0]; nA11 = (unsigned)ix[128 + rA[1]] * (unsigned)(K * 2) + voffA[1]; }
#pragma unroll 1
        for (int t = 0; t < nt; t += 2) {
            const bool last = (t == nt - 2);
            const char* a1h1 = cur.a1 + (size_t)(t + 1) * kstep;
            const char* a2h0 = last ? nxt.a0 : cur.a0 + (size_t)(t + 2) * kstep; const char* a2h1 = last ? nxt.a1 : cur.a1 + (size_t)(t + 2) * kstep;
            const char* b2h0 = last ? nxt.b0 : cur.b0 + (size_t)(t + 2) * kstep; const char* b2h1 = last ? nxt.b1 : cur.b1 + (size_t)(t + 2) * kstep;
            const unsigned x00 = (GATHER && last) ? nA00 : cA00, x01 = (GATHER && last) ? nA01 : cA01, x10 = (GATHER && last) ? nA10 : cA10, x11 = (GATHER && last) ? nA11 : cA11;
            PG8_LDB(B0, 0, 0); PG8_SCHED; PG8_LDA(At, 0, 0); PG8_STAGE(PG8_SA(1, 1), a1h1, cA10, cA11);
            PG8_WAIT_L(8); PG8_BAR; PG8_WAIT_L(0); PG8_MMA(0, 0, At, B0); PG8_BAR; PG8_SCHED;
            PG8_LDB(B1, 0, 1); PG8_STAGE(PG8_SB(0, 0), b2h0, voffB[0], voffB[1]);
            PG8_BAR; PG8_WAIT_L(0); PG8_MMA(0, 1, At, B1); PG8_BAR;
            PG8_LDA(At, 0, 1); PG8_STAGE(PG8_SA(0, 0), a2h0, x00, x01);
            PG8_BAR; PG8_WAIT_L(0); PG8_MMA(1, 0, At, B0); PG8_BAR; PG8_SCHED;
            PG8_STAGE(PG8_SB(0, 1), b2h1, voffB[0], voffB[1]);
            PG8_WAIT_V(6); PG8_BAR; PG8_MMA(1, 1, At, B1); PG8_BAR;
            PG8_LDB(B0, 1, 0); PG8_SCHED; PG8_LDA(At, 1, 0); PG8_STAGE(PG8_SA(0, 1), a2h1, x10, x11);
            PG8_WAIT_L(8); PG8_BAR; PG8_WAIT_L(0); PG8_MMA(0, 0, At, B0); PG8_BAR; PG8_SCHED;
            PG8_LDB(B1, 1, 1); PG8_STAGE(PG8_SB(1, 0), b2h0 + kstep, voffB[0], voffB[1]);
            PG8_BAR; PG8_WAIT_L(0); PG8_MMA(0, 1, At, B1); PG8_BAR;
            PG8_LDA(At, 1, 1); PG8_STAGE(PG8_SA(1, 0), a2h0 + kstep, x00, x01);
            PG8_BAR; PG8_WAIT_L(0); PG8_MMA(1, 0, At, B0); PG8_BAR; PG8_SCHED;
            PG8_STAGE(PG8_SB(1, 1), b2h1 + kstep, voffB[0], voffB[1]);
            PG8_WAIT_V(6); PG8_BAR; PG8_MMA(1, 1, At, B1); PG8_BAR;
        }
        if constexpr (F8) asm volatile("s_nop 15\n\ts_nop 15" ::: "memory");
        E(acc, cur, wr, wc, fr, fq);
        if (!has_next) break;
#pragma unroll
        for (int a = 0; a < 2; ++a)
#pragma unroll
            for (int b = 0; b < 2; ++b)
#pragma unroll
                for (int m = 0; m < 4; ++m)
#pragma unroll
                    for (int n = 0; n < 2; ++n) acc[a][b][m][n] = (f32x4){0.f, 0.f, 0.f, 0.f};
        cur = nxt; cA00 = nA00; cA01 = nA01; cA10 = nA10; cA11 = nA11; ++ui;
    }
    PG8_WAIT_V(0);
    if (wr == 0) PG8_BAR;
    PG8_BAR;
#undef PG8_SA
#undef PG8_SB
#undef PG8_STAGE
#undef PG8_LDA
#undef PG8_LDB
#undef PG8_LO
#undef PG8_HI
#undef PG8_MMA
#undef PG8_WAIT_V
#undef PG8_WAIT_L
#undef PG8_BAR
#undef PG8_SCHED
}
struct GridOrder {
    int nM, nN, nwg, G, c;
    __device__ __forceinline__ bool locate(int i, int& pm, int& pn) const {
        const long L = (long)i * G + c; if (L >= nwg) return false;
        int wgid = (int)L; { const int q = nwg / NXCD, r = nwg % NXCD, xcd = wgid % NXCD, off = wgid / NXCD; wgid = (xcd < r ? xcd * (q + 1) : r * (q + 1) + (xcd - r) * q) + off; }
        const int nig = WGM * nN, gid = wgid / nig, fm = gid * WGM, gsz = (nM - fm) < WGM ? (nM - fm) : WGM;
        pm = fm + ((wgid % nig) % gsz); pn = (wgid % nig) / gsz; return true;
    }
};
}

__device__ __forceinline__ void cvt_load(int q_tid, const float* src, int ldn, float4& va, float4& vb) {
    const int k = q_tid >> 4, n4 = (q_tid & 15) * 4; va = ldnt_f4(src + (size_t)k * ldn + n4); vb = ldnt_f4(src + (size_t)(k + 32) * ldn + n4); }
__device__ __forceinline__ void cvt_tile(int q_tid, LDSP bf16_t* tl, const float4 va, const float4 vb, bf16_t* dst, int K, int k0) {
    __syncthreads();
#pragma unroll
    for (int h = 0; h < 2; ++h) { const int k = (q_tid >> 4) + h * 32, nq = q_tid & 15, n4 = nq * 4; const float4 v = h ? vb : va;
        const int ko = ((((k >> 3) ^ (nq & 7)) << 3) | (k & 7));
        tl[(n4 + 0) * 64 + ko] = f2bf(v.x); tl[(n4 + 1) * 64 + ko] = f2bf(v.y); tl[(n4 + 2) * 64 + ko] = f2bf(v.z); tl[(n4 + 3) * 64 + ko] = f2bf(v.w); }
    __syncthreads();
    { const int n = q_tid >> 3, kc = q_tid & 7; *(u32x4_t*)(dst + (size_t)n * K + k0 + kc * 8) = *(const LDSP u32x4_t*)(tl + n * 64 + ((kc ^ ((n >> 2) & 7)) << 3)); }
}

__device__ __forceinline__ void cvt_tile8(int q_tid, LDSP unsigned char* tl, const float4 va, const float4 vb, unsigned char* dst, int K, int k0, float sc) {
    const int k = q_tid >> 4, nq = q_tid & 15, n4 = nq * 4;
    __syncthreads();
    { const unsigned wa = pk4_fp8(va.x * sc, va.y * sc, va.z * sc, va.w * sc), wb = pk4_fp8(vb.x * sc, vb.y * sc, vb.z * sc, vb.w * sc);
      const int ko = ((((k >> 4) ^ (nq & 3)) << 4) | (k & 15)), ko2 = (((((k + 32) >> 4) ^ (nq & 3)) << 4) | (k & 15));
#pragma unroll
      for (int j = 0; j < 4; ++j) { tl[(n4 + j) * 64 + ko] = (unsigned char)(wa >> (8 * j)); tl[(n4 + j) * 64 + ko2] = (unsigned char)(wb >> (8 * j)); } }
    __syncthreads();
    if (q_tid < 256) { const int n = q_tid >> 2, kc = q_tid & 3; *(u32x4_t*)(dst + (size_t)n * K + k0 + kc * 16) = *(const LDSP u32x4_t*)(tl + n * 64 + ((kc ^ ((n >> 2) & 3)) << 4)); }
}
__device__ __forceinline__ void pre_weights(const Params& p, char* q_ws, int l, float* lds, int q_tid, int q_bid) {
    LDSP bf16_t* tl = (LDSP bf16_t*)lds;
    const float* W = p.in[1] + (size_t)l * D * DIN; const float* WB = p.in[12] + (size_t)l * 3 * MIXW * D; const float* WO = p.in[13] + (size_t)l * D * D;
    bf16_t* WBT = (bf16_t*)(q_ws + WS_WBT); bf16_t* WOT = (bf16_t*)(q_ws + WS_WOT);
    for (int ub = q_bid; ub < 2816; ub += 4 * gridDim.x) {
        float4 va[4], vb[4];
#pragma unroll
        for (int j = 0; j < 4; ++j) { const int u = ub + j * gridDim.x;
            if (u < 2176) { const int n0 = (u >> 4) * 64, kt = u & 15; cvt_load(q_tid, W + n0 + (n0 >= 2048 ? 8 : 0) + (size_t)(kt * 64) * DIN, DIN, va[j], vb[j]); }
            else if (u < 2560) { const int v = u - 2176, br = v >> 7, r = v & 127, n0 = (r >> 3) * 64, kt = r & 7; cvt_load(q_tid, WB + (size_t)br * MIXW * D + n0 + (size_t)(kt * 64) * D, D, va[j], vb[j]); }
            else if (u < 2816) { const int v = u - 2560, n0 = (v >> 4) * 64, kt = v & 15; cvt_load(q_tid, WO + n0 + (size_t)(kt * 64) * D, D, va[j], vb[j]); } }
#pragma unroll
        for (int j = 0; j < 4; ++j) { const int u = ub + j * gridDim.x;
            if (u < 2176) { const int n0 = (u >> 4) * 64, kt = u & 15; cvt_tile8(q_tid, (LDSP unsigned char*)lds, va[j], vb[j], (unsigned char*)(q_ws + WS_WIN) + (size_t)n0 * D, D, kt * 64, WSC_IN); }
            else if (u < 2560) { const int v = u - 2176, br = v >> 7, r = v & 127, n0 = (r >> 3) * 64, kt = r & 7; cvt_tile(q_tid, tl, va[j], vb[j], WBT + (size_t)br * D * MIXW + (size_t)n0 * MIXW, MIXW, kt * 64); }
            else if (u < 2816) { const int v = u - 2560, n0 = (v >> 4) * 64, kt = v & 15; cvt_tile(q_tid, tl, va[j], vb[j], WOT + (size_t)n0 * D, D, kt * 64); } }
    }
    __syncthreads();
}
__device__ __forceinline__ void ph_prew(const Params& p, int q_wave, int l, float* lds) { PH_PROLOGUE pre_weights(p, q_ws, l, lds, q_tid, q_bid); }
__device__ __forceinline__ void stage_wig(const float* W, LDSP float* wig, int q_tid) {
    float4 t[2][2];
#pragma unroll
    for (int j = 0; j < 2; ++j) { const float* src = W + (size_t)(q_tid + j * NTHR) * DIN + 2048; t[j][0] = *(const float4*)src; t[j][1] = *(const float4*)(src + 4); }
#pragma unroll
    for (int j = 0; j < 2; ++j) { const int c = q_tid + j * NTHR; wig[c] = t[j][0].x; wig[1024 + c] = t[j][0].y; wig[2048 + c] = t[j][0].z; wig[3072 + c] = t[j][0].w; wig[4096 + c] = t[j][1].x; wig[5120 + c] = t[j][1].y; wig[6144 + c] = t[j][1].z; wig[7168 + c] = t[j][1].w; }
}
__device__ __forceinline__ void igf_calc(const float4 (&v)[4], const LDSP float* wig, int lane, float (&a8)[8]) {
#pragma unroll
    for (int k = 0; k < 8; ++k) a8[k] = 0.f;
#pragma unroll
    for (int i = 0; i < 4; ++i)
#pragma unroll
        for (int k = 0; k < 8; ++k) { const f32x4_t w = *(const LDSP f32x4_t*)(wig + k * 1024 + RC(i)); a8[k] += v[i].x * w[0] + v[i].y * w[1] + v[i].z * w[2] + v[i].w * w[3]; }
#pragma unroll
    for (int k = 0; k < 8; ++k) a8[k] = wsum(a8[k]);
}
__device__ __forceinline__ void igf_store(const float (&a8)[8], float* IGF, int tok, int lane) {
    if (lane == 0) { *(float4*)(IGF + (size_t)tok * 8) = make_float4(a8[0], a8[1], a8[2], a8[3]); *(float4*)(IGF + (size_t)tok * 8 + 4) = make_float4(a8[4], a8[5], a8[6], a8[7]); }
}
__device__ __forceinline__ void igf_row(const float4 (&v)[4], const LDSP float* wig, float* IGF, int tok, int lane) {
    float a8[8];
#pragma unroll
    for (int k = 0; k < 8; ++k) a8[k] = 0.f;
#pragma unroll
    for (int i = 0; i < 4; ++i)
#pragma unroll
        for (int k = 0; k < 8; ++k) { const f32x4_t w = *(const LDSP f32x4_t*)(wig + k * 1024 + RC(i)); a8[k] += v[i].x * w[0] + v[i].y * w[1] + v[i].z * w[2] + v[i].w * w[3]; }
#pragma unroll
    for (int k = 0; k < 8; ++k) a8[k] = wsum(a8[k]);
    if (lane == 0) { *(float4*)(IGF + (size_t)tok * 8) = make_float4(a8[0], a8[1], a8[2], a8[3]); *(float4*)(IGF + (size_t)tok * 8 + 4) = make_float4(a8[4], a8[5], a8[6], a8[7]); }
}
__device__ __forceinline__ void ph_pre(const Params& p, int q_wave, int l, float* lds) {
    PH_PROLOGUE
    LDSP float* wig = (LDSP float*)lds + 4096;
    stage_wig(p.in[1] + (size_t)l * D * DIN, wig, q_tid);
    pre_weights(p, q_ws, l, lds, q_tid, q_bid);
    __syncthreads();
    const float* X = p.in[0]; unsigned char* XB8 = (unsigned char*)(q_ws + WS_XB8); float* IGF = (float*)(q_ws + WS_IGF);
    const int lane = q_tid & 63, wv = q_tid >> 6;
    float4 v[4], vn[4];
    { const int tok0 = q_bid * 8 + wv;
#pragma unroll
      for (int i = 0; i < 4; ++i) v[i] = ldnt_f4(X + (size_t)tok0 * D + RC(i)); }
    for (int tok = q_bid * 8 + wv; tok < T; tok += gridDim.x * 8) {
        const int tn = tok + gridDim.x * 8 < T ? tok + gridDim.x * 8 : tok;
#pragma unroll
        for (int i = 0; i < 4; ++i) vn[i] = ldnt_f4(X + (size_t)tn * D + RC(i));
#pragma unroll
        for (int i = 0; i < 4; ++i) *(unsigned*)(XB8 + (size_t)tok * D + RC(i)) = pk4_fp8(v[i].x, v[i].y, v[i].z, v[i].w);
        igf_row(v, wig, IGF, tok, lane);
#pragma unroll
        for (int i = 0; i < 4; ++i) v[i] = vn[i];
    }
}

struct EpiStoreBf16 {
    static constexpr bool PERM = true;
    bf16_t* O; bf16_t* G; int ldc; float sc;
    __device__ __forceinline__ void operator()(const pg8::f32x4 (&acc)[2][2][4][2], const pg8::Unit& u, int wr, int wc, int fr, int fq) const {
        const bool gate = u.col0 >= C_GT; const int j = (u.col0 - C_GT) >> 8;
        unsigned char* gt = (unsigned char*)G + ((size_t)((u.row0 >> 8) * 12 + j) << 16) + (size_t)(wr * 4 + wc) * 8192 + (fq * 16 + fr) * 16;
        const int lane = fq * 16 + fr, pr = lane >> 2, pq = lane & 3, srcl = (pq * 16 + pr) * 4;
        bf16_t* prow = O + (size_t)(u.row0 + wr * 64 + pr) * ldc + u.col0 + wc * 32 + 8 * pq;
        if (gate) {
#pragma unroll
            for (int ai = 0; ai < 2; ++ai)
#pragma unroll
                for (int m = 0; m < 4; ++m) { pg8::u32x4 w;
                    { const pg8::f32x4 v0 = acc[ai][0][m][0] * sc, v1 = acc[ai][0][m][1] * sc; w.x = pk4_fp8(v0[0], v0[1], v0[2], v0[3]); w.y = pk4_fp8(v1[0], v1[1], v1[2], v1[3]); }
                    { const pg8::f32x4 v0 = acc[ai][1][m][0] * sc, v1 = acc[ai][1][m][1] * sc; w.z = pk4_fp8(v0[0], v0[1], v0[2], v0[3]); w.w = pk4_fp8(v1[0], v1[1], v1[2], v1[3]); }
                    __builtin_nontemporal_store(w, (pg8::u32x4*)(gt + (ai * 4 + m) * 1024)); }
            return; }
#pragma unroll
        for (int ai = 0; ai < 2; ++ai)
#pragma unroll
            for (int m = 0; m < 4; ++m) {
#pragma unroll
                for (int bj = 0; bj < 2; ++bj) { const pg8::f32x4 v0 = acc[ai][bj][m][0] * sc, v1 = acc[ai][bj][m][1] * sc;
                    pg8::u32x4 w; w.x = pg8::cvt_pk_bf16(v0[0], v0[1]); w.y = pg8::cvt_pk_bf16(v0[2], v0[3]); w.z = pg8::cvt_pk_bf16(v1[0], v1[1]); w.w = pg8::cvt_pk_bf16(v1[2], v1[3]);
                    pg8::u32x4 x; x.x = (unsigned)__builtin_amdgcn_ds_bpermute(srcl, (int)w.x); x.y = (unsigned)__builtin_amdgcn_ds_bpermute(srcl, (int)w.y); x.z = (unsigned)__builtin_amdgcn_ds_bpermute(srcl, (int)w.z); x.w = (unsigned)__builtin_amdgcn_ds_bpermute(srcl, (int)w.w);
                    *(pg8::u32x4*)(prow + (size_t)(ai * 128 + m * 16) * ldc + bj * 128) = x; } }
    }
};
struct SchedGrid {
    pg8::GridOrder g; const char* A; const char* B; int K;
    __device__ __forceinline__ bool next(int i, pg8::Unit& u) const { int pm, pn; if (!g.locate(i, pm, pn)) return false;
        u.a0 = A + (size_t)pm * 256 * K * 2; u.a1 = u.a0 + (size_t)128 * K * 2; u.b0 = B + (size_t)pn * 256 * K * 2; u.b1 = u.b0 + (size_t)128 * K * 2; u.row0 = pm * 256; u.col0 = pn * 256; u.aux = 0; return true; }
};
__device__ __forceinline__ void ph_inproj_mfma(const Params& p, int q_wave, int l, float* lds) {
    PH_PROLOGUE
    SchedGrid S; S.g.nM = T / 256; S.g.nN = NP / 256; S.g.nwg = S.g.nM * S.g.nN; S.g.G = gridDim.x; S.g.c = q_bid; S.A = q_ws + WS_XB8; S.B = q_ws + WS_WIN; S.K = D / 2;
    EpiStoreBf16 E; E.O = (bf16_t*)(q_ws + WS_P); E.ldc = NPP; E.G = (bf16_t*)(q_ws + WS_G); E.sc = 1.0f / WSC_IN;
    pg8::gemm_phase<false, true>(q_tid, (PG8_LAS unsigned char*)lds, D / 2, nullptr, S, E);
}

struct SchedMerge {
    pg8::GridOrder g; const char* Y0; const char* Y1; const char* Y2; const char* B;
    __device__ __forceinline__ bool next(int i, pg8::Unit& u) const { const int j = i / 3, br = i - 3 * j; int pm, pn; if (!g.locate(j, pm, pn)) return false;
        const char* Y = Y0 + (size_t)br * ((size_t)T * MIXW * 2); if (br == 2) Y = Y2;
        u.a0 = Y + (size_t)pm * 256 * MIXW * 2; u.a1 = u.a0 + (size_t)128 * MIXW * 2; u.b0 = B + ((size_t)br * D + (size_t)pn * 256) * MIXW * 2; u.b1 = u.b0 + (size_t)128 * MIXW * 2;
        u.row0 = pm * 256; u.col0 = pn * 256; u.aux = br; return true; }
};
__device__ __forceinline__ void unpack8(const pg8::u32x4 w, float (&f)[8]) {
    f[0] = __uint_as_float(w.x << 16); f[1] = __uint_as_float(w.x & 0xffff0000u); f[2] = __uint_as_float(w.y << 16); f[3] = __uint_as_float(w.y & 0xffff0000u);
    f[4] = __uint_as_float(w.z << 16); f[5] = __uint_as_float(w.z & 0xffff0000u); f[6] = __uint_as_float(w.w << 16); f[7] = __uint_as_float(w.w & 0xffff0000u); }
struct EpiMerge {
    static constexpr bool PERM = true;
    const bf16_t* G; bf16_t* S; bf16_t* MG;
    __device__ __forceinline__ void operator()(const pg8::f32x4 (&acc)[2][2][4][2], const pg8::Unit& u, int wr, int wc, int fr, int fq) const {
        const int row0 = u.row0 + wr * 64 + fr, col0 = u.col0 + wc * 32 + 8 * fq, br = u.aux, pm = u.row0 >> 8, pn = u.col0 >> 8;
        const size_t lo = (size_t)(wr * 4 + wc) * 8192 + (fq * 16 + fr) * 8;
        const unsigned char* gp = (const unsigned char*)G + ((size_t)(pm * 12 + br * 4 + pn) << 16) + (size_t)(wr * 4 + wc) * 8192 + (fq * 16 + fr) * 16; bf16_t* sp = S + ((size_t)(pm * 4 + pn) << 16) + lo; bf16_t* mp = MG + (size_t)row0 * D + col0;
        pg8::u32x4 gq[4], mq[4][2];
#define MERGE_LOAD(k, s) do { gq[s] = __builtin_nontemporal_load((const pg8::u32x4*)(gp + (k) * 1024)); \
            if (br > 0) { mq[s][0] = __builtin_nontemporal_load((const pg8::u32x4*)(sp + (k) * 1024)); mq[s][1] = __builtin_nontemporal_load((const pg8::u32x4*)(sp + (k) * 1024 + 512)); } } while (0)
        MERGE_LOAD(0, 0); MERGE_LOAD(1, 1); MERGE_LOAD(2, 2);
#pragma unroll
        for (int k = 0; k < 8; ++k) { const int ai = k >> 2, m = k & 3, sl = k & 3;
            if (k < 5) { if (((k + 3) & 3) == 0) MERGE_LOAD(k + 3, 0); else if (((k + 3) & 3) == 1) MERGE_LOAD(k + 3, 1); else if (((k + 3) & 3) == 2) MERGE_LOAD(k + 3, 2); else MERGE_LOAD(k + 3, 3); }
            asm volatile("" ::: "memory");
#pragma unroll
            for (int bj = 0; bj < 2; ++bj) { float g[8], o[8]; { const unsigned w0 = bj ? gq[sl].z : gq[sl].x, w1 = bj ? gq[sl].w : gq[sl].y;
                    const f32x2_t a0 = __builtin_amdgcn_cvt_pk_f32_fp8((int)w0, false), a1 = __builtin_amdgcn_cvt_pk_f32_fp8((int)w0, true), a2 = __builtin_amdgcn_cvt_pk_f32_fp8((int)w1, false), a3 = __builtin_amdgcn_cvt_pk_f32_fp8((int)w1, true);
                    g[0] = a0[0]; g[1] = a0[1]; g[2] = a1[0]; g[3] = a1[1]; g[4] = a2[0]; g[5] = a2[1]; g[6] = a3[0]; g[7] = a3[1]; }
                if (br > 0) unpack8(mq[sl][bj], o); else {
#pragma unroll
                    for (int j = 0; j < 8; ++j) o[j] = 0.f; }
                const pg8::f32x4 v0 = acc[ai][bj][m][0], v1 = acc[ai][bj][m][1];
#pragma unroll
                for (int j = 0; j < 4; ++j) { o[j] += sigmoidf_(g[j]) * v0[j]; o[4 + j] += sigmoidf_(g[4 + j]) * v1[j]; }
                pg8::u32x4 w; w.x = pg8::cvt_pk_bf16(o[0], o[1]); w.y = pg8::cvt_pk_bf16(o[2], o[3]); w.z = pg8::cvt_pk_bf16(o[4], o[5]); w.w = pg8::cvt_pk_bf16(o[6], o[7]);
                if (br < 2) *(pg8::u32x4*)(sp + k * 1024 + bj * 512) = w; else *(pg8::u32x4*)(mp + (size_t)(ai * 128 + m * 16) * D + bj * 128) = w; }
            asm volatile("" ::: "memory"); }
#undef MERGE_LOAD
    }
};
__device__ __forceinline__ void ph_merge_mfma(const Params& p, int q_wave, int l, float* lds) {
    PH_PROLOGUE
    SchedMerge S; S.g.nM = T / 256; S.g.nN = D / 256; S.g.nwg = S.g.nM * S.g.nN; S.g.G = gridDim.x; S.g.c = q_bid;
    S.Y0 = q_ws + WS_YR; S.Y1 = q_ws + WS_YM; S.Y2 = (const char*)q_out + DO_YA; S.B = q_ws + WS_WBT;
    EpiMerge E; E.G = (const bf16_t*)(q_ws + WS_G); E.S = (bf16_t*)(q_ws + WS_S); E.MG = (bf16_t*)((char*)q_out + DO_MG);
    pg8::gemm_phase<false, false>(q_tid, (PG8_LAS unsigned char*)lds, MIXW, nullptr, S, E);
}
template <bool RESBF> struct EpiOut {
    static constexpr bool PERM = false;
    const float* XR; const bf16_t* XRB; float* X;
    typedef typename std::conditional<RESBF, u32x2_t, pg8::f32x4>::type raw_t;
    static constexpr int NST = RESBF ? 8 : 4;
    __device__ __forceinline__ raw_t ldraw(size_t o) const { if constexpr (RESBF) return *(const u32x2_t*)(XRB + o); else return __builtin_nontemporal_load((const pg8::f32x4*)(XR + o)); }
    static __device__ __forceinline__ pg8::f32x4 cvres(const raw_t w) { if constexpr (RESBF) return (pg8::f32x4){__uint_as_float(w.x << 16), __uint_as_float(w.x & 0xffff0000u), __uint_as_float(w.y << 16), __uint_as_float(w.y & 0xffff0000u)}; else return w; }
    __device__ __forceinline__ void operator()(const pg8::f32x4 (&acc)[2][2][4][2], const pg8::Unit& u, int wr, int wc, int fr, int fq) const {
        const int row0 = u.row0 + wr * 64 + fr, col0 = u.col0 + wc * 32 + 4 * fq;
        const size_t base = (size_t)row0 * D + col0; float* op = X + base;
        raw_t xq[NST][4];
#define OUT_LOAD(k, s) do { const size_t ro = base + (size_t)(((k) >> 2) * 128 + ((k) & 3) * 16) * D; \
            xq[s][0] = ldraw(ro); xq[s][1] = ldraw(ro + 16); xq[s][2] = ldraw(ro + 128); xq[s][3] = ldraw(ro + 144); } while (0)
#pragma unroll
        for (int k = 0; k < NST - 1; ++k) OUT_LOAD(k, k);
#pragma unroll
        for (int k = 0; k < 8; ++k) { const int ai = k >> 2, m = k & 3, sl = k % NST; const size_t ro = (size_t)(ai * 128 + m * 16) * D;
            if (k + NST - 1 < 8) OUT_LOAD(k + NST - 1, (k + NST - 1) % NST);
            asm volatile("" ::: "memory");
#pragma unroll
            for (int bj = 0; bj < 2; ++bj)
#pragma unroll
                for (int n = 0; n < 2; ++n) *(pg8::f32x4*)(op + ro + bj * 128 + n * 16) = cvres(xq[sl][bj * 2 + n]) * DN_ALPHA + acc[ai][bj][m][n];
            asm volatile("" ::: "memory"); }
#undef OUT_LOAD
    }
};
constexpr float WSC_GU = 32.0f, WSC_DN = 64.0f;
__device__ __forceinline__ void moe_weight_convert(const Params& p, char* q_ws, int l, float* lds, int q_tid, int q_bid, int u_lo, int u_hi) {
    LDSP unsigned char* tl = (LDSP unsigned char*)lds; unsigned char* WM = (unsigned char*)(q_ws + WS_B);
    const int k = q_tid >> 4, nq = q_tid & 15, n4 = nq * 4;
    float4 v[8];
#define MWC_SRC(u_) (p.in[((u_) >> 6) % 3 == 0 ? 18 : (((u_) >> 6) % 3 == 1 ? 20 : 22)] + ((size_t)l * NE + ((u_) >> 6) / 3) * D * D + (size_t)(((u_) & 3) * 256) * D + (((u_) >> 2) & 15) * 64)
#define MWC_LOAD(u_) do { const float* src_ = MWC_SRC(u_) + (size_t)k * D + n4; _Pragma("unroll") for (int i = 0; i < 8; ++i) v[i] = ldnt_f4(src_ + (size_t)(32 * i) * D); } while (0)
    if (u_lo + q_bid < u_hi) MWC_LOAD(u_lo + q_bid);
    for (int u = u_lo + q_bid; u < u_hi; u += gridDim.x) {
        const float sc = ((u >> 6) % 3 == 2) ? WSC_DN : WSC_GU;
        __syncthreads();
#pragma unroll
        for (int i = 0; i < 8; ++i) { const unsigned w = pk4_fp8(v[i].x * sc, v[i].y * sc, v[i].z * sc, v[i].w * sc); const int kk = k + 32 * (i & 1), ko = ((((kk >> 4) ^ (nq & 3)) << 4) | (kk & 15));
#pragma unroll
            for (int j = 0; j < 4; ++j) tl[(i >> 1) * 4096 + (n4 + j) * 64 + ko] = (unsigned char)(w >> (8 * j)); }
        const int un = u + gridDim.x;
        if (un < u_hi) MWC_LOAD(un);
        __syncthreads();
#pragma unroll
        for (int s2 = 0; s2 < 2; ++s2) { const int idx = q_tid + s2 * NTHR, n = idx >> 4, c16 = idx & 15, blk = c16 >> 2, kc = c16 & 3;
            unsigned char* dst = WM + (size_t)(u >> 6) * D * D + (size_t)(((u >> 2) & 15) * 64 + n) * D + (u & 3) * 256 + c16 * 16;
            *(u32x4_t*)dst = *(const LDSP u32x4_t*)(tl + blk * 4096 + n * 64 + ((kc ^ ((n >> 2) & 3)) << 4)); }
    }
#undef MWC_LOAD
#undef MWC_SRC
    __syncthreads();
}
constexpr int MWC_NU = NE * 3 * 64, MWC_SPLIT = MWC_NU * 2 / 3;
__device__ __forceinline__ void ph_outproj_mfma(const Params& p, int q_wave, int l, float* lds) {
    PH_PROLOGUE
    SchedGrid S; S.g.nM = T / 256; S.g.nN = D / 256; S.g.nwg = S.g.nM * S.g.nN; S.g.G = gridDim.x; S.g.c = q_bid; S.A = (const char*)q_out + DO_MG; S.B = q_ws + WS_WOT; S.K = D;
    const bool conv_first = (q_bid >> 3) & 1;
    if (conv_first) moe_weight_convert(p, q_ws, l, lds, q_tid, q_bid, 0, MWC_SPLIT);
    if (l == 0) { EpiOut<false> E; E.XR = p.in[0]; E.XRB = nullptr; E.X = (float*)(q_ws + WS_X); pg8::gemm_phase<false, false>(q_tid, (PG8_LAS unsigned char*)lds, D, nullptr, S, E); }
    else { EpiOut<true> E; E.XR = nullptr; E.XRB = (const bf16_t*)(q_ws + WS_XB); E.X = (float*)(q_ws + WS_X); pg8::gemm_phase<false, false>(q_tid, (PG8_LAS unsigned char*)lds, D, nullptr, S, E); }
    __syncthreads();
    if (!conv_first) moe_weight_convert(p, q_ws, l, lds, q_tid, q_bid, 0, MWC_SPLIT);
}
__device__ __forceinline__ void ph_mwc_tail(const Params& p, int q_wave, int l, float* lds) {
    PH_PROLOGUE
    __syncthreads();
    moe_weight_convert(p, q_ws, l, lds, q_tid, q_bid, MWC_SPLIT, MWC_NU);
}
struct SchedMoe1 {
    const unsigned* ctl; const char* XB8; const char* WM; int nun, G, c;
    __device__ __forceinline__ bool next(int i, pg8::Unit& u) const {
        const int li = i * (G >> 3) + (c >> 3), tile = (li >> 3) * 8 + (c & 7), pn = li & 7; if (tile * 8 >= nun) return false;
        const int e = __builtin_amdgcn_readfirstlane((int)ctl[CW_TILEE + tile]);
        u.a0 = XB8; u.a1 = XB8; u.b0 = WM + ((size_t)(e * 3 + 0) * D + (size_t)pn * 128) * D; u.b1 = WM + ((size_t)(e * 3 + 1) * D + (size_t)pn * 128) * D;
        u.row0 = tile * 256; u.col0 = pn * 128; u.aux = e; return true; }
};
struct EpiMoe1 {
    static constexpr bool PERM = true;
    const float* bg; const float* bu; unsigned char* H;
    __device__ __forceinline__ void operator()(const pg8::f32x4 (&acc)[2][2][4][2], const pg8::Unit& u, int wr, int wc, int fr, int fq) const {
        const int row0 = u.row0 + wr * 64 + fr, col0 = u.col0 + wc * 32 + 8 * fq;
        const pg8::f32x4 g0 = *(const pg8::f32x4*)(bg + u.aux * D + col0), g1 = *(const pg8::f32x4*)(bg + u.aux * D + col0 + 4), u0 = *(const pg8::f32x4*)(bu + u.aux * D + col0), u1 = *(const pg8::f32x4*)(bu + u.aux * D + col0 + 4);
#pragma unroll
        for (int ai = 0; ai < 2; ++ai)
#pragma unroll
            for (int m = 0; m < 4; ++m) { float hh[8];
#pragma unroll
                for (int n = 0; n < 2; ++n) { const pg8::f32x4 gv = acc[ai][0][m][n] * (1.0f / WSC_GU) + (n ? g1 : g0), uv = acc[ai][1][m][n] * (1.0f / WSC_GU) + (n ? u1 : u0);
#pragma unroll
                    for (int j = 0; j < 4; ++j) { const float g = fminf(gv[j], SWI_LIMIT), uu = fminf(fmaxf(uv[j], -SWI_LIMIT), SWI_LIMIT); hh[n * 4 + j] = (uu + 1.0f) * g * sigmoidf_(SWI_ALPHA * g); } }
                *(u32x2_t*)(H + (size_t)(row0 + ai * 128 + m * 16) * D + col0) = (u32x2_t){pk4_fp8(hh[0], hh[1], hh[2], hh[3]), pk4_fp8(hh[4], hh[5], hh[6], hh[7])}; }
    }
};
__device__ __forceinline__ void ph_moe1_mfma(const Params& p, int q_wave, int l, float* lds) {
    PH_PROLOGUE
    const unsigned* ctl = (const unsigned*)(q_ws + WS_CTL);
    SchedMoe1 S; S.ctl = ctl; S.XB8 = q_ws + WS_XB8; S.WM = q_ws + WS_B; S.nun = __builtin_amdgcn_readfirstlane((int)ctl[CW_NTILES]) * 8; S.G = gridDim.x; S.c = q_bid;
    EpiMoe1 E; E.bg = p.in[19] + (size_t)l * NE * D; E.bu = p.in[21] + (size_t)l * NE * D; E.H = (unsigned char*)(q_ws + WS_H);
    pg8::gemm_phase<true, true>(q_tid, (PG8_LAS unsigned char*)lds, D / 2, (const int*)(q_ws + WS_ROWTOK), S, E);
}
struct SchedMoe2 {
    const unsigned* ctl; const char* H; const char* WM; int nun, G, c;
    __device__ __forceinline__ bool next(int i, pg8::Unit& u) const {
        const int li = i * (G >> 3) + (c >> 3), tile = (li >> 2) * 8 + (c & 7), pn = li & 3; if (tile * 4 >= nun) return false;
        const int e = __builtin_amdgcn_readfirstlane((int)ctl[CW_TILEE + tile]);
        u.a0 = H + (size_t)tile * 256 * D; u.a1 = u.a0 + (size_t)128 * D; u.b0 = WM + ((size_t)(e * 3 + 2) * D + (size_t)pn * 256) * D; u.b1 = u.b0 + (size_t)128 * D;
        u.row0 = tile * 256; u.col0 = pn * 256; u.aux = e; return true; }
};
constexpr float YSC = 16.0f;
template <bool Y8> struct EpiMoe2 {
    static constexpr bool PERM = true;
    const float* bd; const float* rowp; bf16_t* Y;
    __device__ __forceinline__ void operator()(const pg8::f32x4 (&acc)[2][2][4][2], const pg8::Unit& u, int wr, int wc, int fr, int fq) const {
        const int row0 = u.row0 + wr * 64 + fr, col0 = u.col0 + wc * 32 + 8 * fq;
        float pr[8]; pg8::f32x4 bb[2][2];
#pragma unroll
        for (int k = 0; k < 8; ++k) pr[k] = rowp[row0 + (k >> 2) * 128 + (k & 3) * 16] * (Y8 ? YSC : 1.0f);
#pragma unroll
        for (int bj = 0; bj < 2; ++bj) { bb[bj][0] = *(const pg8::f32x4*)(bd + u.aux * D + col0 + bj * 128); bb[bj][1] = *(const pg8::f32x4*)(bd + u.aux * D + col0 + bj * 128 + 4); }
#pragma unroll
        for (int ai = 0; ai < 2; ++ai)
#pragma unroll
            for (int m = 0; m < 4; ++m) { const int row = row0 + ai * 128 + m * 16; const float p1 = pr[ai * 4 + m];
#pragma unroll
                for (int bj = 0; bj < 2; ++bj) { const pg8::f32x4 v0 = (acc[ai][bj][m][0] * (1.0f / WSC_DN) + bb[bj][0]) * p1, v1 = (acc[ai][bj][m][1] * (1.0f / WSC_DN) + bb[bj][1]) * p1;
                    if (Y8) *(u32x2_t*)((unsigned char*)Y + (size_t)row * D + col0 + bj * 128) = (u32x2_t){pk4_fp8(v0[0], v0[1], v0[2], v0[3]), pk4_fp8(v1[0], v1[1], v1[2], v1[3])};
                    else { pg8::u32x4 w; w.x = pg8::cvt_pk_bf16(v0[0], v0[1]); w.y = pg8::cvt_pk_bf16(v0[2], v0[3]); w.z = pg8::cvt_pk_bf16(v1[0], v1[1]); w.w = pg8::cvt_pk_bf16(v1[2], v1[3]);
                        *(pg8::u32x4*)(Y + (size_t)row * D + col0 + bj * 128) = w; } } }
    }
};
__device__ __forceinline__ void ph_moe2_mfma(const Params& p, int q_wave, int l, float* lds) {
    PH_PROLOGUE
    const unsigned* ctl = (const unsigned*)(q_ws + WS_CTL);
    SchedMoe2 S; S.ctl = ctl; S.H = q_ws + WS_H; S.WM = q_ws + WS_B; S.nun = __builtin_amdgcn_readfirstlane((int)ctl[CW_NTILES]) * 4; S.G = gridDim.x; S.c = q_bid;
    if (l == DEPTH - 1) { EpiMoe2<true> E; E.bd = p.in[23] + (size_t)l * NE * D; E.rowp = (const float*)(q_ws + WS_ROWP); E.Y = (bf16_t*)(q_ws + WS_Y); pg8::gemm_phase<false, true>(q_tid, (PG8_LAS unsigned char*)lds, D / 2, nullptr, S, E); }
    else { EpiMoe2<false> E; E.bd = p.in[23] + (size_t)l * NE * D; E.rowp = (const float*)(q_ws + WS_ROWP); E.Y = (bf16_t*)(q_ws + WS_Y); pg8::gemm_phase<false, true>(q_tid, (PG8_LAS unsigned char*)lds, D / 2, nullptr, S, E); }
}

__device__ __forceinline__ bf16x8_t frag_row(const LDSP bf16_t* M, int ld, int row0, int k0, int r, int g) { return *(const LDSP bf16x8_t*)(M + (row0 + r) * ld + k0 + 8 * g); }
__device__ __forceinline__ bf16x8_t frag_tr(const LDSP bf16_t* M, int ld, int k0, int n0, int r, int g) {
    const LDSP bf16_t* a = M + (k0 + 8 * g + (r >> 2)) * ld + n0 + 4 * (r & 3);
    const s16x4_t lo = __builtin_amdgcn_ds_read_tr16_b64_v4i16((LDSP s16x4_t*)a), hi = __builtin_amdgcn_ds_read_tr16_b64_v4i16((LDSP s16x4_t*)(a + 4 * ld));
    return (bf16x8_t){lo[0], lo[1], lo[2], lo[3], hi[0], hi[1], hi[2], hi[3]};
}
__device__ __forceinline__ f32x4_t mma(f32x4_t acc, bf16x8_t X, bf16x8_t Y) { return __builtin_amdgcn_mfma_f32_16x16x32_bf16(X, Y, acc, 0, 0, 0); }
__device__ __forceinline__ unsigned pk2(float lo, float hi) { return cvtpk_bf16(lo, hi); }
__device__ __forceinline__ void unpack8u(const u32x4_t w, float (&f)[8]) {
    f[0] = __uint_as_float(w.x << 16); f[1] = __uint_as_float(w.x & 0xffff0000u); f[2] = __uint_as_float(w.y << 16); f[3] = __uint_as_float(w.y & 0xffff0000u);
    f[4] = __uint_as_float(w.z << 16); f[5] = __uint_as_float(w.z & 0xffff0000u); f[6] = __uint_as_float(w.w << 16); f[7] = __uint_as_float(w.w & 0xffff0000u); }
__device__ __forceinline__ u32x4_t pack8u(const float (&f)[8]) { return (u32x4_t){pk2(f[0], f[1]), pk2(f[2], f[3]), pk2(f[4], f[5]), pk2(f[6], f[7])}; }
__device__ __forceinline__ bf16x8_t scale_frag(bf16x8_t q, float s) { const u32x4_t w = __builtin_bit_cast(u32x4_t, q); float f[8]; unpack8u(w, f);
#pragma unroll
    for (int j = 0; j < 8; ++j) f[j] *= s;
    return __builtin_bit_cast(bf16x8_t, pack8u(f)); }

constexpr size_t WS_RKV = WS_B;
__device__ __forceinline__ float ret_lg(int h) { return log1pf(-exp2f(-5.0f - (float)h)); }
__device__ __forceinline__ void ret1_load(const bf16_t* P, int u, int q_tid, u32x4_t (&kr)[2], u32x4_t (&vr)[4]) {
    const int ch = u >> 2, h = u & 3, tok0 = ch * 128;
#pragma unroll
    for (int i = 0; i < 2; ++i) { const int c = q_tid + i * NTHR; kr[i] = *(const u32x4_t*)(P + (size_t)(tok0 + (c >> 3)) * NPP + C_RK + h * 64 + (c & 7) * 8); }
#pragma unroll
    for (int i = 0; i < 4; ++i) { const int c = q_tid + i * NTHR; vr[i] = *(const u32x4_t*)(P + (size_t)(tok0 + (c >> 4)) * NPP + C_RV + h * 128 + (c & 15) * 8); }
}
__device__ __forceinline__ void ph_ret1(const Params& p, int q_wave, int l, float* lds) {
    PH_PROLOGUE
    LDSP bf16_t* Ks = (LDSP bf16_t*)lds; LDSP bf16_t* Vs = Ks + 128 * 72;
    const bf16_t* P = (const bf16_t*)(q_ws + WS_P); bf16_t* RKV = (bf16_t*)(q_ws + WS_RKV);
    const int lane = q_tid & 63, r = lane & 15, g = lane >> 4;
    for (int ub = q_bid; ub < (T / 128) * 4; ub += 4 * gridDim.x) {
    u32x4_t kr4[4][2], vr4[4][4];
#pragma unroll
    for (int s = 0; s < 4; ++s) if (ub + s * (int)gridDim.x < (T / 128) * 4) ret1_load(P, ub + s * gridDim.x, q_tid, kr4[s], vr4[s]);
#pragma unroll
    for (int s = 0; s < 4; ++s) { const int u = ub + s * gridDim.x; if (u >= (T / 128) * 4) break;
        const u32x4_t (&kr)[2] = kr4[s]; const u32x4_t (&vr)[4] = vr4[s];
        const int ch = u >> 2, h = u & 3, b = ch >> 7, n = ch & 127; const float lg = ret_lg(h);
        __syncthreads();
#pragma unroll
        for (int i = 0; i < 2; ++i) { const int c = q_tid + i * NTHR, j = c >> 3; float f[8]; unpack8u(kr[i], f);
            const float sc = __expf(lg * (float)(127 - j)) * 0.125f;
#pragma unroll
            for (int q = 0; q < 8; ++q) f[q] *= sc;
            *(LDSP u32x4_t*)(Ks + j * 72 + (c & 7) * 8) = pack8u(f); }
#pragma unroll
        for (int i = 0; i < 4; ++i) { const int c = q_tid + i * NTHR; *(LDSP u32x4_t*)(Vs + (c >> 4) * 136 + (c & 15) * 8) = vr[i]; }
        __syncthreads();
        f32x4_t acc[4];
#pragma unroll
        for (int dt = 0; dt < 4; ++dt) acc[dt] = (f32x4_t){0.f, 0.f, 0.f, 0.f};
#pragma unroll
        for (int j0 = 0; j0 < 128; j0 += 32) { const bf16x8_t vy = frag_tr(Vs, 136, j0, q_wave * 16, r, g);
#pragma unroll
            for (int dt = 0; dt < 4; ++dt) acc[dt] = mma(acc[dt], frag_tr(Ks, 72, j0, dt * 16, r, g), vy); }
        LDSP float* ob = (LDSP float*)(Vs + 128 * 136) + q_wave * (16 * 68);
#pragma unroll
        for (int dt = 0; dt < 4; ++dt) *(LDSP f32x4_t*)(ob + r * 68 + dt * 16 + 4 * g) = acc[dt];
        bf16_t* dst = RKV + ((((size_t)n * 2 + b) * 4 + h) * 128 + q_wave * 16) * 64;
#pragma unroll
        for (int k = 0; k < 2; ++k) { const int rw = (lane >> 3) + 8 * k, ck = lane & 7; const f32x4_t lo = *(const LDSP f32x4_t*)(ob + rw * 68 + ck * 8), hi = *(const LDSP f32x4_t*)(ob + rw * 68 + ck * 8 + 4);
            *(u32x4_t*)(dst + rw * 64 + ck * 8) = (u32x4_t){pk2(lo[0], lo[1]), pk2(lo[2], lo[3]), pk2(hi[0], hi[1]), pk2(hi[2], hi[3])}; }
    }
    }
}
__device__ __forceinline__ void ph_ret2(const Params& p, int q_wave, int l) {
    PH_PROLOGUE
    bf16_t* RKV = (bf16_t*)(q_ws + WS_RKV);
    for (int idx = q_bid * NTHR + q_tid; idx < 32768; idx += gridDim.x * NTHR) {
        const float cd = __expf(ret_lg((idx >> 12) & 3) * 128.0f); float2 st = make_float2(0.f, 0.f);
#pragma unroll 32
        for (int n = 0; n < 128; ++n) { unsigned* q = (unsigned*)(RKV + (size_t)n * 65536) + idx; const unsigned kv = *q; *q = pk2(st.x, st.y); st.x = cd * st.x + __uint_as_float(kv << 16); st.y = cd * st.y + __uint_as_float(kv & 0xffff0000u); }
    }
}
__device__ __forceinline__ void ret3_load(const bf16_t* P, const bf16_t* RKV, int u, int q_tid, u32x4_t (&kr)[2], u32x4_t (&vr)[4], u32x4_t (&pr)[2]) {
    const int ch = u >> 2, h = u & 3, b = ch >> 7, n = ch & 127, tok0 = ch * 128;
#pragma unroll
    for (int i = 0; i < 2; ++i) { const int c = q_tid + i * NTHR; kr[i] = ldnt_u4(P + (size_t)(tok0 + (c >> 3)) * NPP + C_RK + h * 64 + (c & 7) * 8); }
#pragma unroll
    for (int i = 0; i < 4; ++i) { const int c = q_tid + i * NTHR; vr[i] = ldnt_u4(P + (size_t)(tok0 + (c >> 4)) * NPP + C_RV + h * 128 + (c & 15) * 8); }
    const bf16_t* src = RKV + (((size_t)n * 2 + b) * 4 + h) * 8192;
#pragma unroll
    for (int i = 0; i < 2; ++i) pr[i] = ldnt_u4(src + (q_tid + i * NTHR) * 8);
}
__device__ __forceinline__ void ph_ret3(const Params& p, int q_wave, int l, float* lds) {
    PH_PROLOGUE
    LDSP bf16_t* Ks = (LDSP bf16_t*)lds; LDSP bf16_t* Vs = Ks + 128 * 72; LDSP bf16_t* Pt = Vs + 128 * 136; LDSP bf16_t* Sw = Pt + 128 * 72 + q_wave * (16 * 136);
    const bf16_t* P = (const bf16_t*)(q_ws + WS_P); const bf16_t* RKV = (const bf16_t*)(q_ws + WS_RKV); bf16_t* YR = (bf16_t*)(q_ws + WS_YR);
    const float* rgn = p.in[2] + l * MIXW;
    LDSP float* gw = (LDSP float*)(Pt + 128 * 72 + 8 * 16 * 136);
    __syncthreads(); gw[q_tid] = rgn[q_tid];
    const int lane = q_tid & 63, r = lane & 15, g = lane >> 4, i0 = q_wave * 16;
    u32x4_t kr[2], vr[4], pr[2]; bf16x8_t qn[2];
#define RET3_QLOAD(u_) do { const bf16_t* qr_ = P + (size_t)(((u_) >> 2) * 128 + i0 + r) * NPP + C_RQ + ((u_) & 3) * 64 + 8 * g; qn[0] = ldnt_b8(qr_); qn[1] = ldnt_b8(qr_ + 32); } while (0)
    if (q_bid < (T / 128) * 4) { ret3_load(P, RKV, q_bid, q_tid, kr, vr, pr); RET3_QLOAD(q_bid); }
    int uprev = -1;
#define RET3_FLUSH() do { _Pragma("unroll") for (int k = 0; k < 4; ++k) { const int rw = (lane >> 4) + 4 * k, ck = lane & 15; \
        *(u32x4_t*)(YR + (size_t)((uprev >> 2) * 128 + i0 + rw) * MIXW + (uprev & 3) * 128 + ck * 8) = *(const LDSP u32x4_t*)(Sw + rw * 136 + ck * 8); } } while (0)
    for (int u = q_bid; u < (T / 128) * 4; u += gridDim.x) {
        const int ch = u >> 2, h = u & 3, tok0 = ch * 128; const float lg = ret_lg(h);
        __syncthreads();
#pragma unroll
        for (int i = 0; i < 2; ++i) { const int c = q_tid + i * NTHR; *(LDSP u32x4_t*)(Ks + (c >> 3) * 72 + (c & 7) * 8) = kr[i]; }
#pragma unroll
        for (int i = 0; i < 4; ++i) { const int c = q_tid + i * NTHR; *(LDSP u32x4_t*)(Vs + (c >> 4) * 136 + (c & 15) * 8) = vr[i]; }
#pragma unroll
        for (int i = 0; i < 2; ++i) { const int c = q_tid + i * NTHR, e = c >> 3, d = (c & 7) * 8; *(LDSP u32x4_t*)(Pt + e * 72 + d) = pr[i]; }
        bf16x8_t qf[2]; qf[0] = qn[0]; qf[1] = qn[1];
        __syncthreads();
        asm volatile("" : "+v"(qf[0]), "+v"(qf[1]));
        if (uprev >= 0) RET3_FLUSH();
        u32x2_t rgq[8];
#pragma unroll
        for (int et = 0; et < 8; ++et) rgq[et] = *(const u32x2_t*)(P + (size_t)(tok0 + i0 + r) * NPP + C_RG + h * 128 + et * 16 + 4 * g);
        if (u + (int)gridDim.x < (T / 128) * 4) { ret3_load(P, RKV, u + gridDim.x, q_tid, kr, vr, pr); RET3_QLOAD(u + gridDim.x); }
        const int ntile = q_wave + 1, nt2 = (ntile + 1) & ~1;
        for (int jt = 0; jt < nt2; ++jt) { f32x4_t a = (f32x4_t){0.f, 0.f, 0.f, 0.f};
            if (jt < ntile) { a = mma(a, frag_row(Ks, 72, jt * 16, 0, r, g), qf[0]); a = mma(a, frag_row(Ks, 72, jt * 16, 32, r, g), qf[1]); }
            float sv[4];
#pragma unroll
            for (int ii = 0; ii < 4; ++ii) { const int dij = (i0 + r) - (jt * 16 + 4 * g + ii); sv[ii] = dij >= 0 ? a[ii] * 0.125f * __expf(lg * (float)dij) : 0.f; }
            *(LDSP u32x2_t*)(Sw + r * 136 + jt * 16 + 4 * g) = (u32x2_t){pk2(sv[0], sv[1]), pk2(sv[2], sv[3])}; }
        f32x4_t o[8];
#pragma unroll
        for (int et = 0; et < 8; ++et) o[et] = (f32x4_t){0.f, 0.f, 0.f, 0.f};
        for (int j0 = 0; j0 < nt2 * 16; j0 += 32) { const bf16x8_t sy = frag_row(Sw, 136, 0, j0, r, g);
#pragma unroll
            for (int et = 0; et < 8; ++et) o[et] = mma(o[et], frag_tr(Vs, 136, j0, et * 16, r, g), sy); }
        { const float qd = __expf(lg * (float)(i0 + r + 1)); const bf16x8_t q0 = scale_frag(qf[0], qd), q1 = scale_frag(qf[1], qd);
#pragma unroll
          for (int et = 0; et < 8; ++et) { o[et] = mma(o[et], frag_row(Pt, 72, et * 16, 0, r, g), q0); o[et] = mma(o[et], frag_row(Pt, 72, et * 16, 32, r, g), q1); } }
        float s1 = 0.f;
#pragma unroll
        for (int et = 0; et < 8; ++et) s1 += (o[et][0] + o[et][1]) + (o[et][2] + o[et][3]);
        s1 += __shfl_xor(s1, 16); s1 += __shfl_xor(s1, 32);
        const float mu = s1 * (1.0f / 128.0f); float s2 = 0.f;
#pragma unroll
        for (int et = 0; et < 8; ++et) { o[et] -= mu; s2 += (o[et][0] * o[et][0] + o[et][1] * o[et][1]) + (o[et][2] * o[et][2] + o[et][3] * o[et][3]); }
        s2 += __shfl_xor(s2, 16); s2 += __shfl_xor(s2, 32);
        const float rstd = rsqrtf(s2 * (1.0f / 128.0f) + LN_EPS);
        const size_t tok = (size_t)(tok0 + i0 + r);
#pragma unroll
        for (int et = 0; et < 8; ++et) { const int c = h * 128 + et * 16 + 4 * g; const f32x4_t gn_ = *(const LDSP f32x4_t*)(gw + c); const float4 gn = make_float4(gn_[0], gn_[1], gn_[2], gn_[3]); const float4 rg = make_float4(__uint_as_float(rgq[et].x << 16), __uint_as_float(rgq[et].x & 0xffff0000u), __uint_as_float(rgq[et].y << 16), __uint_as_float(rgq[et].y & 0xffff0000u));
            *(LDSP u32x2_t*)(Sw + r * 136 + et * 16 + 4 * g) = (u32x2_t){pk2(o[et][0] * rstd * gn.x * (rg.x * sigmoidf_(rg.x)), o[et][1] * rstd * gn.y * (rg.y * sigmoidf_(rg.y))), pk2(o[et][2] * rstd * gn.z * (rg.z * sigmoidf_(rg.z)), o[et][3] * rstd * gn.w * (rg.w * sigmoidf_(rg.w)))}; }
        uprev = u;
    }
    if (uprev >= 0) RET3_FLUSH();
#undef RET3_FLUSH
}

__device__ __forceinline__ float wscan_add(float v, int lane) {
#pragma unroll
    for (int o = 1; o < 64; o <<= 1) { const float t = __shfl_up(v, o); if (lane >= o) v += t; }
    return v; }
__device__ __forceinline__ float wscan_max(float v, int lane) {
#pragma unroll
    for (int o = 1; o < 64; o <<= 1) { const float t = __shfl_up(v, o); if (lane >= o) v = fmaxf(v, t); }
    return v; }
__device__ __forceinline__ float logsigmoidf_(float x) { return fminf(x, 0.f) - log1pf(__expf(-fabsf(x))); }
__device__ __forceinline__ void ml_gates(const float* IGF, const float* bi, const float* bfg, int tok0, int h, int lane, LDSP float* cum, LDSP float* ig, LDSP float* pm, float& tot, float& amax) {
    const float i0 = IGF[(size_t)(tok0 + lane) * 8 + h] + bi[h], i1 = IGF[(size_t)(tok0 + 64 + lane) * 8 + h] + bi[h];
    const float l0 = logsigmoidf_(IGF[(size_t)(tok0 + lane) * 8 + 4 + h] + bfg[h]), l1 = logsigmoidf_(IGF[(size_t)(tok0 + 64 + lane) * 8 + 4 + h] + bfg[h]);
    const float c0 = wscan_add(l0, lane), c1 = wscan_add(l1, lane) + __shfl(c0, 63);
    tot = __shfl(c1, 63);
    const float p0 = wscan_max(i0 - c0, lane), p1 = fmaxf(wscan_max(i1 - c1, lane), __shfl(p0, 63));
    amax = wmax(fmaxf(tot - c0 + i0, tot - c1 + i1));
    cum[lane] = c0; cum[64 + lane] = c1; ig[lane] = i0; ig[64 + lane] = i1; pm[lane] = p0; pm[64 + lane] = p1;
}
__device__ __forceinline__ void ph_ml1(const Params& p, int q_wave, int l, float* lds) {
    PH_PROLOGUE
    LDSP bf16_t* Ks = (LDSP bf16_t*)lds; LDSP bf16_t* Vs = Ks + 128 * 136; LDSP float* gt = (LDSP float*)(Vs + 128 * 136); LDSP bf16_t* Xs = (LDSP bf16_t*)(gt + 2048);
    const bf16_t* P = (const bf16_t*)(q_ws + WS_P); const float* IGF = (const float*)(q_ws + WS_IGF);
    bf16_t* MQ = (bf16_t*)(q_ws + WS_MQ); bf16_t* MK = (bf16_t*)(q_ws + WS_MK); bf16_t* MV = (bf16_t*)(q_ws + WS_MV); bf16_t* MC = (bf16_t*)(q_ws + WS_MC);
    bf16_t* MLC = (bf16_t*)(q_ws + WS_MLC); float* MLN = (float*)(q_ws + WS_MLN); float* MLS = (float*)(q_ws + WS_MLS);
    const float* wq = p.in[5] + (size_t)l * 128 * 16; const float* wk = p.in[6] + (size_t)l * 128 * 16; const float* wv = p.in[7] + (size_t)l * 128 * 16;
    const float* bi = p.in[8] + l * 4; const float* bfg = p.in[9] + l * 4; const float* cw = p.in[3] + (size_t)l * 4 * MIXW; const float* cb = p.in[4] + (size_t)l * MIXW;
    const int lane = q_tid & 63, r = lane & 15, g = lane >> 4;
    for (int ch = q_bid; ch < T / 128; ch += gridDim.x) {
        const int b = ch >> 7, n = ch & 127, tok0 = ch * 128;
        u32x4_t xr[5];
#define ML1_XLOAD(h_) do { _Pragma("unroll") for (int i = 0; i < 5; ++i) { const int c = q_tid + i * NTHR, jr = c >> 4, cc = c & 15; xr[i] = (u32x4_t){0u, 0u, 0u, 0u}; \
            if (c < 131 * 16 && (n > 0 || jr >= 3)) xr[i] = ldnt_u4(P + (size_t)(tok0 + jr - 3) * NPP + C_MX + (h_) * 128 + cc * 8); } } while (0)
        ML1_XLOAD(0);
        __syncthreads();
        if (q_wave < 4) { const int h = q_wave; float tot, amax; ml_gates(IGF, bi, bfg, tok0, h, lane, gt + h * 512, gt + h * 512 + 128, gt + h * 512 + 256, tot, amax);
            gt[h * 512 + 384 + lane] = __expf(tot - gt[h * 512 + lane] + gt[h * 512 + 128 + lane] - amax); gt[h * 512 + 384 + 64 + lane] = __expf(tot - gt[h * 512 + 64 + lane] + gt[h * 512 + 128 + 64 + lane] - amax);
            if (lane == 0) { float* ms = MLS + (((size_t)n * 2 + b) * 4 + h) * 4; ms[0] = tot; ms[1] = amax; }
            float* gtg = (float*)(q_ws + WS_GT) + (size_t)(ch * 4 + h) * 384;
#pragma unroll
            for (int q = 0; q < 3; ++q) { gtg[q * 128 + lane] = gt[h * 512 + q * 128 + lane]; gtg[q * 128 + 64 + lane] = gt[h * 512 + q * 128 + 64 + lane]; } }
        __syncthreads();
        for (int h = 0; h < 4; ++h) {
#pragma unroll
            for (int i = 0; i < 5; ++i) { const int c = q_tid + i * NTHR, jr = c >> 4, cc = c & 15; if (c < 131 * 16) *(LDSP u32x4_t*)(Xs + jr * 136 + cc * 8) = xr[i]; }
            if (h < 3) ML1_XLOAD(h + 1);
            const int nb = q_tid & 31, n4 = h * 32 + nb, jr0 = q_tid >> 5;
            float cwr[4][4], cbr[4], wqr[16], wkr[16], wvr[16];
#pragma unroll
            for (int i = 0; i < 4; ++i) { const float4 t4 = *(const float4*)(cw + i * MIXW + n4 * 4); cwr[i][0] = t4.x; cwr[i][1] = t4.y; cwr[i][2] = t4.z; cwr[i][3] = t4.w; }
            { const float4 t4 = *(const float4*)(cb + n4 * 4); cbr[0] = t4.x; cbr[1] = t4.y; cbr[2] = t4.z; cbr[3] = t4.w; }
#pragma unroll
            for (int i = 0; i < 4; ++i) { const float4 a4 = *(const float4*)(wq + n4 * 16 + i * 4), b4 = *(const float4*)(wk + n4 * 16 + i * 4), c4 = *(const float4*)(wv + n4 * 16 + i * 4);
                wqr[i * 4] = a4.x; wqr[i * 4 + 1] = a4.y; wqr[i * 4 + 2] = a4.z; wqr[i * 4 + 3] = a4.w; wkr[i * 4] = b4.x; wkr[i * 4 + 1] = b4.y; wkr[i * 4 + 2] = b4.z; wkr[i * 4 + 3] = b4.w;
                wvr[i * 4] = c4.x; wvr[i * 4 + 1] = c4.y; wvr[i * 4 + 2] = c4.z; wvr[i * 4 + 3] = c4.w; }
            __syncthreads();
#pragma unroll 2
            for (int it = 0; it < 8; ++it) { const int j = jr0 + 16 * it, tok = tok0 + j;
                float xv[4][4];
#pragma unroll
                for (int i = 0; i < 4; ++i) { const u32x2_t w = *(const LDSP u32x2_t*)(Xs + (j + i) * 136 + nb * 4);
                    xv[i][0] = __uint_as_float(w.x << 16); xv[i][1] = __uint_as_float(w.x & 0xffff0000u); xv[i][2] = __uint_as_float(w.y << 16); xv[i][3] = __uint_as_float(w.y & 0xffff0000u); }
                float mc[4], q[4] = {0, 0, 0, 0}, k[4] = {0, 0, 0, 0}, v[4] = {0, 0, 0, 0};
#pragma unroll
                for (int c = 0; c < 4; ++c) { float a = cbr[c];
#pragma unroll
                    for (int i = 0; i < 4; ++i) a += cwr[i][c] * xv[i][c];
                    mc[c] = a * sigmoidf_(a); }
#pragma unroll
                for (int c = 0; c < 4; ++c)
#pragma unroll
                    for (int d = 0; d < 4; ++d) { q[d] += mc[c] * wqr[c * 4 + d]; k[d] += mc[c] * wkr[c * 4 + d]; v[d] += xv[3][c] * wvr[c * 4 + d]; }
#pragma unroll
                for (int d = 0; d < 4; ++d) k[d] *= 0.08838834764831845f;
                const size_t o = (size_t)tok * MIXW + n4 * 4;
                st_bf4(MQ + o, make_float4(q[0], q[1], q[2], q[3])); st_bf4(MK + o, make_float4(k[0], k[1], k[2], k[3])); st_bf4(MV + o, make_float4(v[0], v[1], v[2], v[3])); st_bf4(MC + o, make_float4(mc[0], mc[1], mc[2], mc[3]));
                const float wa = gt[h * 512 + 384 + j];
                *(LDSP u32x2_t*)(Ks + j * 136 + nb * 4) = (u32x2_t){pk2(k[0] * wa, k[1] * wa), pk2(k[2] * wa, k[3] * wa)};
                *(LDSP u32x2_t*)(Vs + j * 136 + nb * 4) = (u32x2_t){pk2(v[0], v[1]), pk2(v[2], v[3])}; }
            __syncthreads();
            f32x4_t acc[8];
#pragma unroll
            for (int dt = 0; dt < 8; ++dt) acc[dt] = (f32x4_t){0.f, 0.f, 0.f, 0.f};
#pragma unroll
            for (int j0 = 0; j0 < 128; j0 += 32) { const bf16x8_t vy = frag_tr(Vs, 136, j0, q_wave * 16, r, g);
#pragma unroll
                for (int dt = 0; dt < 8; ++dt) acc[dt] = mma(acc[dt], frag_tr(Ks, 136, j0, dt * 16, r, g), vy); }
            const size_t sb = ((size_t)n * 2 + b) * 4 + h;
            { LDSP float* ob = (LDSP float*)(Xs + 131 * 136) + q_wave * (16 * 68);
              bf16_t* dst = MLC + (sb * 128 + q_wave * 16) * 128;
#pragma unroll
              for (int hf = 0; hf < 2; ++hf) {
#pragma unroll
                  for (int dt = 0; dt < 4; ++dt) *(LDSP f32x4_t*)(ob + r * 68 + dt * 16 + 4 * g) = acc[hf * 4 + dt];
#pragma unroll
                  for (int k = 0; k < 2; ++k) { const int rw = (lane >> 3) + 8 * k, ck = lane & 7; const f32x4_t lo = *(const LDSP f32x4_t*)(ob + rw * 68 + ck * 8), hi = *(const LDSP f32x4_t*)(ob + rw * 68 + ck * 8 + 4);
                      *(u32x4_t*)(dst + rw * 128 + hf * 64 + ck * 8) = (u32x4_t){pk2(lo[0], lo[1]), pk2(lo[2], lo[3]), pk2(hi[0], hi[1]), pk2(hi[2], hi[3])}; } } }
            if (q_tid < 128) { float sm = 0.f; for (int j = 0; j < 128; ++j) sm += bf2f(Ks[j * 136 + q_tid]); MLN[sb * 128 + q_tid] = sm; }
            __syncthreads();
        }
    }
}
#undef ML1_XLOAD
__device__ __forceinline__ void ph_ml2(const Params& p, int q_wave, int l, float* lds) {
    PH_PROLOGUE
    bf16_t* MLC = (bf16_t*)(q_ws + WS_MLC); float* MLN = (float*)(q_ws + WS_MLN); float* MLS = (float*)(q_ws + WS_MLS);
    LDSP float* co = (LDSP float*)lds;
    const int vb = gridDim.x - 1 - q_bid;
    if (vb * NTHR >= 8 * 16512 / 2) return;
    __syncthreads();
    for (int i = q_tid; i < 1024; i += NTHR) { const int n = i >> 3, bh = i & 7; const float4 ms = *(const float4*)(MLS + ((size_t)n * 8 + bh) * 4); co[(bh * 128 + n) * 2] = ms.x; co[(bh * 128 + n) * 2 + 1] = ms.y; }
    __syncthreads();
    if (q_tid < 8) { const int bh = q_tid; float m = 0.f;
        for (int n = 0; n < 128; ++n) { const float gs = co[(bh * 128 + n) * 2], am = co[(bh * 128 + n) * 2 + 1]; const float mn = fmaxf(gs + m, am);
            co[(bh * 128 + n) * 2] = __expf(gs + m - mn); co[(bh * 128 + n) * 2 + 1] = __expf(am - mn);
            if (vb == 0) MLS[((size_t)n * 8 + bh) * 4 + 2] = m;
            m = mn; } }
    __syncthreads();
    for (int idx = vb * NTHR + q_tid; idx < 8 * 16512 / 2; idx += gridDim.x * NTHR) {
        if (idx < 65536) { const int bh = idx >> 13; unsigned* base = (unsigned*)(MLC + (size_t)bh * 16384) + (idx & 8191); float2 st = make_float2(0.f, 0.f);
#pragma unroll 32
            for (int n = 0; n < 128; ++n) { const float so = co[(bh * 128 + n) * 2], sn = co[(bh * 128 + n) * 2 + 1];
                unsigned* q = base + (size_t)n * (8 * 16384 / 2); const unsigned cv = *q; *q = pk2(st.x, st.y); st.x = so * st.x + sn * __uint_as_float(cv << 16); st.y = so * st.y + sn * __uint_as_float(cv & 0xffff0000u); } }
        else { const int j = idx - 65536, bh = j >> 6; float* base = MLN + (size_t)bh * 128 + (j & 63) * 2; float2 st = make_float2(0.f, 0.f);
#pragma unroll 32
            for (int n = 0; n < 128; ++n) { const float so = co[(bh * 128 + n) * 2], sn = co[(bh * 128 + n) * 2 + 1];
                float2* q = (float2*)(base + (size_t)n * (8 * 128)); const float2 cv = *q; *q = st; st.x = so * st.x + sn * cv.x; st.y = so * st.y + sn * cv.y; } }
    }
}
__device__ __forceinline__ void ml3_load(const bf16_t* MK, const bf16_t* MV, const bf16_t* MLC, const float* GT, const float* MLN, int u, int q_tid, u32x4_t (&kr)[4], u32x4_t (&vr)[4], u32x4_t (&cr)[4], float& gv) {
    const int ch = u >> 2, h = u & 3, b = ch >> 7, n = ch & 127, tok0 = ch * 128; const size_t sb = ((size_t)n * 2 + b) * 4 + h;
#pragma unroll
    for (int i = 0; i < 4; ++i) { const int c = q_tid + i * NTHR; const size_t o = (size_t)(tok0 + (c >> 4)) * MIXW + h * 128 + (c & 15) * 8; kr[i] = ldnt_u4(MK + o); vr[i] = ldnt_u4(MV + o); }
#pragma unroll
    for (int i = 0; i < 4; ++i) cr[i] = ldnt_u4(MLC + sb * 16384 + (size_t)(q_tid + i * NTHR) * 8);
    gv = q_tid < 384 ? GT[(size_t)u * 384 + q_tid] : MLN[sb * 128 + (q_tid - 384)];
}
__device__ __forceinline__ void ph_ml3(const Params& p, int q_wave, int l, float* lds) {
    PH_PROLOGUE
    LDSP bf16_t* Ks = (LDSP bf16_t*)lds; LDSP bf16_t* Vs = Ks + 128 * 136; LDSP bf16_t* Ct = Vs + 128 * 136; LDSP bf16_t* Sw = Ct + 128 * 136 + q_wave * (16 * 136);
    LDSP float* gt = (LDSP float*)(Ct + 128 * 136 + 8 * 16 * 136);
    LDSP float* gw = gt + 512;
    const bf16_t* P = (const bf16_t*)(q_ws + WS_P); const float* IGF = (const float*)(q_ws + WS_IGF);
    const bf16_t* MQ = (const bf16_t*)(q_ws + WS_MQ); const bf16_t* MK = (const bf16_t*)(q_ws + WS_MK); const bf16_t* MV = (const bf16_t*)(q_ws + WS_MV); const bf16_t* MC = (const bf16_t*)(q_ws + WS_MC);
    const bf16_t* MLC = (const bf16_t*)(q_ws + WS_MLC); const float* MLN = (const float*)(q_ws + WS_MLN); const float* MLS = (const float*)(q_ws + WS_MLS);
    bf16_t* YM = (bf16_t*)(q_ws + WS_YM);
    const float* bi = p.in[8] + l * 4; const float* bfg = p.in[9] + l * 4; const float* mgn = p.in[10] + l * MIXW; const float* msk = p.in[11] + l * MIXW;
    const int lane = q_tid & 63, r = lane & 15, g = lane >> 4, i0 = q_wave * 16;
    u32x4_t kr[4], vr[4], cr[4]; float gv = 0.f; const float* GT = (const float*)(q_ws + WS_GT);
    __syncthreads(); gw[q_tid] = mgn[q_tid]; gw[512 + q_tid] = msk[q_tid];
    bf16x8_t qn[4];
#define ML3_QLOAD(u_) do { const bf16_t* qr_ = MQ + (size_t)(((u_) >> 2) * 128 + i0 + r) * MIXW + ((u_) & 3) * 128 + 8 * g; _Pragma("unroll") for (int ks_ = 0; ks_ < 4; ++ks_) qn[ks_] = ldnt_b8(qr_ + 32 * ks_); } while (0)
#define ML3_SB(u_) ((((size_t)(((u_) >> 2) & 127)) * 2 + ((u_) >> 9)) * 4 + ((u_) & 3))
    float mprev_n = 0.f;
    if (q_bid < (T / 128) * 4) { ml3_load(MK, MV, MLC, GT, MLN, q_bid, q_tid, kr, vr, cr, gv); ML3_QLOAD(q_bid); mprev_n = MLS[ML3_SB(q_bid) * 4 + 2]; }
    int uprev = -1;
#define ML3_FLUSH() do { _Pragma("unroll") for (int k = 0; k < 4; ++k) { const int rw = (lane >> 4) + 4 * k, ck = lane & 15; \
        *(u32x4_t*)(YM + (size_t)((uprev >> 2) * 128 + i0 + rw) * MIXW + (uprev & 3) * 128 + ck * 8) = *(const LDSP u32x4_t*)(Sw + rw * 136 + ck * 8); } } while (0)
    for (int u = q_bid; u < (T / 128) * 4; u += gridDim.x) {
        const int ch = u >> 2, h = u & 3, tok0 = ch * 128;
        __syncthreads();
#pragma unroll
        for (int i = 0; i < 4; ++i) { const int c = q_tid + i * NTHR; *(LDSP u32x4_t*)(Ks + (c >> 4) * 136 + (c & 15) * 8) = kr[i]; *(LDSP u32x4_t*)(Vs + (c >> 4) * 136 + (c & 15) * 8) = vr[i]; }
#pragma unroll
        for (int i = 0; i < 4; ++i) { const int c = q_tid + i * NTHR, e = c >> 4, d = (c & 15) * 8; *(LDSP u32x4_t*)(Ct + e * 136 + d) = cr[i]; }
        gt[q_tid] = gv;
        bf16x8_t qf[4];
#pragma unroll
        for (int ks = 0; ks < 4; ++ks) qf[ks] = qn[ks];
        const float mprev = mprev_n;
        __syncthreads();
        asm volatile("" : "+v"(qf[0]), "+v"(qf[1]), "+v"(qf[2]), "+v"(qf[3]));
        if (uprev >= 0) ML3_FLUSH();
        u32x2_t ogq[8], mcq[8];
#pragma unroll
        for (int et = 0; et < 8; ++et) { const int c = h * 128 + et * 16 + 4 * g; ogq[et] = *(const u32x2_t*)(P + (size_t)(tok0 + i0 + r) * NPP + C_MO + c); mcq[et] = *(const u32x2_t*)(MC + (size_t)(tok0 + i0 + r) * MIXW + c); }
        if (u + (int)gridDim.x < (T / 128) * 4) { ml3_load(MK, MV, MLC, GT, MLN, u + gridDim.x, q_tid, kr, vr, cr, gv); ML3_QLOAD(u + gridDim.x); mprev_n = MLS[ML3_SB(u + gridDim.x) * 4 + 2]; }
        const float cum_i = gt[i0 + r], mq = cum_i + fmaxf(mprev, gt[256 + i0 + r]), inter = __expf(cum_i + mprev - mq);
        const int ntile = q_wave + 1, nt2 = (ntile + 1) & ~1;
        float den = 0.f;
        for (int jt = 0; jt < nt2; ++jt) { f32x4_t a = (f32x4_t){0.f, 0.f, 0.f, 0.f};
            if (jt < ntile) {
#pragma unroll
                for (int ks = 0; ks < 4; ++ks) a = mma(a, frag_row(Ks, 136, jt * 16, 32 * ks, r, g), qf[ks]); }
            float sv[4];
#pragma unroll
            for (int ii = 0; ii < 4; ++ii) { const int sj = jt * 16 + 4 * g + ii; sv[ii] = sj <= i0 + r ? a[ii] * __expf(cum_i - gt[sj] + gt[128 + sj] - mq) : 0.f; den += sv[ii]; }
            *(LDSP u32x2_t*)(Sw + r * 136 + jt * 16 + 4 * g) = (u32x2_t){pk2(sv[0], sv[1]), pk2(sv[2], sv[3])}; }
        f32x4_t o[8];
#pragma unroll
        for (int et = 0; et < 8; ++et) o[et] = (f32x4_t){0.f, 0.f, 0.f, 0.f};
        for (int j0 = 0; j0 < nt2 * 16; j0 += 32) { const bf16x8_t sy = frag_row(Sw, 136, 0, j0, r, g);
#pragma unroll
            for (int et = 0; et < 8; ++et) o[et] = mma(o[et], frag_tr(Vs, 136, j0, et * 16, r, g), sy); }
        float qn = 0.f;
#pragma unroll
        for (int ks = 0; ks < 4; ++ks) { float f[8]; unpack8u(__builtin_bit_cast(u32x4_t, qf[ks]), f);
#pragma unroll
            for (int jj = 0; jj < 8; ++jj) qn += f[jj] * gt[384 + 32 * ks + 8 * g + jj];
            qf[ks] = scale_frag(qf[ks], inter); }
#pragma unroll
        for (int et = 0; et < 8; ++et)
#pragma unroll
            for (int ks = 0; ks < 4; ++ks) o[et] = mma(o[et], frag_row(Ct, 136, et * 16, 32 * ks, r, g), qf[ks]);
        den += inter * qn; den += __shfl_xor(den, 16); den += __shfl_xor(den, 32);
        const float dinv = 1.0f / fmaxf(fabsf(den), __expf(-mq));
        float s1 = 0.f;
#pragma unroll
        for (int et = 0; et < 8; ++et) { o[et] *= dinv; s1 += (o[et][0] + o[et][1]) + (o[et][2] + o[et][3]); }
        s1 += __shfl_xor(s1, 16); s1 += __shfl_xor(s1, 32);
        const float mu = s1 * (1.0f / 128.0f); float s2 = 0.f;
#pragma unroll
        for (int et = 0; et < 8; ++et) { o[et] -= mu; s2 += (o[et][0] * o[et][0] + o[et][1] * o[et][1]) + (o[et][2] * o[et][2] + o[et][3] * o[et][3]); }
        s2 += __shfl_xor(s2, 16); s2 += __shfl_xor(s2, 32);
        const float rstd = rsqrtf(s2 * (1.0f / 128.0f) + LN_EPS);
        const size_t tok = (size_t)(tok0 + i0 + r);
#pragma unroll
        for (int et = 0; et < 8; ++et) { const int c = h * 128 + et * 16 + 4 * g; const f32x4_t gn_ = *(const LDSP f32x4_t*)(gw + c), sk_ = *(const LDSP f32x4_t*)(gw + 512 + c); const float4 gn = make_float4(gn_[0], gn_[1], gn_[2], gn_[3]), sk = make_float4(sk_[0], sk_[1], sk_[2], sk_[3]); const float4 og = make_float4(__uint_as_float(ogq[et].x << 16), __uint_as_float(ogq[et].x & 0xffff0000u), __uint_as_float(ogq[et].y << 16), __uint_as_float(ogq[et].y & 0xffff0000u)), mc = make_float4(__uint_as_float(mcq[et].x << 16), __uint_as_float(mcq[et].x & 0xffff0000u), __uint_as_float(mcq[et].y << 16), __uint_as_float(mcq[et].y & 0xffff0000u));
            *(LDSP u32x2_t*)(Sw + r * 136 + et * 16 + 4 * g) = (u32x2_t){pk2(sigmoidf_(og.x) * (o[et][0] * rstd * gn.x + sk.x * mc.x), sigmoidf_(og.y) * (o[et][1] * rstd * gn.y + sk.y * mc.y)), pk2(sigmoidf_(og.z) * (o[et][2] * rstd * gn.z + sk.z * mc.z), sigmoidf_(og.w) * (o[et][3] * rstd * gn.w + sk.w * mc.w))}; }
        uprev = u;
    }
    if (uprev >= 0) ML3_FLUSH();
#undef ML3_FLUSH
}


constexpr size_t DO_ATT = 0;
struct AttU { size_t tokb; int grp, h, dil, rr, nb; };
__device__ __forceinline__ AttU att_decode(int u) { AttU a; a.grp = u >> 10; const int v = u & 1023, blk = v >> 2, b = blk >> 7, bi = blk & 127; a.h = v & 3;
    a.dil = a.grp == 0 ? 1 : (a.grp == 1 ? 4 : 16); a.rr = bi % a.dil; a.nb = bi / a.dil; a.tokb = (size_t)b * SEQ; return a; }
__device__ __forceinline__ void att_load(const bf16_t* P, const AttU& a, int q_tid, u32x4_t (&kreg)[4], u32x4_t (&vreg)[8]) {
#pragma unroll
    for (int i = 0; i < 4; ++i) { const int c = q_tid + i * NTHR, j = c >> 3, cc = c & 7, u0 = (a.nb - 1) * 128 + j, uu = u0 < 0 ? u0 + 128 : u0;
        kreg[i] = *(const u32x4_t*)(P + (a.tokb + (size_t)uu * a.dil + a.rr) * NPP + C_AK + a.grp * 256 + a.h * 64 + cc * 8); }
#pragma unroll
    for (int i = 0; i < 8; ++i) { const int c = q_tid + i * NTHR, j = c >> 4, cc = c & 15, u0 = (a.nb - 1) * 128 + j, uu = u0 < 0 ? u0 + 128 : u0;
        vreg[i] = *(const u32x4_t*)(P + (a.tokb + (size_t)uu * a.dil + a.rr) * NPP + C_AV + a.grp * 512 + a.h * 128 + cc * 8); }
}
__device__ __forceinline__ void ph_att(const Params& p, int q_wave, int l, float* lds) {
    PH_PROLOGUE
    LDSP bf16_t* Ks = (LDSP bf16_t*)lds; LDSP bf16_t* Vs = Ks + 256 * 72; LDSP bf16_t* Pw = Vs + 272 * 136 + q_wave * (16 * 168);
    const bf16_t* P = (const bf16_t*)(q_ws + WS_P); bf16_t* ATT = (bf16_t*)((char*)q_out + DO_ATT); float* LSE = (float*)(q_ws + WS_LSE);
    const int lane = q_tid & 63, r = lane & 15, g = lane >> 4, i0 = q_wave * 16;
    __syncthreads();
    if (q_tid < 256) *(LDSP u32x4_t*)(Vs + (256 + (q_tid >> 4)) * 136 + (q_tid & 15) * 8) = (u32x4_t){0u, 0u, 0u, 0u};
    u32x4_t kreg[4], vreg[8]; bf16x8_t qn[2];
#define ATT_QLOAD(a_) do { const bf16_t* qr_ = P + ((a_).tokb + (size_t)((a_).nb * 128 + i0 + r) * (a_).dil + (a_).rr) * NPP + C_AQ + (a_).grp * 256 + (a_).h * 64 + 8 * g; qn[0] = ldnt_b8(qr_); qn[1] = ldnt_b8(qr_ + 32); } while (0)
    if (q_bid < 3072) { const AttU a0 = att_decode(q_bid); att_load(P, a0, q_tid, kreg, vreg); ATT_QLOAD(a0); }
    float lse_prev = 0.f; int uprev = -1;
#define ATT_FLUSH() do { const AttU ap = att_decode(uprev); _Pragma("unroll") for (int k = 0; k < 4; ++k) { const int rw = (lane >> 4) + 4 * k, ck = lane & 15; \
            const size_t tk = ap.tokb + (size_t)ap.rr * (SEQ / ap.dil) + (size_t)(ap.nb * 128 + i0 + rw);   \
            *(u32x4_t*)(ATT + ((size_t)ap.grp * T + tk) * MIXW + ap.h * 128 + ck * 8) = *(const LDSP u32x4_t*)(Pw + rw * 168 + ck * 8); } \
        if (g == 0) LSE[((size_t)ap.grp * T + ap.tokb + (size_t)ap.rr * (SEQ / ap.dil) + (size_t)(ap.nb * 128 + i0 + r)) * 4 + ap.h] = lse_prev; } while (0)
    for (int u = q_bid; u < 3072; u += gridDim.x) {
        const AttU a = att_decode(u); const int grp = a.grp, h = a.h, dil = a.dil, nb = a.nb;
        const float slope = exp2f(-8.0f * (float)(grp * 4 + h + 1) / 12.0f) * (float)dil;
        __syncthreads();
#pragma unroll
        for (int i = 0; i < 4; ++i) { const int c = q_tid + i * NTHR; *(LDSP u32x4_t*)(Ks + (c >> 3) * 72 + (c & 7) * 8) = kreg[i]; }
#pragma unroll
        for (int i = 0; i < 8; ++i) { const int c = q_tid + i * NTHR; *(LDSP u32x4_t*)(Vs + (c >> 4) * 136 + (c & 15) * 8) = vreg[i]; }
        const size_t tokq = a.tokb + (size_t)(nb * 128 + i0 + r) * dil + a.rr;
        bf16x8_t qf[2]; qf[0] = qn[0]; qf[1] = qn[1];
        __syncthreads();
        asm volatile("" : "+v"(qf[0]), "+v"(qf[1]));
        if (uprev >= 0) ATT_FLUSH();
        if (u + (int)gridDim.x < 3072) { const AttU an = att_decode(u + gridDim.x); att_load(P, an, q_tid, kreg, vreg); ATT_QLOAD(an); }
        f32x4_t sc[9]; float mx = -INFINITY;
#pragma unroll
        for (int tt = 0; tt < 9; ++tt) { f32x4_t a4 = (f32x4_t){0.f, 0.f, 0.f, 0.f}; const int j0 = (q_wave + tt) * 16;
            a4 = mma(a4, frag_row(Ks, 72, j0, 0, r, g), qf[0]); a4 = mma(a4, frag_row(Ks, 72, j0, 32, r, g), qf[1]);
#pragma unroll
            for (int ii = 0; ii < 4; ++ii) { const int delta = r + 128 - 16 * tt - 4 * g - ii, j = j0 + 4 * g + ii; const bool ok = delta >= 0 && delta <= 128 && (nb > 0 || j >= 128);
                a4[ii] = ok ? a4[ii] * 0.125f - slope * (float)delta : -INFINITY; mx = fmaxf(mx, a4[ii]); }
            sc[tt] = a4; }
        mx = fmaxf(mx, __shfl_xor(mx, 16)); mx = fmaxf(mx, __shfl_xor(mx, 32));
        float ls = 0.f;
#pragma unroll
        for (int tt = 0; tt < 9; ++tt) { float pv[4];
#pragma unroll
            for (int ii = 0; ii < 4; ++ii) { pv[ii] = __expf(sc[tt][ii] - mx); ls += pv[ii]; }
            *(LDSP u32x2_t*)(Pw + r * 168 + tt * 16 + 4 * g) = (u32x2_t){pk2(pv[0], pv[1]), pk2(pv[2], pv[3])}; }
        *(LDSP u32x2_t*)(Pw + r * 168 + 144 + 4 * g) = (u32x2_t){0u, 0u};
        ls += __shfl_xor(ls, 16); ls += __shfl_xor(ls, 32);
        f32x4_t o[8];
#pragma unroll
        for (int et = 0; et < 8; ++et) o[et] = (f32x4_t){0.f, 0.f, 0.f, 0.f};
#pragma unroll
        for (int jj0 = 0; jj0 < 160; jj0 += 32) { const bf16x8_t sy = frag_row(Pw, 168, 0, jj0, r, g);
#pragma unroll
            for (int et = 0; et < 8; ++et) o[et] = mma(o[et], frag_tr(Vs, 136, i0 + jj0, et * 16, r, g), sy); }
        const float inv = 1.0f / ls;
#pragma unroll
        for (int et = 0; et < 8; ++et) *(LDSP u32x2_t*)(Pw + r * 168 + et * 16 + 4 * g) = (u32x2_t){pk2(o[et][0] * inv, o[et][1] * inv), pk2(o[et][2] * inv, o[et][3] * inv)};
        lse_prev = mx + __logf(ls); uprev = u;
    }
    if (uprev >= 0) ATT_FLUSH();
#undef ATT_FLUSH
#undef ATT_QLOAD
}
__device__ __forceinline__ void ph_att_combine(const Params& p, int q_wave, int l) {
    PH_PROLOGUE
    const bf16_t* ATT = (const bf16_t*)((char*)q_out + DO_ATT); const float* LSE = (const float*)(q_ws + WS_LSE); bf16_t* YA = (bf16_t*)((char*)q_out + DO_YA);
    const size_t step = (size_t)gridDim.x * NTHR;
    for (size_t i0 = (size_t)q_bid * NTHR + q_tid; i0 < (size_t)T * 64; i0 += 4 * step) {
        u32x4_t qa[4], qb[4], qc[4]; float l0[4], l1[4], l2[4];
#pragma unroll
        for (int j = 0; j < 4; ++j) { const size_t i = i0 + j * step < (size_t)T * 64 ? i0 + j * step : i0; const size_t tok = i >> 6; const int c8 = (int)(i & 63) * 8, h = c8 >> 7;
            const size_t ts = tok & (size_t)(SEQ - 1), tb = tok - ts, r1 = (size_t)T + tb + (ts & 3) * (SEQ / 4) + (ts >> 2), r2 = (size_t)2 * T + tb + (ts & 15) * (SEQ / 16) + (ts >> 4);
            l0[j] = LSE[tok * 4 + h]; l1[j] = LSE[r1 * 4 + h]; l2[j] = LSE[r2 * 4 + h];
            qa[j] = ldnt_u4(ATT + tok * MIXW + c8); qb[j] = ldnt_u4(ATT + r1 * MIXW + c8); qc[j] = ldnt_u4(ATT + r2 * MIXW + c8); }
        asm volatile("" ::: "memory");
#pragma unroll
        for (int j = 0; j < 4; ++j) { const size_t i = i0 + j * step; if (i < (size_t)T * 64) { const size_t tok = i >> 6; const int c8 = (int)(i & 63) * 8;
            const float m = fmaxf(l0[j], fmaxf(l1[j], l2[j])), e0 = __expf(l0[j] - m), e1 = __expf(l1[j] - m), e2 = __expf(l2[j] - m), inv = 1.0f / (e0 + e1 + e2);
            float a[8], b8[8], c[8]; unpack8u(qa[j], a); unpack8u(qb[j], b8); unpack8u(qc[j], c);
#pragma unroll
            for (int jj = 0; jj < 8; ++jj) a[jj] = (a[jj] * e0 + b8[jj] * e1 + c[jj] * e2) * inv;
            *(u32x4_t*)(YA + tok * MIXW + c8) = pack8u(a); } }
    }
}


__device__ __forceinline__ void ln_row(float4 (&v)[4], const float* g, const float* b, int lane) {
    float s = 0.f;
#pragma unroll
    for (int i = 0; i < 4; ++i) s += (v[i].x + v[i].y) + (v[i].z + v[i].w);
    const float mu = wsum(s) * (1.0f / D); float q = 0.f;
#pragma unroll
    for (int i = 0; i < 4; ++i) { v[i].x -= mu; v[i].y -= mu; v[i].z -= mu; v[i].w -= mu; q += (v[i].x * v[i].x + v[i].y * v[i].y) + (v[i].z * v[i].z + v[i].w * v[i].w); }
    const float rstd = rsqrtf(wsum(q) * (1.0f / D) + LN_EPS);
#pragma unroll
    for (int i = 0; i < 4; ++i) { const float4 gg = *(const float4*)(g + RC(i)), bb = *(const float4*)(b + RC(i));
        v[i].x = v[i].x * rstd * gg.x + bb.x; v[i].y = v[i].y * rstd * gg.y + bb.y; v[i].z = v[i].z * rstd * gg.z + bb.z; v[i].w = v[i].w * rstd * gg.w + bb.w; }
}

__device__ __forceinline__ void ph_ln1_router(const Params& p, int q_wave, int l, float* lds) {
    PH_PROLOGUE
    float* X = (float*)(q_ws + WS_X); bf16_t* XB = (bf16_t*)(q_ws + WS_XB); unsigned char* XB8 = (unsigned char*)(q_ws + WS_XB8);
    const float* g1 = p.in[14] + l * D; const float* b1 = p.in[15] + l * D;
    const float* wr = p.in[16] + (size_t)l * D * NE; const float* br = p.in[17] + l * NE;
    int* topi = (int*)(q_ws + WS_TOPI); float* topp = (float*)(q_ws + WS_TOPP);
    unsigned* ctl = (unsigned*)(q_ws + WS_CTL);
    const int lane = q_tid & 63, wv = q_tid >> 6;
    LDSP float* ybuf = (LDSP float*)lds + wv * (4 * D);
    LDSP unsigned* cnt = (LDSP unsigned*)((LDSP float*)lds + 8 * 4 * D);
    for (int ch = q_bid; ch < T / 128; ch += gridDim.x) {
        if (q_tid < NE) cnt[q_tid] = 0u;
        __syncthreads();
        float4 nx[4];
#pragma unroll
        for (int i = 0; i < 4; ++i) nx[i] = ldnt_f4(X + (size_t)(ch * 128 + wv * 16) * D + RC(i));
        for (int grp = 0; grp < 4; ++grp) {
#pragma unroll
            for (int tt = 0; tt < 4; ++tt) {
                const int it = grp * 4 + tt, tok = ch * 128 + wv * 16 + it;
                float4 v[4];
#pragma unroll
                for (int i = 0; i < 4; ++i) v[i] = nx[i];
                if (it < 15) {
#pragma unroll
                    for (int i = 0; i < 4; ++i) nx[i] = ldnt_f4(X + (size_t)(tok + 1) * D + RC(i)); }
                ln_row(v, g1, b1, lane);
#pragma unroll
                for (int i = 0; i < 4; ++i) { const int cb = RC(i), sw = lane & 7;
                    ybuf[((cb + 0) ^ sw) * 4 + tt] = v[i].x; ybuf[((cb + 1) ^ sw) * 4 + tt] = v[i].y; ybuf[((cb + 2) ^ sw) * 4 + tt] = v[i].z; ybuf[((cb + 3) ^ sw) * 4 + tt] = v[i].w; }
#pragma unroll
                for (int c = 0; c < 2; ++c) { const float f8[8] = {v[2 * c].x, v[2 * c].y, v[2 * c].z, v[2 * c].w, v[2 * c + 1].x, v[2 * c + 1].y, v[2 * c + 1].z, v[2 * c + 1].w};
                    *(u32x4_t*)(XB + (size_t)tok * D + c * 512 + lane * 8) = pack8u(f8);
                    *(u32x2_t*)(XB8 + (size_t)tok * D + c * 512 + lane * 8) = (u32x2_t){pk4_fp8(f8[0], f8[1], f8[2], f8[3]), pk4_fp8(f8[4], f8[5], f8[6], f8[7])}; }
            }
            const int e = lane & 31, hf = lane >> 5; f32x2_t a01 = (f32x2_t){0.f, 0.f}, a23 = (f32x2_t){0.f, 0.f};
            const float* wp = wr + (size_t)(hf * 512) * NE + e; const LDSP float* yq = ybuf + hf * 512 * 4;
#pragma unroll 8
            for (int c = 0; c < 512; ++c) { const f32x4_t y = *(const LDSP f32x4_t*)(yq + c * 4); const float w = wp[(size_t)(c ^ ((c >> 3) & 7)) * NE];     const f32x2_t w2 = (f32x2_t){w, w};
                a01 = __builtin_elementwise_fma((f32x2_t){y[0], y[1]}, w2, a01); a23 = __builtin_elementwise_fma((f32x2_t){y[2], y[3]}, w2, a23); }
            float lg4[4] = {a01[0], a01[1], a23[0], a23[1]};
#pragma unroll
            for (int tt = 0; tt < 4; ++tt) { const int tok = ch * 128 + wv * 16 + grp * 4 + tt;
                float acc = lg4[tt]; acc += __shfl_xor(acc, 32); acc += br[e];
                float val = lane < 32 ? acc : -INFINITY; float tv[4]; int ti[4];
#pragma unroll
                for (int r = 0; r < 4; ++r) { const float mx = wmax(val); const unsigned long long bal = __ballot(val == mx); const int idx = __ffsll((long long)bal) - 1; tv[r] = mx; ti[r] = idx; if (lane == idx) val = -INFINITY; }
                const float e1 = __expf(tv[1] - tv[0]), e2 = __expf(tv[2] - tv[0]), e3 = __expf(tv[3] - tv[0]), inv = 1.0f / (1.0f + e1 + e2 + e3);
                if (lane == 0) { *(int4*)(topi + (size_t)tok * 4) = make_int4(ti[0], ti[1], ti[2], ti[3]); *(float4*)(topp + (size_t)tok * 4) = make_float4(inv, e1 * inv, e2 * inv, e3 * inv); }
                { const int myti = lane == 0 ? ti[0] : (lane == 1 ? ti[1] : (lane == 2 ? ti[2] : ti[3])); if (lane < 4) __hip_atomic_fetch_add(&cnt[myti], 1u, __ATOMIC_RELAXED, __HIP_MEMORY_SCOPE_WORKGROUP); } }
        }
        __syncthreads();
        if (q_tid < NE) ctl[CW_CHCNT + ch * NE + q_tid] = cnt[q_tid];
        __syncthreads();
    }
}
__device__ __forceinline__ void ph_assign(const Params& p, int q_wave, int l, float* lds) {
    PH_PROLOGUE
    unsigned* ctl = (unsigned*)(q_ws + WS_CTL);
    const int* topi = (const int*)(q_ws + WS_TOPI); const float* topp = (const float*)(q_ws + WS_TOPP);
    int* tokrow = (int*)(q_ws + WS_TOKROW); int* rowtok = (int*)(q_ws + WS_ROWTOK); float* rowp = (float*)(q_ws + WS_ROWP);
    LDSP unsigned* base = (LDSP unsigned*)lds;
    LDSP unsigned* tot = base + 32;
    LDSP unsigned* pst = base + 64;
    LDSP unsigned* red = base + 128;
    for (int ch = q_bid; ch < T / 128; ch += gridDim.x) {
        { const int e = q_tid & 31, part = q_tid >> 5; unsigned before = 0, all = 0;
#pragma unroll
          for (int k = 0; k < 16; ++k) { const int c = part * 16 + k; const unsigned v = ctl[CW_CHCNT + c * NE + e]; all += v; before += c < ch ? v : 0u; }
          red[q_tid] = before; red[512 + q_tid] = all; }
        __syncthreads();
        if (q_tid < NE) { unsigned before = 0, all = 0;
#pragma unroll
          for (int k = 0; k < 16; ++k) { before += red[k * 32 + q_tid]; all += red[512 + k * 32 + q_tid]; }
          base[q_tid] = before; tot[q_tid] = all; }
        __syncthreads();
        if (q_tid == 0) { unsigned s = 0; for (int e = 0; e < NE; ++e) { pst[e] = s; s += (tot[e] + 255u) / 256u * 256u; } pst[NE] = s; }
        __syncthreads();
        if (q_tid < NE) base[q_tid] += pst[q_tid];
        __syncthreads();
        { const int tok = ch * 128 + (q_tid >> 2), k = q_tid & 3; const int e = topi[(size_t)tok * 4 + k];
          const unsigned row = __hip_atomic_fetch_add(&base[e], 1u, __ATOMIC_RELAXED, __HIP_MEMORY_SCOPE_WORKGROUP); tokrow[(size_t)tok * 4 + k] = (int)row; rowtok[row] = tok; rowp[row] = topp[(size_t)tok * 4 + k]; }
        if (ch == 0) {
            for (int e = 0; e < NE; ++e) { const unsigned s = pst[e] + tot[e], en = pst[e + 1]; for (unsigned r = s + q_tid; r < en; r += NTHR) { rowtok[r] = 0; rowp[r] = 0.f; } }
            if (q_tid < NE) { ctl[CW_PSTART + q_tid] = pst[q_tid]; for (unsigned tl = pst[q_tid] / 256u; tl < pst[q_tid + 1] / 256u; ++tl) ctl[CW_TILEE + tl] = q_tid; }
            if (q_tid == 0) ctl[CW_NTILES] = pst[NE] / 256u;
        }
        __syncthreads();
    }
}
__device__ __forceinline__ void ph_ln2(const Params& p, int q_wave, int l, float* lds) {
    PH_PROLOGUE
    LDSP float* wig = (LDSP float*)lds; float* IGF = (float*)(q_ws + WS_IGF); unsigned char* XB8 = (unsigned char*)(q_ws + WS_XB8);
    if (l != DEPTH - 1) { __syncthreads(); stage_wig(p.in[1] + (size_t)(l + 1) * D * DIN, wig, q_tid); __syncthreads(); }
    float* X = (float*)(q_ws + WS_X); bf16_t* XB = (bf16_t*)(q_ws + WS_XB); const bf16_t* Y = (const bf16_t*)(q_ws + WS_Y);
    const int* tokrow = (const int*)(q_ws + WS_TOKROW);
    const float* g2 = p.in[24] + l * D; const float* b2 = p.in[25] + l * D;
    const int lane = q_tid & 63, wv = q_tid >> 6;
    const int tstep = gridDim.x * 8; int tok = q_bid * 8 + wv;
    int4 r1 = make_int4(0, 0, 0, 0); u32x4_t xq[2], yq[2][4];
    const bool y8 = l == DEPTH - 1;
#define LN2_LOAD(t_, r_) do { const int rr_[4] = {(r_).x, (r_).y, (r_).z, (r_).w}; _Pragma("unroll") for (int c = 0; c < 2; ++c) { xq[c] = ldnt_u4(XB + (size_t)(t_) * D + c * 512 + lane * 8); \
        _Pragma("unroll") for (int k = 0; k < 4; ++k) { if (y8) { const uint2 t8_ = ldnt_u2((const unsigned char*)Y + (size_t)rr_[k] * D + c * 512 + lane * 8); yq[c][k] = (u32x4_t){t8_.x, t8_.y, 0u, 0u}; } \
            else yq[c][k] = ldnt_u4(Y + (size_t)rr_[k] * D + c * 512 + lane * 8); } } } while (0)
    if (tok < T) { const int4 r0 = *(const int4*)(tokrow + (size_t)tok * 4); if (tok + tstep < T) r1 = *(const int4*)(tokrow + (size_t)(tok + tstep) * 4); LN2_LOAD(tok, r0); }
    int tprev = -1; u32x4_t hb[2] = {}; u32x2_t h8[2] = {}; float hg[8] = {}; f32x4_t ho[4] = {};
#define LN2_FLUSH() do { if (l == DEPTH - 1) { _Pragma("unroll") for (int i = 0; i < 4; ++i) __builtin_nontemporal_store(ho[i], (f32x4_t*)(q_out + (size_t)tprev * D + RC(i))); } \
        else { _Pragma("unroll") for (int c = 0; c < 2; ++c) { *(u32x4_t*)(XB + (size_t)tprev * D + c * 512 + lane * 8) = hb[c]; *(u32x2_t*)(XB8 + (size_t)tprev * D + c * 512 + lane * 8) = h8[c]; } igf_store(hg, IGF, tprev, lane); } } while (0)
    for (; tok < T; tok += tstep) {
        float4 v[4];
#pragma unroll
        for (int c = 0; c < 2; ++c) { float xa[8]; unpack8u(xq[c], xa);
#pragma unroll
            for (int j = 0; j < 8; ++j) xa[j] *= DN_ALPHA;
#pragma unroll
            for (int k = 0; k < 4; ++k) { float ya[8];
                if (y8) { const f32x2_t a0 = __builtin_amdgcn_cvt_pk_f32_fp8((int)yq[c][k][0], false), a1 = __builtin_amdgcn_cvt_pk_f32_fp8((int)yq[c][k][0], true), a2 = __builtin_amdgcn_cvt_pk_f32_fp8((int)yq[c][k][1], false), a3 = __builtin_amdgcn_cvt_pk_f32_fp8((int)yq[c][k][1], true);
                    ya[0] = a0[0] * (1.0f / YSC); ya[1] = a0[1] * (1.0f / YSC); ya[2] = a1[0] * (1.0f / YSC); ya[3] = a1[1] * (1.0f / YSC); ya[4] = a2[0] * (1.0f / YSC); ya[5] = a2[1] * (1.0f / YSC); ya[6] = a3[0] * (1.0f / YSC); ya[7] = a3[1] * (1.0f / YSC); }
                else unpack8u(yq[c][k], ya);
#pragma unroll
                for (int j = 0; j < 8; ++j) xa[j] += ya[j]; }
            v[2 * c] = make_float4(xa[0], xa[1], xa[2], xa[3]); v[2 * c + 1] = make_float4(xa[4], xa[5], xa[6], xa[7]); }
        asm volatile("" : "+v"(v[0].x), "+v"(v[1].x), "+v"(v[2].x), "+v"(v[3].x));
        if (tprev >= 0) LN2_FLUSH();
        if (tok + tstep < T) { const int4 rc = r1; if (tok + 2 * tstep < T) r1 = *(const int4*)(tokrow + (size_t)(tok + 2 * tstep) * 4); LN2_LOAD(tok + tstep, rc); }
        ln_row(v, g2, b2, lane);
        if (l == DEPTH - 1) {
#pragma unroll
            for (int i = 0; i < 4; ++i) ho[i] = (f32x4_t){v[i].x, v[i].y, v[i].z, v[i].w};
        } else {
#pragma unroll
            for (int c = 0; c < 2; ++c) { const float f8[8] = {v[2 * c].x, v[2 * c].y, v[2 * c].z, v[2 * c].w, v[2 * c + 1].x, v[2 * c + 1].y, v[2 * c + 1].z, v[2 * c + 1].w};
                hb[c] = pack8u(f8); h8[c] = (u32x2_t){pk4_fp8(f8[0], f8[1], f8[2], f8[3]), pk4_fp8(f8[4], f8[5], f8[6], f8[7])}; }
            igf_calc(v, wig, lane, hg);
        }
        tprev = tok;
    }
    if (tprev >= 0) LN2_FLUSH();
#undef LN2_FLUSH
#undef LN2_LOAD
}

#define XB_TMO      128
#define XB_XCNT(j)  (256  + 64 * (j))
#define XB_XSUB(j)  (1280 + 64 * (j))
#define XB_XGEN(j)  (2304 + 64 * (j))
#define XB_TOP      3328
#define XB_TOPGEN   3392
#define XCD_BAR_WORDS 3456
#define XB_SPIN_CAP (1u << 22)
#define LAS __attribute__((address_space(3)))
__device__ __forceinline__ unsigned xb_ld(unsigned* p)              { return __hip_atomic_load(p, __ATOMIC_RELAXED, __HIP_MEMORY_SCOPE_AGENT); }
__device__ __forceinline__ unsigned xb_add(unsigned* p, unsigned v) { return __hip_atomic_fetch_add(p, v, __ATOMIC_RELAXED, __HIP_MEMORY_SCOPE_AGENT); }
__device__ __forceinline__ unsigned xb_xcc_id() { return (unsigned)__builtin_amdgcn_s_getreg((3 << 11) | 20) & 0xFu; }
#define XB_SPIN(cond, bar) do { unsigned _sp = 0; while (cond) { __builtin_amdgcn_s_sleep(1); \
    if ((++_sp & 255u) == 0u) { if (xb_ld(&(bar)[XB_TMO])) break; if (_sp > XB_SPIN_CAP) { atomicAdd(&(bar)[XB_TMO], 1u); break; } } } } while (0)
struct XcdBarrier { unsigned* bar; unsigned x; volatile LAS unsigned* st; int wave; };
__device__ __forceinline__ XcdBarrier xcd_barrier_post(unsigned* bar, volatile LAS unsigned* st, int wave) {
    XcdBarrier b; b.bar = bar; b.x = xb_xcc_id(); b.st = st; b.wave = wave;
    if (wave == 0 && lane_id() == 0) (void)xb_add(&bar[XB_XCNT(b.x)], 1u);
    return b;
}
__device__ __forceinline__ void xcd_barrier_complete(unsigned* bar, unsigned x, unsigned& nloc, unsigned& nx) {
    const unsigned G = gridDim.x * gridDim.y * gridDim.z;
    unsigned sum, cnt, mine, sp = 0u;
    for (;;) {
        sum = 0u; cnt = 0u; mine = 0u;
#pragma unroll
        for (unsigned j = 0; j < 16; ++j) { const unsigned c = xb_ld(&bar[XB_XCNT(j)]); sum += c; cnt += (c > 0u) ? 1u : 0u; mine = (j == x) ? c : mine; }
        if (sum == G) break;
        __builtin_amdgcn_s_sleep(1);
        if ((++sp & 255u) == 0u) { if (xb_ld(&bar[XB_TMO])) break; if (sp > XB_SPIN_CAP) { atomicAdd(&bar[XB_TMO], 1u); break; } }
    }
    nloc = mine > 0u ? mine : 1u; nx = cnt > 0u ? cnt : 1u;
}
__device__ __forceinline__ void xcd_barrier(const XcdBarrier& b) {
    asm volatile("s_waitcnt vmcnt(0)" ::: "memory");
    __syncthreads();
    if (b.wave == 0 && lane_id() == 0) {
        unsigned* bar = b.bar;
        __builtin_amdgcn_s_waitcnt(0);
        unsigned nloc = b.st[0], nx = b.st[1];
        if (nloc == 0u) { xcd_barrier_complete(bar, b.x, nloc, nx); b.st[0] = nloc; b.st[1] = nx; }
        const unsigned old = xb_add(&bar[XB_XSUB(b.x)], 1u);
        const unsigned gen = old / nloc;
        if (old + 1u == (gen + 1u) * nloc) {
            __builtin_amdgcn_fence(__ATOMIC_RELEASE, "agent");
            asm volatile("s_waitcnt vmcnt(0)" ::: "memory");
            const unsigned og = xb_add(&bar[XB_TOP], 1u);
            const unsigned tg = og / nx;
            if (og + 1u == (tg + 1u) * nx) xb_add(&bar[XB_TOPGEN], 1u);
            else XB_SPIN(xb_ld(&bar[XB_TOPGEN]) == tg, bar);
            __builtin_amdgcn_fence(__ATOMIC_ACQUIRE, "agent");
            xb_add(&bar[XB_XGEN(b.x)], 1u);
            asm volatile("s_waitcnt vmcnt(0)" ::: "memory");
        } else {
            XB_SPIN(xb_ld(&bar[XB_XGEN(b.x)]) == gen, bar);
            __builtin_amdgcn_fence(__ATOMIC_ACQUIRE, "agent");
            asm volatile("s_waitcnt vmcnt(0)" ::: "memory");
        }
    }
    __syncthreads();
}
constexpr int CW_BAR = 65536;
constexpr int LDS_BYTES = 154112;

__global__ void __launch_bounds__(NTHR, 2) k_mega(Params pk) {
    extern __shared__ __attribute__((aligned(16))) float lds[];
    volatile LAS unsigned* xbw = (volatile LAS unsigned*)((LAS char*)lds + LDS_BYTES - 16);
    const int q_wave = __builtin_amdgcn_readfirstlane((int)(threadIdx.x >> 6));
    if (threadIdx.x == 0) { xbw[0] = 0u; xbw[1] = 0u; xbw[2] = 0u; xbw[3] = 0u; }
    __syncthreads();
    const Params& p = pk;
    (void)xcd_barrier_post((unsigned*)(uni_ptr(pk.ws) + WS_CTL) + CW_BAR, xbw, q_wave);
#define GRID_SYNC() do { XcdBarrier bar_; bar_.bar = (unsigned*)(uni_ptr(pk.ws) + WS_CTL) + CW_BAR; bar_.x = xb_xcc_id(); bar_.st = xbw; bar_.wave = q_wave; xcd_barrier(bar_); } while (0)
#define LAYER_BODY(l) do { \
        if (l == 0) { ph_pre(p, q_wave, l, lds);               GRID_SYNC(); } \
        ph_inproj_mfma(p, q_wave, l, lds);       GRID_SYNC(); \
        ph_ret1(p, q_wave, l, lds); ph_ml1(p, q_wave, l, lds); ph_att(p, q_wave, l, lds);   GRID_SYNC(); \
        ph_ret2(p, q_wave, l); ph_ml2(p, q_wave, l, lds);   GRID_SYNC(); \
        ph_ret3(p, q_wave, l, lds); ph_ml3(p, q_wave, l, lds); ph_att_combine(p, q_wave, l);   GRID_SYNC(); \
        ph_merge_mfma(p, q_wave, l, lds);        GRID_SYNC(); \
        ph_outproj_mfma(p, q_wave, l, lds);      GRID_SYNC(); \
        ph_ln1_router(p, q_wave, l, lds);        GRID_SYNC(); \
        ph_assign(p, q_wave, l, lds); if (l + 1 < DEPTH) ph_prew(p, q_wave, l + 1, lds); ph_mwc_tail(p, q_wave, l, lds);   GRID_SYNC(); \
        ph_moe1_mfma(p, q_wave, l, lds);         GRID_SYNC(); \
        ph_moe2_mfma(p, q_wave, l, lds);         GRID_SYNC(); \
        ph_ln2(p, q_wave, l, lds);               GRID_SYNC(); \
    } while (0)
    LAYER_BODY(0);
    LAYER_BODY(1);
#undef LAYER_BODY
}

}

extern "C" void kernel_launch(void* const* d_in, const int* in_sizes, int n_in, void* d_out, int out_size, void* d_ws, size_t ws_size, hipStream_t stream) {
    if (n_in != 26 || out_size != T * D || ws_size < WS_END) { fprintf(stderr, "kernel_launch: unexpected shapes (n_in %d out %d ws %zu need %zu)\n", n_in, out_size, ws_size, (size_t)WS_END); return; }
    Params p; memset(&p, 0, sizeof(p));
    for (int i = 0; i < 26; ++i) p.in[i] = (const float*)d_in[i];
    p.out = (float*)d_out; p.ws = (char*)d_ws;
    (void)hipMemsetAsync((char*)d_ws + WS_CTL, 0, CTL_BYTES, stream);
    static int grid = 0;
    if (!grid) {
        int dev = 0, cus = 0, per_cu = 0;
        if (hipGetDevice(&dev) != hipSuccess || hipDeviceGetAttribute(&cus, hipDeviceAttributeMultiprocessorCount, dev) != hipSuccess) { fprintf(stderr, "kernel_launch: device query failed\n"); grid = -1; return; }
        (void)hipFuncSetAttribute((const void*)k_mega, hipFuncAttributeMaxDynamicSharedMemorySize, LDS_BYTES);
        if (hipOccupancyMaxActiveBlocksPerMultiprocessor(&per_cu, (const void*)k_mega, NTHR, LDS_BYTES) != hipSuccess || per_cu < 1) { fprintf(stderr, "kernel_launch: occupancy query says %d\n", per_cu); grid = -1; return; }
        grid = cus;
    }
    if (grid < 0) return;
    hipLaunchKernelGGL(k_mega, dim3(grid), dim3(NTHR), LDS_BYTES, stream, p);
}
```

```cpp
#include <hip/hip_runtime.h>
#include <type_traits>
#include <stdint.h>
#include <stdio.h>
#include <string.h>

namespace {
typedef unsigned short bf16_t;
typedef short bf16x8_t __attribute__((ext_vector_type(8)));
typedef short s16x4_t __attribute__((ext_vector_type(4)));
typedef float f32x4_t __attribute__((ext_vector_type(4)));
typedef float f32x2_t __attribute__((ext_vector_type(2)));
typedef unsigned u32x4_t __attribute__((ext_vector_type(4)));
typedef unsigned u32x2_t __attribute__((ext_vector_type(2)));
#define LDSP __attribute__((address_space(3)))
constexpr int D = 1024, BATCH = 2, SEQ = 16384, T = BATCH * SEQ, DEPTH = 2;
constexpr int MIXW = 512, DIN = 8712, NP = 8704, NPP = 5632;
constexpr int C_RQ = 0, C_RK = 256, C_RV = 512, C_RG = 1024, C_MX = 1536, C_MO = 2048, C_AQ = 2560, C_AK = 3328, C_AV = 4096, C_GT = 5632;
constexpr int NE = 32, TOPK = 4, RMAX = 139264  , MAXTILES = 544;
constexpr float DN_ALPHA = 1.41421356237f, LN_EPS = 1e-5f, SWI_LIMIT = 7.0f, SWI_ALPHA = 1.702f;
constexpr int NTHR = 512;
#define RC(i) ((((i) >> 1) * 512) + lane * 8 + (((i) & 1) * 4))
constexpr float WSC_BR = 32.0f;
constexpr float WSC_IN = 32.0f;

constexpr size_t MiB = 1u << 20;
constexpr size_t WS_CTL = 0, CTL_BYTES = 1 * MiB;
constexpr size_t WS_P = WS_CTL + CTL_BYTES;
constexpr size_t P_BYTES = (size_t)T * NP * 2;
constexpr size_t WS_H = WS_P, WS_Y = WS_P + (size_t)RMAX * D * 2;
constexpr size_t WS_G = WS_P + (size_t)T * NPP * 2;
constexpr size_t WS_B = WS_P + P_BYTES;
constexpr size_t B_BYTES = (size_t)NE * 3 * D * D * 2;
constexpr size_t WS_S = WS_B;
constexpr size_t WS_MLC = WS_B + 32 * MiB, WS_MQ = WS_B + 96 * MiB, WS_MK = WS_B + 128 * MiB, WS_MV = WS_B + 160 * MiB;
constexpr size_t WS_X = WS_B + B_BYTES;
constexpr size_t WS_XB = WS_X + (size_t)T * D * 4;
constexpr size_t WS_YR = WS_X, WS_YM = WS_X + (size_t)T * MIXW;
constexpr size_t WS_IGF = WS_XB + (size_t)T * D * 2;
constexpr size_t WS_TOPI = WS_IGF + (size_t)T * 8 * 4;
constexpr size_t WS_TOPP = WS_TOPI + (size_t)T * 4 * 4;
constexpr size_t WS_TOKROW = WS_TOPP + (size_t)T * 4 * 4;
constexpr size_t WS_ROWTOK = WS_TOKROW + (size_t)T * 4 * 4;
constexpr size_t WS_ROWP = WS_ROWTOK + (size_t)RMAX * 4;
constexpr size_t WS_WIN = WS_ROWP + (size_t)RMAX * 4;
constexpr size_t WS_WBT = WS_WIN + (size_t)NP * D * 2;
constexpr size_t WS_WOT = WS_WBT + (size_t)3 * D * MIXW * 2;
constexpr size_t WS_MC = WS_WOT + (size_t)D * D * 2;
constexpr size_t WS_MLN = WS_MC + (size_t)T * MIXW * 2;
constexpr size_t WS_MLS = WS_MLN + (size_t)128 * 8 * 128 * 4;
constexpr size_t WS_LSE = WS_MLS + (size_t)128 * 8 * 4 * 4;
constexpr size_t WS_XB8 = WS_LSE + (size_t)3 * T * 4 * 4;
constexpr size_t WS_GT = WS_XB8 + (size_t)T * D;
constexpr size_t WS_END = WS_GT + (size_t)256 * 4 * 384 * 4;
constexpr size_t DO_MG = 0;
constexpr size_t DO_YA = 3 * (size_t)T * MIXW * 2;
constexpr int CW_CHCNT = 1024;
constexpr int CW_PSTART = 16384;
constexpr int CW_NTILES = 16500;
constexpr int CW_TILEE = 16640;

struct Params {
    const float* in[26];
    float* out;
    char* ws;
};

__device__ __forceinline__ int lane_id() { return (int)__builtin_amdgcn_mbcnt_hi(~0u, __builtin_amdgcn_mbcnt_lo(~0u, 0u)); }
__device__ __forceinline__ int tid_of(int q_wave) { int t = q_wave * 64 + lane_id(); asm volatile("" : "+v"(t)); return t; }
__device__ __forceinline__ float4 ldnt_f4(const float* p) { const f32x4_t v = __builtin_nontemporal_load((const f32x4_t*)p); return make_float4(v[0], v[1], v[2], v[3]); }
__device__ __forceinline__ uint2 ldnt_u2(const void* p) { const u32x2_t v = __builtin_nontemporal_load((const u32x2_t*)p); return make_uint2(v[0], v[1]); }
__device__ __forceinline__ u32x4_t ldnt_u4(const void* p) { return __builtin_nontemporal_load((const u32x4_t*)p); }
__device__ __forceinline__ bf16x8_t ldnt_b8(const bf16_t* p) { return __builtin_nontemporal_load((const bf16x8_t*)p); }
__device__ __forceinline__ float4 ldnt_bf4(const bf16_t* p) { const u32x2_t u = __builtin_nontemporal_load((const u32x2_t*)p); return make_float4(__uint_as_float(u[0] << 16), __uint_as_float(u[0] & 0xffff0000u), __uint_as_float(u[1] << 16), __uint_as_float(u[1] & 0xffff0000u)); }
__device__ __forceinline__ float bf2f(bf16_t b) { return __uint_as_float(((unsigned)b) << 16); }
__device__ __forceinline__ unsigned cvtpk_bf16(float lo, float hi) { unsigned r; asm("v_cvt_pk_bf16_f32 %0, %1, %2" : "=v"(r) : "v"(lo), "v"(hi)); return r; }
__device__ __forceinline__ bf16_t f2bf(float f) { unsigned u = __float_as_uint(f); u += 0x7FFFu + ((u >> 16) & 1u); return (bf16_t)(u >> 16); }
__device__ __forceinline__ unsigned pk4_fp8(float a, float b, float c, float d) { int w = 0; w = __builtin_amdgcn_cvt_pk_fp8_f32(a, b, w, false); w = __builtin_amdgcn_cvt_pk_fp8_f32(c, d, w, true); return (unsigned)w; }
__device__ __forceinline__ float sigmoidf_(float x) { return __builtin_amdgcn_rcpf(1.0f + __expf(-x)); }
__device__ __forceinline__ float wsum(float v) {
#pragma unroll
    for (int o = 32; o > 0; o >>= 1) v += __shfl_xor(v, o);
    return v; }
__device__ __forceinline__ float wmax(float v) {
#pragma unroll
    for (int o = 32; o > 0; o >>= 1) v = fmaxf(v, __shfl_xor(v, o));
    return v; }

__device__ __forceinline__ float4 ld_bf4(const bf16_t* p) { const uint2 u = *(const uint2*)p; return make_float4(__uint_as_float(u.x << 16), __uint_as_float(u.x & 0xffff0000u), __uint_as_float(u.y << 16), __uint_as_float(u.y & 0xffff0000u)); }
__device__ __forceinline__ void st_bf4(bf16_t* p, float4 v) { uint2 u; u.x = cvtpk_bf16(v.x, v.y); u.y = cvtpk_bf16(v.z, v.w); *(uint2*)p = u; }

__device__ __forceinline__ char* uni_ptr(const void* p) { const unsigned long long v = (unsigned long long)p; unsigned lo = __builtin_amdgcn_readfirstlane((unsigned)v), hi = __builtin_amdgcn_readfirstlane((unsigned)(v >> 32)); asm volatile("" : "+s"(lo), "+s"(hi)); return (char*)(__attribute__((address_space(1))) char*)(((unsigned long long)hi << 32) | lo); }
#define PH_PROLOGUE int q_tid = tid_of(q_wave), q_bid = blockIdx.x; asm volatile("" : "+s"(q_bid)); char* q_ws = uni_ptr(p.ws); float* q_out = (float*)uni_ptr(p.out);
namespace pg8 {
#define PG8_LAS __attribute__((address_space(3)))
typedef short bf16x8 __attribute__((ext_vector_type(8)));
typedef float f32x4 __attribute__((ext_vector_type(4)));
typedef unsigned u32x4 __attribute__((ext_vector_type(4)));
constexpr int BM = 256, BK = 64, HALF = 128, HTB = HALF * BK * 2, STAGE_BYTES = 8 * HTB, NXCD = 8, WGM = 8;
__device__ __forceinline__ int lds_byte(int r, int c) { const int st = (r >> 4) * 2 + (c >> 5), rr = r & 15, cc = c & 31, ob = rr * 64 + cc * 2; return st * 1024 + (ob ^ (((ob >> 9) & 1) << 5)); }
__device__ __forceinline__ void stage_rc(int b, int& R, int& C) { const int st = b / 1024, sb = b % 1024, swz = sb ^ (((sb >> 9) & 1) << 5); R = (st >> 1) * 16 + swz / 64; C = (st & 1) * 32 + (swz % 64) / 2; }
__device__ __forceinline__ int perm32(int rho) { const int n = rho >> 4, i = rho & 15; return 8 * (i >> 2) + 4 * n + (i & 3); }
__device__ __forceinline__ unsigned cvt_pk_bf16(float lo, float hi) { unsigned r; asm volatile("v_cvt_pk_bf16_f32 %0, %1, %2" : "=v"(r) : "v"(lo), "v"(hi)); return r; }
typedef int i32x4 __attribute__((ext_vector_type(4)));
typedef int i32x8 __attribute__((ext_vector_type(8)));

struct Unit { const char* a0; const char* a1; const char* b0; const char* b1; int row0, col0, aux; };
template <bool GATHER, bool F8, class Epi, class Sched>
__device__ __forceinline__ void gemm_phase(const int tid, PG8_LAS unsigned char* lds, const int K, const int* __restrict__ rowidx, const Sched& S, const Epi& E) {
    const int wid = __builtin_amdgcn_readfirstlane(tid >> 6), lane = tid & 63, wr = wid >> 2, wc = wid & 3, fr = lane & 15, fq = lane >> 4;
    const int nt = K / BK;
    unsigned voffA[2], voffB[2]; int rA[2];
#pragma unroll
    for (int i = 0; i < 2; ++i) { int R, C; stage_rc(tid * 16 + i * 8192, R, C); const int Rb = Epi::PERM ? ((R & ~31) + perm32(R & 31)) : R;
        voffA[i] = GATHER ? (unsigned)(C * 2) : (unsigned)(R * K + C) * 2u; voffB[i] = (unsigned)(Rb * K + C) * 2u; rA[i] = R; }
    const size_t kstep = (size_t)(BK * 2);
    const unsigned ldsw = (unsigned)wid * 1024u;
    const int aoff = lds_byte(wr * 64 + fr, fq * 8), boff = lds_byte(wc * 32 + fr, fq * 8);
#define PG8_SA(b, h) (((b) * 2 + (h)) * HTB)
#define PG8_SB(b, h) ((4 + (b) * 2 + (h)) * HTB)
#define PG8_STAGE(bufoff, gbase, v0, v1) do { \
        __builtin_amdgcn_global_load_lds((const unsigned*)((const char*)(gbase) + (v0)), (PG8_LAS unsigned*)(lds + (bufoff) + ldsw), 16, 0, 0); \
        __builtin_amdgcn_global_load_lds((const unsigned*)((const char*)(gbase) + (v1)), (PG8_LAS unsigned*)(lds + (bufoff) + ldsw + 8192), 16, 0, 0); } while (0)
#define PG8_LDA(dst, b, h) do { _Pragma("unroll") for (int m = 0; m < 4; ++m) { const i32x4 lo_ = *(const PG8_LAS i32x4*)(lds + PG8_SA(b, h) + aoff + m * 2048), hi_ = *(const PG8_LAS i32x4*)(lds + PG8_SA(b, h) + aoff + m * 2048 + 1024); \
        dst[m] = __builtin_shufflevector(lo_, hi_, 0, 1, 2, 3, 4, 5, 6, 7); } } while (0)
#define PG8_LDB(dst, b, h) do { _Pragma("unroll") for (int n = 0; n < 2; ++n) { const i32x4 lo_ = *(const PG8_LAS i32x4*)(lds + PG8_SB(b, h) + boff + n * 2048), hi_ = *(const PG8_LAS i32x4*)(lds + PG8_SB(b, h) + boff + n * 2048 + 1024); \
        dst[n] = __builtin_shufflevector(lo_, hi_, 0, 1, 2, 3, 4, 5, 6, 7); } } while (0)
#define PG8_LO(v) __builtin_bit_cast(bf16x8, (i32x4)__builtin_shufflevector(v, v, 0, 1, 2, 3))
#define PG8_HI(v) __builtin_bit_cast(bf16x8, (i32x4)__builtin_shufflevector(v, v, 4, 5, 6, 7))
#define PG8_MMA(ai, bj, At, Bt) do { __builtin_amdgcn_s_setprio(1); \
        if constexpr (F8) { _Pragma("unroll") for (int m = 0; m < 4; ++m) _Pragma("unroll") for (int n = 0; n < 2; ++n) \
            asm volatile("v_mfma_scale_f32_16x16x128_f8f6f4 %0, %1, %2, %0, %3, %3 op_sel_hi:[0,0,0]" : "+v"(acc[ai][bj][m][n]) : "v"(Bt[n]), "v"(At[m]), "v"(sc1)); } \
        else { _Pragma("unroll") for (int m = 0; m < 4; ++m) _Pragma("unroll") for (int n = 0; n < 2; ++n) { \
            acc[ai][bj][m][n] = __builtin_amdgcn_mfma_f32_16x16x32_bf16(PG8_LO(Bt[n]), PG8_LO(At[m]), acc[ai][bj][m][n], 0, 0, 0); \
            acc[ai][bj][m][n] = __builtin_amdgcn_mfma_f32_16x16x32_bf16(PG8_HI(Bt[n]), PG8_HI(At[m]), acc[ai][bj][m][n], 0, 0, 0); } } \
        __builtin_amdgcn_s_setprio(0); } while (0)
#define PG8_WAIT_V(n) asm volatile("s_waitcnt vmcnt(" #n ")" ::: "memory")
#define PG8_WAIT_L(n) asm volatile("s_waitcnt lgkmcnt(" #n ")" ::: "memory")
#define PG8_BAR __builtin_amdgcn_s_barrier()
#define PG8_SCHED __builtin_amdgcn_sched_barrier(0)
    int sc1 = 0x7f7f7f7f; asm volatile("" : "+v"(sc1));
    Unit cur, nxt; int ui = 0;
    if (!S.next(0, cur)) return;
    f32x4 acc[2][2][4][2];
#pragma unroll
    for (int a = 0; a < 2; ++a)
#pragma unroll
        for (int b = 0; b < 2; ++b)
#pragma unroll
            for (int m = 0; m < 4; ++m)
#pragma unroll
                for (int n = 0; n < 2; ++n) acc[a][b][m][n] = (f32x4){0.f, 0.f, 0.f, 0.f};
    i32x8 At[4], B0[2], B1[2];
    unsigned cA00 = voffA[0], cA01 = voffA[1], cA10 = voffA[0], cA11 = voffA[1], nA00 = voffA[0], nA01 = voffA[1], nA10 = voffA[0], nA11 = voffA[1];
    if (GATHER) { const int* ix = rowidx + cur.row0;
        cA00 = (unsigned)ix[rA[0]] * (unsigned)(K * 2) + voffA[0]; cA01 = (unsigned)ix[rA[1]] * (unsigned)(K * 2) + voffA[1];
        cA10 = (unsigned)ix[128 + rA[0]] * (unsigned)(K * 2) + voffA[0]; cA11 = (unsigned)ix[128 + rA[1]] * (unsigned)(K * 2) + voffA[1]; }
    PG8_STAGE(PG8_SB(0, 0), cur.b0, voffB[0], voffB[1]); PG8_STAGE(PG8_SA(0, 0), cur.a0, cA00, cA01); PG8_STAGE(PG8_SB(0, 1), cur.b1, voffB[0], voffB[1]); PG8_STAGE(PG8_SA(0, 1), cur.a1, cA10, cA11);
    if (wr == 1) PG8_BAR;
    PG8_WAIT_V(4); PG8_BAR;
    PG8_STAGE(PG8_SB(1, 0), cur.b0 + kstep, voffB[0], voffB[1]); PG8_STAGE(PG8_SA(1, 0), cur.a0 + kstep, cA00, cA01); PG8_STAGE(PG8_SB(1, 1), cur.b1 + kstep, voffB[0], voffB[1]);
    PG8_WAIT_V(6); PG8_BAR;
    for (;;) {
        const bool has_next = S.next(ui + 1, nxt);
        if (!has_next) nxt = cur;
        if (GATHER) { const int* ix = rowidx + nxt.row0;
            nA00 = (unsigned)ix[rA[0]] * (unsigned)(K * 2) + voffA[0]; nA01 = (unsigned)ix[rA[1]] * (unsigned)(K * 2) + voffA[1];
            nA10 = (unsigned)ix[128 + rA[0]] * (unsigned)(K * 2) + voffA[0]; nA11 = (unsigned)ix[128 + rA[1]] * (unsigned)(K * 2) + voffA[1]; }
#pragma unroll 1
        for (int t = 0; t < nt; t += 2) {
            const bool last = (t == nt - 2);
            const char* a1h1 = cur.a1 + (size_t)(t + 1) * kstep;
            const char* a2h0 = last ? nxt.a0 : cur.a0 + (size_t)(t + 2) * kstep; const char* a2h1 = last ? nxt.a1 : cur.a1 + (size_t)(t + 2) * kstep;
            const char* b2h0 = last ? nxt.b0 : cur.b0 + (size_t)(t + 2) * kstep; const char* b2h1 = last ? nxt.b1 : cur.b1 + (size_t)(t + 2) * kstep;
            const unsigned x00 = (GATHER && last) ? nA00 : cA00, x01 = (GATHER && last) ? nA01 : cA01, x10 = (GATHER && last) ? nA10 : cA10, x11 = (GATHER && last) ? nA11 : cA11;
            PG8_LDB(B0, 0, 0); PG8_SCHED; PG8_LDA(At, 0, 0); PG8_STAGE(PG8_SA(1, 1), a1h1, cA10, cA11);
            PG8_WAIT_L(8); PG8_BAR; PG8_WAIT_L(0); PG8_MMA(0, 0, At, B0); PG8_BAR; PG8_SCHED;
            PG8_LDB(B1, 0, 1); PG8_STAGE(PG8_SB(0, 0), b2h0, voffB[0], voffB[1]);
            PG8_BAR; PG8_WAIT_L(0); PG8_MMA(0, 1, At, B1); PG8_BAR;
            PG8_LDA(At, 0, 1); PG8_STAGE(PG8_SA(0, 0), a2h0, x00, x01);
            PG8_BAR; PG8_WAIT_L(0); PG8_MMA(1, 0, At, B0); PG8_BAR; PG8_SCHED;
            PG8_STAGE(PG8_SB(0, 1), b2h1, voffB[0], voffB[1]);
            PG8_WAIT_V(6); PG8_BAR; PG8_MMA(1, 1, At, B1); PG8_BAR;
            PG8_LDB(B0, 1, 0); PG8_SCHED; PG8_LDA(At, 1, 0); PG8_STAGE(PG8_SA(0, 1), a2h1, x10, x11);
            PG8_WAIT_L(8); PG8_BAR; PG8_WAIT_L(0); PG8_MMA(0, 0, At, B0); PG8_BAR; PG8_SCHED;
            PG8_LDB(B1, 1, 1); PG8_STAGE(PG8_SB(1, 0), b2h0 + kstep, voffB[0], voffB[1]);
            PG8_BAR; PG8_WAIT_L(0); PG8_MMA(0, 1, At, B1); PG8_BAR;
            PG8_LDA(At, 1, 1); PG8_STAGE(PG8_SA(1, 0), a2h0 + kstep, x00, x01);
            PG8_BAR; PG8_WAIT_L(0); PG8_MMA(1, 0, At, B0); PG8_BAR; PG8_SCHED;
            PG8_STAGE(PG8_SB(1, 1), b2h1 + kstep, voffB[0], voffB[1]);
            PG8_WAIT_V(6); PG8_BAR; PG8_MMA(1, 1, At, B1); PG8_BAR;
        }
        if constexpr (F8) asm volatile("s_nop 15\n\ts_nop 15" ::: "memory");
        E(acc, cur, wr, wc, fr, fq);
        if (!has_next) break;
#pragma unroll
        for (int a = 0; a < 2; ++a)
#pragma unroll
            for (int b = 0; b < 2; ++b)
#pragma unroll
                for (int m = 0; m < 4; ++m)
#pragma unroll
                    for (int n = 0; n < 2; ++n) acc[a][b][m][n] = (f32x4){0.f, 0.f, 0.f, 0.f};
        cur = nxt; cA00 = nA00; cA01 = nA01; cA10 = nA10; cA11 = nA11; ++ui;
    }
    PG8_WAIT_V(0);
    if (wr == 0) PG8_BAR;
    PG8_BAR;
#undef PG8_SA
#undef PG8_SB
#undef PG8_STAGE
#undef PG8_LDA
#undef PG8_LDB
#undef PG8_LO
#undef PG8_HI
#undef PG8_MMA
#undef PG8_WAIT_V
#undef PG8_WAIT_L
#undef PG8_BAR
#undef PG8_SCHED
}
struct GridOrder {
    int nM, nN, nwg, G, c;
    __device__ __forceinline__ bool locate(int i, int& pm, int& pn) const {
        const long L = (long)i * G + c; if (L >= nwg) return false;
        int wgid = (int)L; { const int q = nwg / NXCD, r = nwg % NXCD, xcd = wgid % NXCD, off = wgid / NXCD; wgid = (xcd < r ? xcd * (q + 1) : r * (q + 1) + (xcd - r) * q) + off; }
        const int nig = WGM * nN, gid = wgid / nig, fm = gid * WGM, gsz = (nM - fm) < WGM ? (nM - fm) : WGM;
        pm = fm + ((wgid % nig) % gsz); pn = (wgid % nig) / gsz; return true;
    }
};
}

__device__ __forceinline__ void cvt_load(int q_tid, const float* src, int ldn, float4& va, float4& vb) {
    const int k = q_tid >> 4, n4 = (q_tid & 15) * 4; va = ldnt_f4(src + (size_t)k * ldn + n4); vb = ldnt_f4(src + (size_t)(k + 32) * ldn + n4); }
__device__ __forceinline__ void cvt_tile(int q_tid, LDSP bf16_t* tl, const float4 va, const float4 vb, bf16_t* dst, int K, int k0) {
    __syncthreads();
#pragma unroll
    for (int h = 0; h < 2; ++h) { const int k = (q_tid >> 4) + h * 32, nq = q_tid & 15, n4 = nq * 4; const float4 v = h ? vb : va;
        const int ko = ((((k >> 3) ^ (nq & 7)) << 3) | (k & 7));
        tl[(n4 + 0) * 64 + ko] = f2bf(v.x); tl[(n4 + 1) * 64 + ko] = f2bf(v.y); tl[(n4 + 2) * 64 + ko] = f2bf(v.z); tl[(n4 + 3) * 64 + ko] = f2bf(v.w); }
    __syncthreads();
    { const int n = q_tid >> 3, kc = q_tid & 7; *(u32x4_t*)(dst + (size_t)n * K + k0 + kc * 8) = *(const LDSP u32x4_t*)(tl + n * 64 + ((kc ^ ((n >> 2) & 7)) << 3)); }
}

__device__ __forceinline__ void cvt_tile8(int q_tid, LDSP unsigned char* tl, const float4 va, const float4 vb, unsigned char* dst, int K, int k0, float sc) {
    const int k = q_tid >> 4, nq = q_tid & 15, n4 = nq * 4;
    __syncthreads();
    { const unsigned wa = pk4_fp8(va.x * sc, va.y * sc, va.z * sc, va.w * sc), wb = pk4_fp8(vb.x * sc, vb.y * sc, vb.z * sc, vb.w * sc);
      const int ko = ((((k >> 4) ^ (nq & 3)) << 4) | (k & 15)), ko2 = (((((k + 32) >> 4) ^ (nq & 3)) << 4) | (k & 15));
#pragma unroll
      for (int j = 0; j < 4; ++j) { tl[(n4 + j) * 64 + ko] = (unsigned char)(wa >> (8 * j)); tl[(n4 + j) * 64 + ko2] = (unsigned char)(wb >> (8 * j)); } }
    __syncthreads();
    if (q_tid < 256) { const int n = q_tid >> 2, kc = q_tid & 3; *(u32x4_t*)(dst + (size_t)n * K + k0 + kc * 16) = *(const LDSP u32x4_t*)(tl + n * 64 + ((kc ^ ((n >> 2) & 3)) << 4)); }
}
__device__ __forceinline__ void pre_weights(const Params& p, char* q_ws, int l, float* lds, int q_tid, int q_bid) {
    LDSP bf16_t* tl = (LDSP bf16_t*)lds;
    const float* W = p.in[1] + (size_t)l * D * DIN; const float* WB = p.in[12] + (size_t)l * 3 * MIXW * D; const float* WO = p.in[13] + (size_t)l * D * D;
    bf16_t* WBT = (bf16_t*)(q_ws + WS_WBT); bf16_t* WOT = (bf16_t*)(q_ws + WS_WOT);
    for (int ub = q_bid; ub < 2816; ub += 4 * gridDim.x) {
        float4 va[4], vb[4];
#pragma unroll
        for (int j = 0; j < 4; ++j) { const int u = ub + j * gridDim.x;
            if (u < 2176) { const int n0 = (u >> 4) * 64, kt = u & 15; cvt_load(q_tid, W + n0 + (n0 >= 2048 ? 8 : 0) + (size_t)(kt * 64) * DIN, DIN, va[j], vb[j]); }
            else if (u < 2560) { const int v = u - 2176, br = v >> 7, r = v & 127, n0 = (r >> 3) * 64, kt = r & 7; cvt_load(q_tid, WB + (size_t)br * MIXW * D + n0 + (size_t)(kt * 64) * D, D, va[j], vb[j]); }
            else if (u < 2816) { const int v = u - 2560, n0 = (v >> 4) * 64, kt = v & 15; cvt_load(q_tid, WO + n0 + (size_t)(kt * 64) * D, D, va[j], vb[j]); } }
#pragma unroll
        for (int j = 0; j < 4; ++j) { const int u = ub + j * gridDim.x;
            if (u < 2176) { const int n0 = (u >> 4) * 64, kt = u & 15; cvt_tile8(q_tid, (LDSP unsigned char*)lds, va[j], vb[j], (unsigned char*)(q_ws + WS_WIN) + (size_t)n0 * D, D, kt * 64, WSC_IN); }
            else if (u < 2560) { const int v = u - 2176, br = v >> 7, r = v & 127, n0 = (r >> 3) * 64, kt = r & 7; cvt_tile8(q_tid, (LDSP unsigned char*)lds, va[j], vb[j], (unsigned char*)WBT + ((size_t)br * D + n0) * MIXW, MIXW, kt * 64, WSC_BR); }
            else if (u < 2816) { const int v = u - 2560, n0 = (v >> 4) * 64, kt = v & 15; cvt_tile(q_tid, tl, va[j], vb[j], WOT + (size_t)n0 * D, D, kt * 64); } }
    }
    __syncthreads();
}
__device__ __forceinline__ void ph_prew(const Params& p, int q_wave, int l, float* lds) { PH_PROLOGUE pre_weights(p, q_ws, l, lds, q_tid, q_bid); }
__device__ __forceinline__ void stage_wig(const float* W, LDSP float* wig, int q_tid) {
    float4 t[2][2];
#pragma unroll
    for (int j = 0; j < 2; ++j) { const float* src = W + (size_t)(q_tid + j * NTHR) * DIN + 2048; t[j][0] = *(const float4*)src; t[j][1] = *(const float4*)(src + 4); }
#pragma unroll
    for (int j = 0; j < 2; ++j) { const int c = q_tid + j * NTHR; wig[c] = t[j][0].x; wig[1024 + c] = t[j][0].y; wig[2048 + c] = t[j][0].z; wig[3072 + c] = t[j][0].w; wig[4096 + c] = t[j][1].x; wig[5120 + c] = t[j][1].y; wig[6144 + c] = t[j][1].z; wig[7168 + c] = t[j][1].w; }
}
__device__ __forceinline__ void igf_calc(const float4 (&v)[4], const LDSP float* wig, int lane, float (&a8)[8]) {
#pragma unroll
    for (int k = 0; k < 8; ++k) a8[k] = 0.f;
#pragma unroll
    for (int i = 0; i < 4; ++i)
#pragma unroll
        for (int k = 0; k < 8; ++k) { const f32x4_t w = *(const LDSP f32x4_t*)(wig + k * 1024 + RC(i)); a8[k] += v[i].x * w[0] + v[i].y * w[1] + v[i].z * w[2] + v[i].w * w[3]; }
#pragma unroll
    for (int k = 0; k < 8; ++k) a8[k] = wsum(a8[k]);
}
__device__ __forceinline__ void igf_store(const float (&a8)[8], float* IGF, int tok, int lane) {
    if (lane == 0) { *(float4*)(IGF + (size_t)tok * 8) = make_float4(a8[0], a8[1], a8[2], a8[3]); *(float4*)(IGF + (size_t)tok * 8 + 4) = make_float4(a8[4], a8[5], a8[6], a8[7]); }
}
__device__ __forceinline__ void igf_row(const float4 (&v)[4], const LDSP float* wig, float* IGF, int tok, int lane) {
    float a8[8];
#pragma unroll
    for (int k = 0; k < 8; ++k) a8[k] = 0.f;
#pragma unroll
    for (int i = 0; i < 4; ++i)
#pragma unroll
        for (int k = 0; k < 8; ++k) { const f32x4_t w = *(const LDSP f32x4_t*)(wig + k * 1024 + RC(i)); a8[k] += v[i].x * w[0] + v[i].y * w[1] + v[i].z * w[2] + v[i].w * w[3]; }
#pragma unroll
    for (int k = 0; k < 8; ++k) a8[k] = wsum(a8[k]);
    if (lane == 0) { *(float4*)(IGF + (size_t)tok * 8) = make_float4(a8[0], a8[1], a8[2], a8[3]); *(float4*)(IGF + (size_t)tok * 8 + 4) = make_float4(a8[4], a8[5], a8[6], a8[7]); }
}
__device__ __forceinline__ void ph_pre(const Params& p, int q_wave, int l, float* lds) {
    PH_PROLOGUE
    LDSP float* wig = (LDSP float*)lds + 4096;
    stage_wig(p.in[1] + (size_t)l * D * DIN, wig, q_tid);
    pre_weights(p, q_ws, l, lds, q_tid, q_bid);
    __syncthreads();
    const float* X = p.in[0]; unsigned char* XB8 = (unsigned char*)(q_ws + WS_XB8); float* IGF = (float*)(q_ws + WS_IGF);
    const int lane = q_tid & 63, wv = q_tid >> 6;
    float4 v[4], vn[4];
    { const int tok0 = q_bid * 8 + wv;
#pragma unroll
      for (int i = 0; i < 4; ++i) v[i] = ldnt_f4(X + (size_t)tok0 * D + RC(i)); }
    for (int tok = q_bid * 8 + wv; tok < T; tok += gridDim.x * 8) {
        const int tn = tok + gridDim.x * 8 < T ? tok + gridDim.x * 8 : tok;
#pragma unroll
        for (int i = 0; i < 4; ++i) vn[i] = ldnt_f4(X + (size_t)tn * D + RC(i));
#pragma unroll
        for (int i = 0; i < 4; ++i) *(unsigned*)(XB8 + (size_t)tok * D + RC(i)) = pk4_fp8(v[i].x, v[i].y, v[i].z, v[i].w);
        igf_row(v, wig, IGF, tok, lane);
#pragma unroll
        for (int i = 0; i < 4; ++i) v[i] = vn[i];
    }
}

struct EpiStoreBf16 {
    static constexpr bool PERM = true;
    bf16_t* O; bf16_t* G; int ldc; float sc;
    __device__ __forceinline__ void operator()(const pg8::f32x4 (&acc)[2][2][4][2], const pg8::Unit& u, int wr, int wc, int fr, int fq) const {
        const bool gate = u.col0 >= C_GT; const int j = (u.col0 - C_GT) >> 8;
        unsigned char* gt = (unsigned char*)G + ((size_t)((u.row0 >> 8) * 12 + j) << 16) + (size_t)(wr * 4 + wc) * 8192 + (fq * 16 + fr) * 16;
        const int lane = fq * 16 + fr, pr = lane >> 2, pq = lane & 3, srcl = (pq * 16 + pr) * 4;
        bf16_t* prow = O + (size_t)(u.row0 + wr * 64 + pr) * ldc + u.col0 + wc * 32 + 8 * pq;
        if (gate) {
#pragma unroll
            for (int ai = 0; ai < 2; ++ai)
#pragma unroll
                for (int m = 0; m < 4; ++m) { pg8::u32x4 w;
                    { const pg8::f32x4 v0 = acc[ai][0][m][0] * sc, v1 = acc[ai][0][m][1] * sc; w.x = pk4_fp8(v0[0], v0[1], v0[2], v0[3]); w.y = pk4_fp8(v1[0], v1[1], v1[2], v1[3]); }
                    { const pg8::f32x4 v0 = acc[ai][1][m][0] * sc, v1 = acc[ai][1][m][1] * sc; w.z = pk4_fp8(v0[0], v0[1], v0[2], v0[3]); w.w = pk4_fp8(v1[0], v1[1], v1[2], v1[3]); }
                    __builtin_nontemporal_store(w, (pg8::u32x4*)(gt + (ai * 4 + m) * 1024)); }
            return; }
#pragma unroll
        for (int ai = 0; ai < 2; ++ai)
#pragma unroll
            for (int m = 0; m < 4; ++m) {
#pragma unroll
                for (int bj = 0; bj < 2; ++bj) { const pg8::f32x4 v0 = acc[ai][bj][m][0] * sc, v1 = acc[ai][bj][m][1] * sc;
                    pg8::u32x4 w; w.x = pg8::cvt_pk_bf16(v0[0], v0[1]); w.y = pg8::cvt_pk_bf16(v0[2], v0[3]); w.z = pg8::cvt_pk_bf16(v1[0], v1[1]); w.w = pg8::cvt_pk_bf16(v1[2], v1[3]);
                    pg8::u32x4 x; x.x = (unsigned)__builtin_amdgcn_ds_bpermute(srcl, (int)w.x); x.y = (unsigned)__builtin_amdgcn_ds_bpermute(srcl, (int)w.y); x.z = (unsigned)__builtin_amdgcn_ds_bpermute(srcl, (int)w.z); x.w = (unsigned)__builtin_amdgcn_ds_bpermute(srcl, (int)w.w);
                    *(pg8::u32x4*)(prow + (size_t)(ai * 128 + m * 16) * ldc + bj * 128) = x; } }
    }
};
struct SchedGrid {
    pg8::GridOrder g; const char* A; const char* B; int K;
    __device__ __forceinline__ bool next(int i, pg8::Unit& u) const { int pm, pn; if (!g.locate(i, pm, pn)) return false;
        u.a0 = A + (size_t)pm * 256 * K * 2; u.a1 = u.a0 + (size_t)128 * K * 2; u.b0 = B + (size_t)pn * 256 * K * 2; u.b1 = u.b0 + (size_t)128 * K * 2; u.row0 = pm * 256; u.col0 = pn * 256; u.aux = 0; return true; }
};
__device__ __forceinline__ void ph_inproj_mfma(const Params& p, int q_wave, int l, float* lds) {
    PH_PROLOGUE
    SchedGrid S; S.g.nM = T / 256; S.g.nN = NP / 256; S.g.nwg = S.g.nM * S.g.nN; S.g.G = gridDim.x; S.g.c = q_bid; S.A = q_ws + WS_XB8; S.B = q_ws + WS_WIN; S.K = D / 2;
    EpiStoreBf16 E; E.O = (bf16_t*)(q_ws + WS_P); E.ldc = NPP; E.G = (bf16_t*)(q_ws + WS_G); E.sc = 1.0f / WSC_IN;
    pg8::gemm_phase<false, true>(q_tid, (PG8_LAS unsigned char*)lds, D / 2, nullptr, S, E);
}

struct SchedMerge {
    pg8::GridOrder g; const char* Y0; const char* Y1; const char* Y2; const char* B;
    __device__ __forceinline__ bool next(int i, pg8::Unit& u) const { const int j = i / 3, br = i - 3 * j; int pm, pn; if (!g.locate(j, pm, pn)) return false;
        const char* Y = Y0 + (size_t)br * ((size_t)T * MIXW); if (br == 2) Y = Y2;
        u.a0 = Y + (size_t)pm * 256 * MIXW; u.a1 = u.a0 + (size_t)128 * MIXW; u.b0 = B + ((size_t)br * D + (size_t)pn * 256) * MIXW; u.b1 = u.b0 + (size_t)128 * MIXW;
        u.row0 = pm * 256; u.col0 = pn * 256; u.aux = br; return true; }
};
__device__ __forceinline__ void unpack8(const pg8::u32x4 w, float (&f)[8]) {
    f[0] = __uint_as_float(w.x << 16); f[1] = __uint_as_float(w.x & 0xffff0000u); f[2] = __uint_as_float(w.y << 16); f[3] = __uint_as_float(w.y & 0xffff0000u);
    f[4] = __uint_as_float(w.z << 16); f[5] = __uint_as_float(w.z & 0xffff0000u); f[6] = __uint_as_float(w.w << 16); f[7] = __uint_as_float(w.w & 0xffff0000u); }
struct EpiMerge {
    static constexpr bool PERM = true;
    const bf16_t* G; bf16_t* S; bf16_t* MG;
    __device__ __forceinline__ void operator()(const pg8::f32x4 (&acc)[2][2][4][2], const pg8::Unit& u, int wr, int wc, int fr, int fq) const {
        const int row0 = u.row0 + wr * 64 + fr, col0 = u.col0 + wc * 32 + 8 * fq, br = u.aux, pm = u.row0 >> 8, pn = u.col0 >> 8;
        const size_t lo = (size_t)(wr * 4 + wc) * 8192 + (fq * 16 + fr) * 8;
        const unsigned char* gp = (const unsigned char*)G + ((size_t)(pm * 12 + br * 4 + pn) << 16) + (size_t)(wr * 4 + wc) * 8192 + (fq * 16 + fr) * 16; bf16_t* sp = S + ((size_t)(pm * 4 + pn) << 16) + lo; bf16_t* mp = MG + (size_t)row0 * D + col0;
        pg8::u32x4 gq[4], mq[4][2];
#define MERGE_LOAD(k, s) do { gq[s] = __builtin_nontemporal_load((const pg8::u32x4*)(gp + (k) * 1024)); \
            if (br > 0) { mq[s][0] = __builtin_nontemporal_load((const pg8::u32x4*)(sp + (k) * 1024)); mq[s][1] = __builtin_nontemporal_load((const pg8::u32x4*)(sp + (k) * 1024 + 512)); } } while (0)
        MERGE_LOAD(0, 0); MERGE_LOAD(1, 1); MERGE_LOAD(2, 2);
#pragma unroll
        for (int k = 0; k < 8; ++k) { const int ai = k >> 2, m = k & 3, sl = k & 3;
            if (k < 5) { if (((k + 3) & 3) == 0) MERGE_LOAD(k + 3, 0); else if (((k + 3) & 3) == 1) MERGE_LOAD(k + 3, 1); else if (((k + 3) & 3) == 2) MERGE_LOAD(k + 3, 2); else MERGE_LOAD(k + 3, 3); }
            asm volatile("" ::: "memory");
#pragma unroll
            for (int bj = 0; bj < 2; ++bj) { float g[8], o[8]; { const unsigned w0 = bj ? gq[sl].z : gq[sl].x, w1 = bj ? gq[sl].w : gq[sl].y;
                    const f32x2_t a0 = __builtin_amdgcn_cvt_pk_f32_fp8((int)w0, false), a1 = __builtin_amdgcn_cvt_pk_f32_fp8((int)w0, true), a2 = __builtin_amdgcn_cvt_pk_f32_fp8((int)w1, false), a3 = __builtin_amdgcn_cvt_pk_f32_fp8((int)w1, true);
                    g[0] = a0[0]; g[1] = a0[1]; g[2] = a1[0]; g[3] = a1[1]; g[4] = a2[0]; g[5] = a2[1]; g[6] = a3[0]; g[7] = a3[1]; }
                if (br > 0) unpack8(mq[sl][bj], o); else {
#pragma unroll
                    for (int j = 0; j < 8; ++j) o[j] = 0.f; }
                const pg8::f32x4 v0 = acc[ai][bj][m][0] * (1.0f / WSC_BR), v1 = acc[ai][bj][m][1] * (1.0f / WSC_BR);
#pragma unroll
                for (int j = 0; j < 4; ++j) { o[j] += sigmoidf_(g[j]) * v0[j]; o[4 + j] += sigmoidf_(g[4 + j]) * v1[j]; }
                pg8::u32x4 w; w.x = pg8::cvt_pk_bf16(o[0], o[1]); w.y = pg8::cvt_pk_bf16(o[2], o[3]); w.z = pg8::cvt_pk_bf16(o[4], o[5]); w.w = pg8::cvt_pk_bf16(o[6], o[7]);
                if (br < 2) *(pg8::u32x4*)(sp + k * 1024 + bj * 512) = w; else *(pg8::u32x4*)(mp + (size_t)(ai * 128 + m * 16) * D + bj * 128) = w; }
            asm volatile("" ::: "memory"); }
#undef MERGE_LOAD
    }
};
__device__ __forceinline__ void ph_merge_mfma(const Params& p, int q_wave, int l, float* lds) {
    PH_PROLOGUE
    SchedMerge S; S.g.nM = T / 256; S.g.nN = D / 256; S.g.nwg = S.g.nM * S.g.nN; S.g.G = gridDim.x; S.g.c = q_bid;
    S.Y0 = q_ws + WS_YR; S.Y1 = q_ws + WS_YM; S.Y2 = (const char*)q_out + DO_YA; S.B = q_ws + WS_WBT;
    EpiMerge E; E.G = (const bf16_t*)(q_ws + WS_G); E.S = (bf16_t*)(q_ws + WS_S); E.MG = (bf16_t*)((char*)q_out + DO_MG);
    pg8::gemm_phase<false, true>(q_tid, (PG8_LAS unsigned char*)lds, MIXW / 2, nullptr, S, E);
}
template <bool RESBF> struct EpiOut {
    static constexpr bool PERM = false;
    const float* XR; const bf16_t* XRB; float* X;
    typedef typename std::conditional<RESBF, u32x2_t, pg8::f32x4>::type raw_t;
    static constexpr int NST = RESBF ? 8 : 4;
    __device__ __forceinline__ raw_t ldraw(size_t o) const { if constexpr (RESBF) return *(const u32x2_t*)(XRB + o); else return __builtin_nontemporal_load((const pg8::f32x4*)(XR + o)); }
    static __device__ __forceinline__ pg8::f32x4 cvres(const raw_t w) { if constexpr (RESBF) return (pg8::f32x4){__uint_as_float(w.x << 16), __uint_as_float(w.x & 0xffff0000u), __uint_as_float(w.y << 16), __uint_as_float(w.y & 0xffff0000u)}; else return w; }
    __device__ __forceinline__ void operator()(const pg8::f32x4 (&acc)[2][2][4][2], const pg8::Unit& u, int wr, int wc, int fr, int fq) const {
        const int row0 = u.row0 + wr * 64 + fr, col0 = u.col0 + wc * 32 + 4 * fq;
        const size_t base = (size_t)row0 * D + col0; float* op = X + base;
        raw_t xq[NST][4];
#define OUT_LOAD(k, s) do { const size_t ro = base + (size_t)(((k) >> 2) * 128 + ((k) & 3) * 16) * D; \
            xq[s][0] = ldraw(ro); xq[s][1] = ldraw(ro + 16); xq[s][2] = ldraw(ro + 128); xq[s][3] = ldraw(ro + 144); } while (0)
#pragma unroll
        for (int k = 0; k < NST - 1; ++k) OUT_LOAD(k, k);
#pragma unroll
        for (int k = 0; k < 8; ++k) { const int ai = k >> 2, m = k & 3, sl = k % NST; const size_t ro = (size_t)(ai * 128 + m * 16) * D;
            if (k + NST - 1 < 8) OUT_LOAD(k + NST - 1, (k + NST - 1) % NST);
            asm volatile("" ::: "memory");
#pragma unroll
            for (int bj = 0; bj < 2; ++bj)
#pragma unroll
                for (int n = 0; n < 2; ++n) *(pg8::f32x4*)(op + ro + bj * 128 + n * 16) = cvres(xq[sl][bj * 2 + n]) * DN_ALPHA + acc[ai][bj][m][n];
            asm volatile("" ::: "memory"); }
#undef OUT_LOAD
    }
};
constexpr float WSC_GU = 32.0f, WSC_DN = 64.0f;
__device__ __forceinline__ void moe_weight_convert(const Params& p, char* q_ws, int l, float* lds, int q_tid, int q_bid, int u_lo, int u_hi) {
    LDSP unsigned char* tl = (LDSP unsigned char*)lds; unsigned char* WM = (unsigned char*)(q_ws + WS_B);
    const int k = q_tid >> 4, nq = q_tid & 15, n4 = nq * 4;
    float4 v[8];
#define MWC_SRC(u_) (p.in[((u_) >> 6) % 3 == 0 ? 18 : (((u_) >> 6) % 3 == 1 ? 20 : 22)] + ((size_t)l * NE + ((u_) >> 6) / 3) * D * D + (size_t)(((u_) & 3) * 256) * D + (((u_) >> 2) & 15) * 64)
#define MWC_LOAD(u_) do { const float* src_ = MWC_SRC(u_) + (size_t)k * D + n4; _Pragma("unroll") for (int i = 0; i < 8; ++i) v[i] = ldnt_f4(src_ + (size_t)(32 * i) * D); } while (0)
    if (u_lo + q_bid < u_hi) MWC_LOAD(u_lo + q_bid);
    for (int u = u_lo + q_bid; u < u_hi; u += gridDim.x) {
        const float sc = ((u >> 6) % 3 == 2) ? WSC_DN : WSC_GU;
        __syncthreads();
#pragma unroll
        for (int i = 0; i < 8; ++i) { const unsigned w = pk4_fp8(v[i].x * sc, v[i].y * sc, v[i].z * sc, v[i].w * sc); const int kk = k + 32 * (i & 1), ko = ((((kk >> 4) ^ (nq & 3)) << 4) | (kk & 15));
#pragma unroll
            for (int j = 0; j < 4; ++j) tl[(i >> 1) * 4096 + (n4 + j) * 64 + ko] = (unsigned char)(w >> (8 * j)); }
        const int un = u + gridDim.x;
        if (un < u_hi) MWC_LOAD(un);
        __syncthreads();
#pragma unroll
        for (int s2 = 0; s2 < 2; ++s2) { const int idx = q_tid + s2 * NTHR, n = idx >> 4, c16 = idx & 15, blk = c16 >> 2, kc = c16 & 3;
            unsigned char* dst = WM + (size_t)(u >> 6) * D * D + (size_t)(((u >> 2) & 15) * 64 + n) * D + (u & 3) * 256 + c16 * 16;
            *(u32x4_t*)dst = *(const LDSP u32x4_t*)(tl + blk * 4096 + n * 64 + ((kc ^ ((n >> 2) & 3)) << 4)); }
    }
#undef MWC_LOAD
#undef MWC_SRC
    __syncthreads();
}
constexpr int MWC_NU = NE * 3 * 64, MWC_SPLIT = MWC_NU * 2 / 3;
__device__ __forceinline__ void ph_outproj_mfma(const Params& p, int q_wave, int l, float* lds) {
    PH_PROLOGUE
    SchedGrid S; S.g.nM = T / 256; S.g.nN = D / 256; S.g.nwg = S.g.nM * S.g.nN; S.g.G = gridDim.x; S.g.c = q_bid; S.A = (const char*)q_out + DO_MG; S.B = q_ws + WS_WOT; S.K = D;
    const bool conv_first = (q_bid >> 3) & 1;
    if (conv_first) moe_weight_convert(p, q_ws, l, lds, q_tid, q_bid, 0, MWC_SPLIT);
    if (l == 0) { EpiOut<false> E; E.XR = p.in[0]; E.XRB = nullptr; E.X = (float*)(q_ws + WS_X); pg8::gemm_phase<false, false>(q_tid, (PG8_LAS unsigned char*)lds, D, nullptr, S, E); }
    else { EpiOut<true> E; E.XR = nullptr; E.XRB = (const bf16_t*)(q_ws + WS_XB); E.X = (float*)(q_ws + WS_X); pg8::gemm_phase<false, false>(q_tid, (PG8_LAS unsigned char*)lds, D, nullptr, S, E); }
    __syncthreads();
    if (!conv_first) moe_weight_convert(p, q_ws, l, lds, q_tid, q_bid, 0, MWC_SPLIT);
}
__device__ __forceinline__ void ph_mwc_tail(const Params& p, int q_wave, int l, float* lds) {
    PH_PROLOGUE
    __syncthreads();
    moe_weight_convert(p, q_ws, l, lds, q_tid, q_bid, MWC_SPLIT, MWC_NU);
}
struct SchedMoe1 {
    const unsigned* ctl; const char* XB8; const char* WM; int nun, G, c;
    __device__ __forceinline__ bool next(int i, pg8::Unit& u) const {
        const int li = i * (G >> 3) + (c >> 3), tile = (li >> 3) * 8 + (c & 7), pn = li & 7; if (tile * 8 >= nun) return false;
        const int e = __builtin_amdgcn_readfirstlane((int)ctl[CW_TILEE + tile]);
        u.a0 = XB8; u.a1 = XB8; u.b0 = WM + ((size_t)(e * 3 + 0) * D + (size_t)pn * 128) * D; u.b1 = WM + ((size_t)(e * 3 + 1) * D + (size_t)pn * 128) * D;
        u.row0 = tile * 256; u.col0 = pn * 128; u.aux = e; return true; }
};
struct EpiMoe1 {
    static constexpr bool PERM = true;
    const float* bg; const float* bu; unsigned char* H;
    __device__ __forceinline__ void operator()(const pg8::f32x4 (&acc)[2][2][4][2], const pg8::Unit& u, int wr, int wc, int fr, int fq) const {
        const int row0 = u.row0 + wr * 64 + fr, col0 = u.col0 + wc * 32 + 8 * fq;
        const pg8::f32x4 g0 = *(const pg8::f32x4*)(bg + u.aux * D + col0), g1 = *(const pg8::f32x4*)(bg + u.aux * D + col0 + 4), u0 = *(const pg8::f32x4*)(bu + u.aux * D + col0), u1 = *(const pg8::f32x4*)(bu + u.aux * D + col0 + 4);
#pragma unroll
        for (int ai = 0; ai < 2; ++ai)
#pragma unroll
            for (int m = 0; m < 4; ++m) { float hh[8];
#pragma unroll
                for (int n = 0; n < 2; ++n) { const pg8::f32x4 gv = acc[ai][0][m][n] * (1.0f / WSC_GU) + (n ? g1 : g0), uv = acc[ai][1][m][n] * (1.0f / WSC_GU) + (n ? u1 : u0);
#pragma unroll
                    for (int j = 0; j < 4; ++j) { const float g = fminf(gv[j], SWI_LIMIT), uu = fminf(fmaxf(uv[j], -SWI_LIMIT), SWI_LIMIT); hh[n * 4 + j] = (uu + 1.0f) * g * sigmoidf_(SWI_ALPHA * g); } }
                *(u32x2_t*)(H + (size_t)(row0 + ai * 128 + m * 16) * D + col0) = (u32x2_t){pk4_fp8(hh[0], hh[1], hh[2], hh[3]), pk4_fp8(hh[4], hh[5], hh[6], hh[7])}; }
    }
};
__device__ __forceinline__ void ph_moe1_mfma(const Params& p, int q_wave, int l, float* lds) {
    PH_PROLOGUE
    const unsigned* ctl = (const unsigned*)(q_ws + WS_CTL);
    SchedMoe1 S; S.ctl = ctl; S.XB8 = q_ws + WS_XB8; S.WM = q_ws + WS_B; S.nun = __builtin_amdgcn_readfirstlane((int)ctl[CW_NTILES]) * 8; S.G = gridDim.x; S.c = q_bid;
    EpiMoe1 E; E.bg = p.in[19] + (size_t)l * NE * D; E.bu = p.in[21] + (size_t)l * NE * D; E.H = (unsigned char*)(q_ws + WS_H);
    pg8::gemm_phase<true, true>(q_tid, (PG8_LAS unsigned char*)lds, D / 2, (const int*)(q_ws + WS_ROWTOK), S, E);
}
struct SchedMoe2 {
    const unsigned* ctl; const char* H; const char* WM; int nun, G, c;
    __device__ __forceinline__ bool next(int i, pg8::Unit& u) const {
        const int li = i * (G >> 3) + (c >> 3), tile = (li >> 2) * 8 + (c & 7), pn = li & 3; if (tile * 4 >= nun) return false;
        const int e = __builtin_amdgcn_readfirstlane((int)ctl[CW_TILEE + tile]);
        u.a0 = H + (size_t)tile * 256 * D; u.a1 = u.a0 + (size_t)128 * D; u.b0 = WM + ((size_t)(e * 3 + 2) * D + (size_t)pn * 256) * D; u.b1 = u.b0 + (size_t)128 * D;
        u.row0 = tile * 256; u.col0 = pn * 256; u.aux = e; return true; }
};
constexpr float YSC = 16.0f;
template <bool Y8> struct EpiMoe2 {
    static constexpr bool PERM = true;
    const float* bd; const float* rowp; bf16_t* Y;
    __device__ __forceinline__ void operator()(const pg8::f32x4 (&acc)[2][2][4][2], const pg8::Unit& u, int wr, int wc, int fr, int fq) const {
        const int row0 = u.row0 + wr * 64 + fr, col0 = u.col0 + wc * 32 + 8 * fq;
        float pr[8]; pg8::f32x4 bb[2][2];
#pragma unroll
        for (int k = 0; k < 8; ++k) pr[k] = rowp[row0 + (k >> 2) * 128 + (k & 3) * 16] * (Y8 ? YSC : 1.0f);
#pragma unroll
        for (int bj = 0; bj < 2; ++bj) { bb[bj][0] = *(const pg8::f32x4*)(bd + u.aux * D + col0 + bj * 128); bb[bj][1] = *(const pg8::f32x4*)(bd + u.aux * D + col0 + bj * 128 + 4); }
#pragma unroll
        for (int ai = 0; ai < 2; ++ai)
#pragma unroll
            for (int m = 0; m < 4; ++m) { const int row = row0 + ai * 128 + m * 16; const float p1 = pr[ai * 4 + m];
#pragma unroll
                for (int bj = 0; bj < 2; ++bj) { const pg8::f32x4 v0 = (acc[ai][bj][m][0] * (1.0f / WSC_DN) + bb[bj][0]) * p1, v1 = (acc[ai][bj][m][1] * (1.0f / WSC_DN) + bb[bj][1]) * p1;
                    if (Y8) *(u32x2_t*)((unsigned char*)Y + (size_t)row * D + col0 + bj * 128) = (u32x2_t){pk4_fp8(v0[0], v0[1], v0[2], v0[3]), pk4_fp8(v1[0], v1[1], v1[2], v1[3])};
                    else { pg8::u32x4 w; w.x = pg8::cvt_pk_bf16(v0[0], v0[1]); w.y = pg8::cvt_pk_bf16(v0[2], v0[3]); w.z = pg8::cvt_pk_bf16(v1[0], v1[1]); w.w = pg8::cvt_pk_bf16(v1[2], v1[3]);
                        *(pg8::u32x4*)(Y + (size_t)row * D + col0 + bj * 128) = w; } } }
    }
};
__device__ __forceinline__ void ph_moe2_mfma(const Params& p, int q_wave, int l, float* lds) {
    PH_PROLOGUE
    const unsigned* ctl = (const unsigned*)(q_ws + WS_CTL);
    SchedMoe2 S; S.ctl = ctl; S.H = q_ws + WS_H; S.WM = q_ws + WS_B; S.nun = __builtin_amdgcn_readfirstlane((int)ctl[CW_NTILES]) * 4; S.G = gridDim.x; S.c = q_bid;
    if (l == DEPTH - 1) { EpiMoe2<true> E; E.bd = p.in[23] + (size_t)l * NE * D; E.rowp = (const float*)(q_ws + WS_ROWP); E.Y = (bf16_t*)(q_ws + WS_Y); pg8::gemm_phase<false, true>(q_tid, (PG8_LAS unsigned char*)lds, D / 2, nullptr, S, E); }
    else { EpiMoe2<false> E; E.bd = p.in[23] + (size_t)l * NE * D; E.rowp = (const float*)(q_ws + WS_ROWP); E.Y = (bf16_t*)(q_ws + WS_Y); pg8::gemm_phase<false, true>(q_tid, (PG8_LAS unsigned char*)lds, D / 2, nullptr, S, E); }
}

__device__ __forceinline__ bf16x8_t frag_row(const LDSP bf16_t* M, int ld, int row0, int k0, int r, int g) { return *(const LDSP bf16x8_t*)(M + (row0 + r) * ld + k0 + 8 * g); }
__device__ __forceinline__ bf16x8_t frag_tr(const LDSP bf16_t* M, int ld, int k0, int n0, int r, int g) {
    const LDSP bf16_t* a = M + (k0 + 8 * g + (r >> 2)) * ld + n0 + 4 * (r & 3);
    const s16x4_t lo = __builtin_amdgcn_ds_read_tr16_b64_v4i16((LDSP s16x4_t*)a), hi = __builtin_amdgcn_ds_read_tr16_b64_v4i16((LDSP s16x4_t*)(a + 4 * ld));
    return (bf16x8_t){lo[0], lo[1], lo[2], lo[3], hi[0], hi[1], hi[2], hi[3]};
}
__device__ __forceinline__ f32x4_t mma(f32x4_t acc, bf16x8_t X, bf16x8_t Y) { return __builtin_amdgcn_mfma_f32_16x16x32_bf16(X, Y, acc, 0, 0, 0); }
__device__ __forceinline__ unsigned pk2(float lo, float hi) { return cvtpk_bf16(lo, hi); }
__device__ __forceinline__ void unpack8u(const u32x4_t w, float (&f)[8]) {
    f[0] = __uint_as_float(w.x << 16); f[1] = __uint_as_float(w.x & 0xffff0000u); f[2] = __uint_as_float(w.y << 16); f[3] = __uint_as_float(w.y & 0xffff0000u);
    f[4] = __uint_as_float(w.z << 16); f[5] = __uint_as_float(w.z & 0xffff0000u); f[6] = __uint_as_float(w.w << 16); f[7] = __uint_as_float(w.w & 0xffff0000u); }
__device__ __forceinline__ u32x4_t pack8u(const float (&f)[8]) { return (u32x4_t){pk2(f[0], f[1]), pk2(f[2], f[3]), pk2(f[4], f[5]), pk2(f[6], f[7])}; }
__device__ __forceinline__ bf16x8_t scale_frag(bf16x8_t q, float s) { const u32x4_t w = __builtin_bit_cast(u32x4_t, q); float f[8]; unpack8u(w, f);
#pragma unroll
    for (int j = 0; j < 8; ++j) f[j] *= s;
    return __builtin_bit_cast(bf16x8_t, pack8u(f)); }

constexpr size_t WS_RKV = WS_B;
__device__ __forceinline__ float ret_lg(int h) { return log1pf(-exp2f(-5.0f - (float)h)); }
__device__ __forceinline__ void ret1_load(const bf16_t* P, int u, int q_tid, u32x4_t (&kr)[2], u32x4_t (&vr)[4]) {
    const int ch = u >> 2, h = u & 3, tok0 = ch * 128;
#pragma unroll
    for (int i = 0; i < 2; ++i) { const int c = q_tid + i * NTHR; kr[i] = *(const u32x4_t*)(P + (size_t)(tok0 + (c >> 3)) * NPP + C_RK + h * 64 + (c & 7) * 8); }
#pragma unroll
    for (int i = 0; i < 4; ++i) { const int c = q_tid + i * NTHR; vr[i] = *(const u32x4_t*)(P + (size_t)(tok0 + (c >> 4)) * NPP + C_RV + h * 128 + (c & 15) * 8); }
}
__device__ __forceinline__ void ph_ret1(const Params& p, int q_wave, int l, float* lds) {
    PH_PROLOGUE
    LDSP bf16_t* Ks = (LDSP bf16_t*)lds; LDSP bf16_t* Vs = Ks + 128 * 72;
    const bf16_t* P = (const bf16_t*)(q_ws + WS_P); bf16_t* RKV = (bf16_t*)(q_ws + WS_RKV);
    const int lane = q_tid & 63, r = lane & 15, g = lane >> 4;
    for (int ub = q_bid; ub < (T / 128) * 4; ub += 4 * gridDim.x) {
    u32x4_t kr4[4][2], vr4[4][4];
#pragma unroll
    for (int s = 0; s < 4; ++s) if (ub + s * (int)gridDim.x < (T / 128) * 4) ret1_load(P, ub + s * gridDim.x, q_tid, kr4[s], vr4[s]);
#pragma unroll
    for (int s = 0; s < 4; ++s) { const int u = ub + s * gridDim.x; if (u >= (T / 128) * 4) break;
        const u32x4_t (&kr)[2] = kr4[s]; const u32x4_t (&vr)[4] = vr4[s];
        const int ch = u >> 2, h = u & 3, b = ch >> 7, n = ch & 127; const float lg = ret_lg(h);
        __syncthreads();
#pragma unroll
        for (int i = 0; i < 2; ++i) { const int c = q_tid + i * NTHR, j = c >> 3; float f[8]; unpack8u(kr[i], f);
            const float sc = __expf(lg * (float)(127 - j)) * 0.125f;
#pragma unroll
            for (int q = 0; q < 8; ++q) f[q] *= sc;
            *(LDSP u32x4_t*)(Ks + j * 72 + (c & 7) * 8) = pack8u(f); }
#pragma unroll
        for (int i = 0; i < 4; ++i) { const int c = q_tid + i * NTHR; *(LDSP u32x4_t*)(Vs + (c >> 4) * 136 + (c & 15) * 8) = vr[i]; }
        __syncthreads();
        f32x4_t acc[4];
#pragma unroll
        for (int dt = 0; dt < 4; ++dt) acc[dt] = (f32x4_t){0.f, 0.f, 0.f, 0.f};
#pragma unroll
        for (int j0 = 0; j0 < 128; j0 += 32) { const bf16x8_t vy = frag_tr(Vs, 136, j0, q_wave * 16, r, g);
#pragma unroll
            for (int dt = 0; dt < 4; ++dt) acc[dt] = mma(acc[dt], frag_tr(Ks, 72, j0, dt * 16, r, g), vy); }
        LDSP float* ob = (LDSP float*)(Vs + 128 * 136) + q_wave * (16 * 68);
#pragma unroll
        for (int dt = 0; dt < 4; ++dt) *(LDSP f32x4_t*)(ob + r * 68 + dt * 16 + 4 * g) = acc[dt];
        bf16_t* dst = RKV + ((((size_t)n * 2 + b) * 4 + h) * 128 + q_wave * 16) * 64;
#pragma unroll
        for (int k = 0; k < 2; ++k) { const int rw = (lane >> 3) + 8 * k, ck = lane & 7; const f32x4_t lo = *(const LDSP f32x4_t*)(ob + rw * 68 + ck * 8), hi = *(const LDSP f32x4_t*)(ob + rw * 68 + ck * 8 + 4);
            *(u32x4_t*)(dst + rw * 64 + ck * 8) = (u32x4_t){pk2(lo[0], lo[1]), pk2(lo[2], lo[3]), pk2(hi[0], hi[1]), pk2(hi[2], hi[3])}; }
    }
    }
}
__device__ __forceinline__ void ph_ret2(const Params& p, int q_wave, int l) {
    PH_PROLOGUE
    bf16_t* RKV = (bf16_t*)(q_ws + WS_RKV);
    for (int idx = q_bid * NTHR + q_tid; idx < 32768; idx += gridDim.x * NTHR) {
        const float cd = __expf(ret_lg((idx >> 12) & 3) * 128.0f); float2 st = make_float2(0.f, 0.f);
#pragma unroll 32
        for (int n = 0; n < 128; ++n) { unsigned* q = (unsigned*)(RKV + (size_t)n * 65536) + idx; const unsigned kv = *q; *q = pk2(st.x, st.y); st.x = cd * st.x + __uint_as_float(kv << 16); st.y = cd * st.y + __uint_as_float(kv & 0xffff0000u); }
    }
}
__device__ __forceinline__ void ret3_load(const bf16_t* P, const bf16_t* RKV, int u, int q_tid, u32x4_t (&kr)[2], u32x4_t (&vr)[4], u32x4_t (&pr)[2]) {
    const int ch = u >> 2, h = u & 3, b = ch >> 7, n = ch & 127, tok0 = ch * 128;
#pragma unroll
    for (int i = 0; i < 2; ++i) { const int c = q_tid + i * NTHR; kr[i] = ldnt_u4(P + (size_t)(tok0 + (c >> 3)) * NPP + C_RK + h * 64 + (c & 7) * 8); }
#pragma unroll
    for (int i = 0; i < 4; ++i) { const int c = q_tid + i * NTHR; vr[i] = ldnt_u4(P + (size_t)(tok0 + (c >> 4)) * NPP + C_RV + h * 128 + (c & 15) * 8); }
    const bf16_t* src = RKV + (((size_t)n * 2 + b) * 4 + h) * 8192;
#pragma unroll
    for (int i = 0; i < 2; ++i) pr[i] = ldnt_u4(src + (q_tid + i * NTHR) * 8);
}
__device__ __forceinline__ void ph_ret3(const Params& p, int q_wave, int l, float* lds) {
    PH_PROLOGUE
    LDSP bf16_t* Ks = (LDSP bf16_t*)lds; LDSP bf16_t* Vs = Ks + 128 * 72; LDSP bf16_t* Pt = Vs + 128 * 136; LDSP bf16_t* Sw = Pt + 128 * 72 + q_wave * (16 * 136);
    const bf16_t* P = (const bf16_t*)(q_ws + WS_P); const bf16_t* RKV = (const bf16_t*)(q_ws + WS_RKV); bf16_t* YR = (bf16_t*)(q_ws + WS_YR);
    const float* rgn = p.in[2] + l * MIXW;
    LDSP float* gw = (LDSP float*)(Pt + 128 * 72 + 8 * 16 * 136);
    __syncthreads(); gw[q_tid] = rgn[q_tid];
    const int lane = q_tid & 63, r = lane & 15, g = lane >> 4, i0 = q_wave * 16;
    u32x4_t kr[2], vr[4], pr[2]; bf16x8_t qn[2];
#define RET3_QLOAD(u_) do { const bf16_t* qr_ = P + (size_t)(((u_) >> 2) * 128 + i0 + r) * NPP + C_RQ + ((u_) & 3) * 64 + 8 * g; qn[0] = ldnt_b8(qr_); qn[1] = ldnt_b8(qr_ + 32); } while (0)
    if (q_bid < (T / 128) * 4) { ret3_load(P, RKV, q_bid, q_tid, kr, vr, pr); RET3_QLOAD(q_bid); }
    int uprev = -1;
#define RET3_FLUSH() do { _Pragma("unroll") for (int k = 0; k < 4; ++k) { const int rw = (lane >> 4) + 4 * k, ck = lane & 15; \
        *(u32x4_t*)(YR + (size_t)((uprev >> 2) * 128 + i0 + rw) * MIXW + (uprev & 3) * 128 + ck * 8) = *(const LDSP u32x4_t*)(Sw + rw * 136 + ck * 8); } } while (0)
#undef RET3_FLUSH
#define RET3_FLUSH() do { _Pragma("unroll") for (int k = 0; k < 2; ++k) { const int rw = (lane >> 3) + 8 * k, ck = lane & 7; \
        *(u32x4_t*)((unsigned char*)YR + (size_t)((uprev >> 2) * 128 + i0 + rw) * MIXW + (uprev & 3) * 128 + ck * 16) = *(const LDSP u32x4_t*)((LDSP unsigned char*)Sw + rw * 144 + ck * 16); } } while (0)
    for (int u = q_bid; u < (T / 128) * 4; u += gridDim.x) {
        const int ch = u >> 2, h = u & 3, tok0 = ch * 128; const float lg = ret_lg(h);
        __syncthreads();
#pragma unroll
        for (int i = 0; i < 2; ++i) { const int c = q_tid + i * NTHR; *(LDSP u32x4_t*)(Ks + (c >> 3) * 72 + (c & 7) * 8) = kr[i]; }
#pragma unroll
        for (int i = 0; i < 4; ++i) { const int c = q_tid + i * NTHR; *(LDSP u32x4_t*)(Vs + (c >> 4) * 136 + (c & 15) * 8) = vr[i]; }
#pragma unroll
        for (int i = 0; i < 2; ++i) { const int c = q_tid + i * NTHR, e = c >> 3, d = (c & 7) * 8; *(LDSP u32x4_t*)(Pt + e * 72 + d) = pr[i]; }
        bf16x8_t qf[2]; qf[0] = qn[0]; qf[1] = qn[1];
        __syncthreads();
        asm volatile("" : "+v"(qf[0]), "+v"(qf[1]));
        if (uprev >= 0) RET3_FLUSH();
        u32x2_t rgq[8];
#pragma unroll
        for (int et = 0; et < 8; ++et) rgq[et] = *(const u32x2_t*)(P + (size_t)(tok0 + i0 + r) * NPP + C_RG + h * 128 + et * 16 + 4 * g);
        if (u + (int)gridDim.x < (T / 128) * 4) { ret3_load(P, RKV, u + gridDim.x, q_tid, kr, vr, pr); RET3_QLOAD(u + gridDim.x); }
        const int ntile = q_wave + 1, nt2 = (ntile + 1) & ~1;
        for (int jt = 0; jt < nt2; ++jt) { f32x4_t a = (f32x4_t){0.f, 0.f, 0.f, 0.f};
            if (jt < ntile) { a = mma(a, frag_row(Ks, 72, jt * 16, 0, r, g), qf[0]); a = mma(a, frag_row(Ks, 72, jt * 16, 32, r, g), qf[1]); }
            float sv[4];
#pragma unroll
            for (int ii = 0; ii < 4; ++ii) { const int dij = (i0 + r) - (jt * 16 + 4 * g + ii); sv[ii] = dij >= 0 ? a[ii] * 0.125f * __expf(lg * (float)dij) : 0.f; }
            *(LDSP u32x2_t*)(Sw + r * 136 + jt * 16 + 4 * g) = (u32x2_t){pk2(sv[0], sv[1]), pk2(sv[2], sv[3])}; }
        f32x4_t o[8];
#pragma unroll
        for (int et = 0; et < 8; ++et) o[et] = (f32x4_t){0.f, 0.f, 0.f, 0.f};
        for (int j0 = 0; j0 < nt2 * 16; j0 += 32) { const bf16x8_t sy = frag_row(Sw, 136, 0, j0, r, g);
#pragma unroll
            for (int et = 0; et < 8; ++et) o[et] = mma(o[et], frag_tr(Vs, 136, j0, et * 16, r, g), sy); }
        { const float qd = __expf(lg * (float)(i0 + r + 1)); const bf16x8_t q0 = scale_frag(qf[0], qd), q1 = scale_frag(qf[1], qd);
#pragma unroll
          for (int et = 0; et < 8; ++et) { o[et] = mma(o[et], frag_row(Pt, 72, et * 16, 0, r, g), q0); o[et] = mma(o[et], frag_row(Pt, 72, et * 16, 32, r, g), q1); } }
        float s1 = 0.f;
#pragma unroll
        for (int et = 0; et < 8; ++et) s1 += (o[et][0] + o[et][1]) + (o[et][2] + o[et][3]);
        s1 += __shfl_xor(s1, 16); s1 += __shfl_xor(s1, 32);
        const float mu = s1 * (1.0f / 128.0f); float s2 = 0.f;
#pragma unroll
        for (int et = 0; et < 8; ++et) { o[et] -= mu; s2 += (o[et][0] * o[et][0] + o[et][1] * o[et][1]) + (o[et][2] * o[et][2] + o[et][3] * o[et][3]); }
        s2 += __shfl_xor(s2, 16); s2 += __shfl_xor(s2, 32);
        const float rstd = rsqrtf(s2 * (1.0f / 128.0f) + LN_EPS);
        const size_t tok = (size_t)(tok0 + i0 + r);
#pragma unroll
        for (int et = 0; et < 8; ++et) { const int c = h * 128 + et * 16 + 4 * g; const f32x4_t gn_ = *(const LDSP f32x4_t*)(gw + c); const float4 gn = make_float4(gn_[0], gn_[1], gn_[2], gn_[3]); const float4 rg = make_float4(__uint_as_float(rgq[et].x << 16), __uint_as_float(rgq[et].x & 0xffff0000u), __uint_as_float(rgq[et].y << 16), __uint_as_float(rgq[et].y & 0xffff0000u));
            *(LDSP unsigned*)((LDSP unsigned char*)Sw + r * 144 + et * 16 + 4 * g) = pk4_fp8(o[et][0] * rstd * gn.x * (rg.x * sigmoidf_(rg.x)), o[et][1] * rstd * gn.y * (rg.y * sigmoidf_(rg.y)), o[et][2] * rstd * gn.z * (rg.z * sigmoidf_(rg.z)), o[et][3] * rstd * gn.w * (rg.w * sigmoidf_(rg.w))); }
        uprev = u;
    }
    if (uprev >= 0) RET3_FLUSH();
#undef RET3_FLUSH
}

__device__ __forceinline__ float wscan_add(float v, int lane) {
#pragma unroll
    for (int o = 1; o < 64; o <<= 1) { const float t = __shfl_up(v, o); if (lane >= o) v += t; }
    return v; }
__device__ __forceinline__ float wscan_max(float v, int lane) {
#pragma unroll
    for (int o = 1; o < 64; o <<= 1) { const float t = __shfl_up(v, o); if (lane >= o) v = fmaxf(v, t); }
    return v; }
__device__ __forceinline__ float logsigmoidf_(float x) { return fminf(x, 0.f) - log1pf(__expf(-fabsf(x))); }
__device__ __forceinline__ void ml_gates(const float* IGF, const float* bi, const float* bfg, int tok0, int h, int lane, LDSP float* cum, LDSP float* ig, LDSP float* pm, float& tot, float& amax) {
    const float i0 = IGF[(size_t)(tok0 + lane) * 8 + h] + bi[h], i1 = IGF[(size_t)(tok0 + 64 + lane) * 8 + h] + bi[h];
    const float l0 = logsigmoidf_(IGF[(size_t)(tok0 + lane) * 8 + 4 + h] + bfg[h]), l1 = logsigmoidf_(IGF[(size_t)(tok0 + 64 + lane) * 8 + 4 + h] + bfg[h]);
    const float c0 = wscan_add(l0, lane), c1 = wscan_add(l1, lane) + __shfl(c0, 63);
    tot = __shfl(c1, 63);
    const float p0 = wscan_max(i0 - c0, lane), p1 = fmaxf(wscan_max(i1 - c1, lane), __shfl(p0, 63));
    amax = wmax(fmaxf(tot - c0 + i0, tot - c1 + i1));
    cum[lane] = c0; cum[64 + lane] = c1; ig[lane] = i0; ig[64 + lane] = i1; pm[lane] = p0; pm[64 + lane] = p1;
}
__device__ __forceinline__ void ph_ml1(const Params& p, int q_wave, int l, float* lds) {
    PH_PROLOGUE
    LDSP bf16_t* Ks = (LDSP bf16_t*)lds; LDSP bf16_t* Vs = Ks + 128 * 136; LDSP float* gt = (LDSP float*)(Vs + 128 * 136); LDSP bf16_t* Xs = (LDSP bf16_t*)(gt + 2048);
    const bf16_t* P = (const bf16_t*)(q_ws + WS_P); const float* IGF = (const float*)(q_ws + WS_IGF);
    bf16_t* MQ = (bf16_t*)(q_ws + WS_MQ); bf16_t* MK = (bf16_t*)(q_ws + WS_MK); bf16_t* MV = (bf16_t*)(q_ws + WS_MV); bf16_t* MC = (bf16_t*)(q_ws + WS_MC);
    bf16_t* MLC = (bf16_t*)(q_ws + WS_MLC); float* MLN = (float*)(q_ws + WS_MLN); float* MLS = (float*)(q_ws + WS_MLS);
    const float* wq = p.in[5] + (size_t)l * 128 * 16; const float* wk = p.in[6] + (size_t)l * 128 * 16; const float* wv = p.in[7] + (size_t)l * 128 * 16;
    const float* bi = p.in[8] + l * 4; const float* bfg = p.in[9] + l * 4; const float* cw = p.in[3] + (size_t)l * 4 * MIXW; const float* cb = p.in[4] + (size_t)l * MIXW;
    const int lane = q_tid & 63, r = lane & 15, g = lane >> 4;
    for (int ch = q_bid; ch < T / 128; ch += gridDim.x) {
        const int b = ch >> 7, n = ch & 127, tok0 = ch * 128;
        u32x4_t xr[5];
#define ML1_XLOAD(h_) do { _Pragma("unroll") for (int i = 0; i < 5; ++i) { const int c = q_tid + i * NTHR, jr = c >> 4, cc = c & 15; xr[i] = (u32x4_t){0u, 0u, 0u, 0u}; \
            if (c < 131 * 16 && (n > 0 || jr >= 3)) xr[i] = ldnt_u4(P + (size_t)(tok0 + jr - 3) * NPP + C_MX + (h_) * 128 + cc * 8); } } while (0)
        ML1_XLOAD(0);
        __syncthreads();
        if (q_wave < 4) { const int h = q_wave; float tot, amax; ml_gates(IGF, bi, bfg, tok0, h, lane, gt + h * 512, gt + h * 512 + 128, gt + h * 512 + 256, tot, amax);
            gt[h * 512 + 384 + lane] = __expf(tot - gt[h * 512 + lane] + gt[h * 512 + 128 + lane] - amax); gt[h * 512 + 384 + 64 + lane] = __expf(tot - gt[h * 512 + 64 + lane] + gt[h * 512 + 128 + 64 + lane] - amax);
            if (lane == 0) { float* ms = MLS + (((size_t)n * 2 + b) * 4 + h) * 4; ms[0] = tot; ms[1] = amax; }
            float* gtg = (float*)(q_ws + WS_GT) + (size_t)(ch * 4 + h) * 384;
#pragma unroll
            for (int q = 0; q < 3; ++q) { gtg[q * 128 + lane] = gt[h * 512 + q * 128 + lane]; gtg[q * 128 + 64 + lane] = gt[h * 512 + q * 128 + 64 + lane]; } }
        __syncthreads();
        for (int h = 0; h < 4; ++h) {
#pragma unroll
            for (int i = 0; i < 5; ++i) { const int c = q_tid + i * NTHR, jr = c >> 4, cc = c & 15; if (c < 131 * 16) *(LDSP u32x4_t*)(Xs + jr * 136 + cc * 8) = xr[i]; }
            if (h < 3) ML1_XLOAD(h + 1);
            const int nb = q_tid & 31, n4 = h * 32 + nb, jr0 = q_tid >> 5;
            float cwr[4][4], cbr[4], wqr[16], wkr[16], wvr[16];
#pragma unroll
            for (int i = 0; i < 4; ++i) { const float4 t4 = *(const float4*)(cw + i * MIXW + n4 * 4); cwr[i][0] = t4.x; cwr[i][1] = t4.y; cwr[i][2] = t4.z; cwr[i][3] = t4.w; }
            { const float4 t4 = *(const float4*)(cb + n4 * 4); cbr[0] = t4.x; cbr[1] = t4.y; cbr[2] = t4.z; cbr[3] = t4.w; }
#pragma unroll
            for (int i = 0; i < 4; ++i) { const float4 a4 = *(const float4*)(wq + n4 * 16 + i * 4), b4 = *(const float4*)(wk + n4 * 16 + i * 4), c4 = *(const float4*)(wv + n4 * 16 + i * 4);
                wqr[i * 4] = a4.x; wqr[i * 4 + 1] = a4.y; wqr[i * 4 + 2] = a4.z; wqr[i * 4 + 3] = a4.w; wkr[i * 4] = b4.x; wkr[i * 4 + 1] = b4.y; wkr[i * 4 + 2] = b4.z; wkr[i * 4 + 3] = b4.w;
                wvr[i * 4] = c4.x; wvr[i * 4 + 1] = c4.y; wvr[i * 4 + 2] = c4.z; wvr[i * 4 + 3] = c4.w; }
            __syncthreads();
#pragma unroll 2
            for (int it = 0; it < 8; ++it) { const int j = jr0 + 16 * it, tok = tok0 + j;
                float xv[4][4];
#pragma unroll
                for (int i = 0; i < 4; ++i) { const u32x2_t w = *(const LDSP u32x2_t*)(Xs + (j + i) * 136 + nb * 4);
                    xv[i][0] = __uint_as_float(w.x << 16); xv[i][1] = __uint_as_float(w.x & 0xffff0000u); xv[i][2] = __uint_as_float(w.y << 16); xv[i][3] = __uint_as_float(w.y & 0xffff0000u); }
                float mc[4], q[4] = {0, 0, 0, 0}, k[4] = {0, 0, 0, 0}, v[4] = {0, 0, 0, 0};
#pragma unroll
                for (int c = 0; c < 4; ++c) { float a = cbr[c];
#pragma unroll
                    for (int i = 0; i < 4; ++i) a += cwr[i][c] * xv[i][c];
                    mc[c] = a * sigmoidf_(a); }
#pragma unroll
                for (int c = 0; c < 4; ++c)
#pragma unroll
                    for (int d = 0; d < 4; ++d) { q[d] += mc[c] * wqr[c * 4 + d]; k[d] += mc[c] * wkr[c * 4 + d]; v[d] += xv[3][c] * wvr[c * 4 + d]; }
#pragma unroll
                for (int d = 0; d < 4; ++d) k[d] *= 0.08838834764831845f;
                const size_t o = (size_t)tok * MIXW + n4 * 4;
                st_bf4(MQ + o, make_float4(q[0], q[1], q[2], q[3])); st_bf4(MK + o, make_float4(k[0], k[1], k[2], k[3])); st_bf4(MV + o, make_float4(v[0], v[1], v[2], v[3])); st_bf4(MC + o, make_float4(mc[0], mc[1], mc[2], mc[3]));
                const float wa = gt[h * 512 + 384 + j];
                *(LDSP u32x2_t*)(Ks + j * 136 + nb * 4) = (u32x2_t){pk2(k[0] * wa, k[1] * wa), pk2(k[2] * wa, k[3] * wa)};
                *(LDSP u32x2_t*)(Vs + j * 136 + nb * 4) = (u32x2_t){pk2(v[0], v[1]), pk2(v[2], v[3])}; }
            __syncthreads();
            f32x4_t acc[8];
#pragma unroll
            for (int dt = 0; dt < 8; ++dt) acc[dt] = (f32x4_t){0.f, 0.f, 0.f, 0.f};
#pragma unroll
            for (int j0 = 0; j0 < 128; j0 += 32) { const bf16x8_t vy = frag_tr(Vs, 136, j0, q_wave * 16, r, g);
#pragma unroll
                for (int dt = 0; dt < 8; ++dt) acc[dt] = mma(acc[dt], frag_tr(Ks, 136, j0, dt * 16, r, g), vy); }
            const size_t sb = ((size_t)n * 2 + b) * 4 + h;
            { LDSP float* ob = (LDSP float*)(Xs + 131 * 136) + q_wave * (16 * 68);
              bf16_t* dst = MLC + (sb * 128 + q_wave * 16) * 128;
#pragma unroll
              for (int hf = 0; hf < 2; ++hf) {
#pragma unroll
                  for (int dt = 0; dt < 4; ++dt) *(LDSP f32x4_t*)(ob + r * 68 + dt * 16 + 4 * g) = acc[hf * 4 + dt];
#pragma unroll
                  for (int k = 0; k < 2; ++k) { const int rw = (lane >> 3) + 8 * k, ck = lane & 7; const f32x4_t lo = *(const LDSP f32x4_t*)(ob + rw * 68 + ck * 8), hi = *(const LDSP f32x4_t*)(ob + rw * 68 + ck * 8 + 4);
                      *(u32x4_t*)(dst + rw * 128 + hf * 64 + ck * 8) = (u32x4_t){pk2(lo[0], lo[1]), pk2(lo[2], lo[3]), pk2(hi[0], hi[1]), pk2(hi[2], hi[3])}; } } }
            if (q_tid < 128) { float sm = 0.f; for (int j = 0; j < 128; ++j) sm += bf2f(Ks[j * 136 + q_tid]); MLN[sb * 128 + q_tid] = sm; }
            __syncthreads();
        }
    }
}
#undef ML1_XLOAD
__device__ __forceinline__ void ph_ml2(const Params& p, int q_wave, int l, float* lds) {
    PH_PROLOGUE
    bf16_t* MLC = (bf16_t*)(q_ws + WS_MLC); float* MLN = (float*)(q_ws + WS_MLN); float* MLS = (float*)(q_ws + WS_MLS);
    LDSP float* co = (LDSP float*)lds;
    const int vb = gridDim.x - 1 - q_bid;
    if (vb * NTHR >= 8 * 16512 / 2) return;
    __syncthreads();
    for (int i = q_tid; i < 1024; i += NTHR) { const int n = i >> 3, bh = i & 7; const float4 ms = *(const float4*)(MLS + ((size_t)n * 8 + bh) * 4); co[(bh * 128 + n) * 2] = ms.x; co[(bh * 128 + n) * 2 + 1] = ms.y; }
    __syncthreads();
    if (q_tid < 8) { const int bh = q_tid; float m = 0.f;
        for (int n = 0; n < 128; ++n) { const float gs = co[(bh * 128 + n) * 2], am = co[(bh * 128 + n) * 2 + 1]; const float mn = fmaxf(gs + m, am);
            co[(bh * 128 + n) * 2] = __expf(gs + m - mn); co[(bh * 128 + n) * 2 + 1] = __expf(am - mn);
            if (vb == 0) MLS[((size_t)n * 8 + bh) * 4 + 2] = m;
            m = mn; } }
    __syncthreads();
    for (int idx = vb * NTHR + q_tid; idx < 8 * 16512 / 2; idx += gridDim.x * NTHR) {
        if (idx < 65536) { const int bh = idx >> 13; unsigned* base = (unsigned*)(MLC + (size_t)bh * 16384) + (idx & 8191); float2 st = make_float2(0.f, 0.f);
#pragma unroll 32
            for (int n = 0; n < 128; ++n) { const float so = co[(bh * 128 + n) * 2], sn = co[(bh * 128 + n) * 2 + 1];
                unsigned* q = base + (size_t)n * (8 * 16384 / 2); const unsigned cv = *q; *q = pk2(st.x, st.y); st.x = so * st.x + sn * __uint_as_float(cv << 16); st.y = so * st.y + sn * __uint_as_float(cv & 0xffff0000u); } }
        else { const int j = idx - 65536, bh = j >> 6; float* base = MLN + (size_t)bh * 128 + (j & 63) * 2; float2 st = make_float2(0.f, 0.f);
#pragma unroll 32
            for (int n = 0; n < 128; ++n) { const float so = co[(bh * 128 + n) * 2], sn = co[(bh * 128 + n) * 2 + 1];
                float2* q = (float2*)(base + (size_t)n * (8 * 128)); const float2 cv = *q; *q = st; st.x = so * st.x + sn * cv.x; st.y = so * st.y + sn * cv.y; } }
    }
}
__device__ __forceinline__ void ml3_load(const bf16_t* MK, const bf16_t* MV, const bf16_t* MLC, const float* GT, const float* MLN, int u, int q_tid, u32x4_t (&kr)[4], u32x4_t (&vr)[4], u32x4_t (&cr)[4], float& gv) {
    const int ch = u >> 2, h = u & 3, b = ch >> 7, n = ch & 127, tok0 = ch * 128; const size_t sb = ((size_t)n * 2 + b) * 4 + h;
#pragma unroll
    for (int i = 0; i < 4; ++i) { const int c = q_tid + i * NTHR; const size_t o = (size_t)(tok0 + (c >> 4)) * MIXW + h * 128 + (c & 15) * 8; kr[i] = ldnt_u4(MK + o); vr[i] = ldnt_u4(MV + o); }
#pragma unroll
    for (int i = 0; i < 4; ++i) cr[i] = ldnt_u4(MLC + sb * 16384 + (size_t)(q_tid + i * NTHR) * 8);
    gv = q_tid < 384 ? GT[(size_t)u * 384 + q_tid] : MLN[sb * 128 + (q_tid - 384)];
}
__device__ __forceinline__ void ph_ml3(const Params& p, int q_wave, int l, float* lds) {
    PH_PROLOGUE
    LDSP bf16_t* Ks = (LDSP bf16_t*)lds; LDSP bf16_t* Vs = Ks + 128 * 136; LDSP bf16_t* Ct = Vs + 128 * 136; LDSP bf16_t* Sw = Ct + 128 * 136 + q_wave * (16 * 136);
    LDSP float* gt = (LDSP float*)(Ct + 128 * 136 + 8 * 16 * 136);
    LDSP float* gw = gt + 512;
    const bf16_t* P = (const bf16_t*)(q_ws + WS_P); const float* IGF = (const float*)(q_ws + WS_IGF);
    const bf16_t* MQ = (const bf16_t*)(q_ws + WS_MQ); const bf16_t* MK = (const bf16_t*)(q_ws + WS_MK); const bf16_t* MV = (const bf16_t*)(q_ws + WS_MV); const bf16_t* MC = (const bf16_t*)(q_ws + WS_MC);
    const bf16_t* MLC = (const bf16_t*)(q_ws + WS_MLC); const float* MLN = (const float*)(q_ws + WS_MLN); const float* MLS = (const float*)(q_ws + WS_MLS);
    bf16_t* YM = (bf16_t*)(q_ws + WS_YM);
    const float* bi = p.in[8] + l * 4; const float* bfg = p.in[9] + l * 4; const float* mgn = p.in[10] + l * MIXW; const float* msk = p.in[11] + l * MIXW;
    const int lane = q_tid & 63, r = lane & 15, g = lane >> 4, i0 = q_wave * 16;
    u32x4_t kr[4], vr[4], cr[4]; float gv = 0.f; const float* GT = (const float*)(q_ws + WS_GT);
    __syncthreads(); gw[q_tid] = mgn[q_tid]; gw[512 + q_tid] = msk[q_tid];
    bf16x8_t qn[4];
#define ML3_QLOAD(u_) do { const bf16_t* qr_ = MQ + (size_t)(((u_) >> 2) * 128 + i0 + r) * MIXW + ((u_) & 3) * 128 + 8 * g; _Pragma("unroll") for (int ks_ = 0; ks_ < 4; ++ks_) qn[ks_] = ldnt_b8(qr_ + 32 * ks_); } while (0)
#define ML3_SB(u_) ((((size_t)(((u_) >> 2) & 127)) * 2 + ((u_) >> 9)) * 4 + ((u_) & 3))
    float mprev_n = 0.f;
    if (q_bid < (T / 128) * 4) { ml3_load(MK, MV, MLC, GT, MLN, q_bid, q_tid, kr, vr, cr, gv); ML3_QLOAD(q_bid); mprev_n = MLS[ML3_SB(q_bid) * 4 + 2]; }
    int uprev = -1;
#define ML3_FLUSH() do { _Pragma("unroll") for (int k = 0; k < 4; ++k) { const int rw = (lane >> 4) + 4 * k, ck = lane & 15; \
        *(u32x4_t*)(YM + (size_t)((uprev >> 2) * 128 + i0 + rw) * MIXW + (uprev & 3) * 128 + ck * 8) = *(const LDSP u32x4_t*)(Sw + rw * 136 + ck * 8); } } while (0)
#undef ML3_FLUSH
#define ML3_FLUSH() do { _Pragma("unroll") for (int k = 0; k < 2; ++k) { const int rw = (lane >> 3) + 8 * k, ck = lane & 7; \
        *(u32x4_t*)((unsigned char*)YM + (size_t)((uprev >> 2) * 128 + i0 + rw) * MIXW + (uprev & 3) * 128 + ck * 16) = *(const LDSP u32x4_t*)((LDSP unsigned char*)Sw + rw * 144 + ck * 16); } } while (0)
    for (int u = q_bid; u < (T / 128) * 4; u += gridDim.x) {
        const int ch = u >> 2, h = u & 3, tok0 = ch * 128;
        __syncthreads();
#pragma unroll
        for (int i = 0; i < 4; ++i) { const int c = q_tid + i * NTHR; *(LDSP u32x4_t*)(Ks + (c >> 4) * 136 + (c & 15) * 8) = kr[i]; *(LDSP u32x4_t*)(Vs + (c >> 4) * 136 + (c & 15) * 8) = vr[i]; }
#pragma unroll
        for (int i = 0; i < 4; ++i) { const int c = q_tid + i * NTHR, e = c >> 4, d = (c & 15) * 8; *(LDSP u32x4_t*)(Ct + e * 136 + d) = cr[i]; }
        gt[q_tid] = gv;
        bf16x8_t qf[4];
#pragma unroll
        for (int ks = 0; ks < 4; ++ks) qf[ks] = qn[ks];
        const float mprev = mprev_n;
        __syncthreads();
        asm volatile("" : "+v"(qf[0]), "+v"(qf[1]), "+v"(qf[2]), "+v"(qf[3]));
        if (uprev >= 0) ML3_FLUSH();
        u32x2_t ogq[8], mcq[8];
#pragma unroll
        for (int et = 0; et < 8; ++et) { const int c = h * 128 + et * 16 + 4 * g; ogq[et] = *(const u32x2_t*)(P + (size_t)(tok0 + i0 + r) * NPP + C_MO + c); mcq[et] = *(const u32x2_t*)(MC + (size_t)(tok0 + i0 + r) * MIXW + c); }
        if (u + (int)gridDim.x < (T / 128) * 4) { ml3_load(MK, MV, MLC, GT, MLN, u + gridDim.x, q_tid, kr, vr, cr, gv); ML3_QLOAD(u + gridDim.x); mprev_n = MLS[ML3_SB(u + gridDim.x) * 4 + 2]; }
        const float cum_i = gt[i0 + r], mq = cum_i + fmaxf(mprev, gt[256 + i0 + r]), inter = __expf(cum_i + mprev - mq);
        const int ntile = q_wave + 1, nt2 = (ntile + 1) & ~1;
        float den = 0.f;
        for (int jt = 0; jt < nt2; ++jt) { f32x4_t a = (f32x4_t){0.f, 0.f, 0.f, 0.f};
            if (jt < ntile) {
#pragma unroll
                for (int ks = 0; ks < 4; ++ks) a = mma(a, frag_row(Ks, 136, jt * 16, 32 * ks, r, g), qf[ks]); }
            float sv[4];
#pragma unroll
            for (int ii = 0; ii < 4; ++ii) { const int sj = jt * 16 + 4 * g + ii; sv[ii] = sj <= i0 + r ? a[ii] * __expf(cum_i - gt[sj] + gt[128 + sj] - mq) : 0.f; den += sv[ii]; }
            *(LDSP u32x2_t*)(Sw + r * 136 + jt * 16 + 4 * g) = (u32x2_t){pk2(sv[0], sv[1]), pk2(sv[2], sv[3])}; }
        f32x4_t o[8];
#pragma unroll
        for (int et = 0; et < 8; ++et) o[et] = (f32x4_t){0.f, 0.f, 0.f, 0.f};
        for (int j0 = 0; j0 < nt2 * 16; j0 += 32) { const bf16x8_t sy = frag_row(Sw, 136, 0, j0, r, g);
#pragma unroll
            for (int et = 0; et < 8; ++et) o[et] = mma(o[et], frag_tr(Vs, 136, j0, et * 16, r, g), sy); }
        float qn = 0.f;
#pragma unroll
        for (int ks = 0; ks < 4; ++ks) { float f[8]; unpack8u(__builtin_bit_cast(u32x4_t, qf[ks]), f);
#pragma unroll
            for (int jj = 0; jj < 8; ++jj) qn += f[jj] * gt[384 + 32 * ks + 8 * g + jj];
            qf[ks] = scale_frag(qf[ks], inter); }
#pragma unroll
        for (int et = 0; et < 8; ++et)
#pragma unroll
            for (int ks = 0; ks < 4; ++ks) o[et] = mma(o[et], frag_row(Ct, 136, et * 16, 32 * ks, r, g), qf[ks]);
        den += inter * qn; den += __shfl_xor(den, 16); den += __shfl_xor(den, 32);
        const float dinv = 1.0f / fmaxf(fabsf(den), __expf(-mq));
        float s1 = 0.f;
#pragma unroll
        for (int et = 0; et < 8; ++et) { o[et] *= dinv; s1 += (o[et][0] + o[et][1]) + (o[et][2] + o[et][3]); }
        s1 += __shfl_xor(s1, 16); s1 += __shfl_xor(s1, 32);
        const float mu = s1 * (1.0f / 128.0f); float s2 = 0.f;
#pragma unroll
        for (int et = 0; et < 8; ++et) { o[et] -= mu; s2 += (o[et][0] * o[et][0] + o[et][1] * o[et][1]) + (o[et][2] * o[et][2] + o[et][3] * o[et][3]); }
        s2 += __shfl_xor(s2, 16); s2 += __shfl_xor(s2, 32);
        const float rstd = rsqrtf(s2 * (1.0f / 128.0f) + LN_EPS);
        const size_t tok = (size_t)(tok0 + i0 + r);
#pragma unroll
        for (int et = 0; et < 8; ++et) { const int c = h * 128 + et * 16 + 4 * g; const f32x4_t gn_ = *(const LDSP f32x4_t*)(gw + c), sk_ = *(const LDSP f32x4_t*)(gw + 512 + c); const float4 gn = make_float4(gn_[0], gn_[1], gn_[2], gn_[3]), sk = make_float4(sk_[0], sk_[1], sk_[2], sk_[3]); const float4 og = make_float4(__uint_as_float(ogq[et].x << 16), __uint_as_float(ogq[et].x & 0xffff0000u), __uint_as_float(ogq[et].y << 16), __uint_as_float(ogq[et].y & 0xffff0000u)), mc = make_float4(__uint_as_float(mcq[et].x << 16), __uint_as_float(mcq[et].x & 0xffff0000u), __uint_as_float(mcq[et].y << 16), __uint_as_float(mcq[et].y & 0xffff0000u));
            *(LDSP unsigned*)((LDSP unsigned char*)Sw + r * 144 + et * 16 + 4 * g) = pk4_fp8(sigmoidf_(og.x) * (o[et][0] * rstd * gn.x + sk.x * mc.x), sigmoidf_(og.y) * (o[et][1] * rstd * gn.y + sk.y * mc.y), sigmoidf_(og.z) * (o[et][2] * rstd * gn.z + sk.z * mc.z), sigmoidf_(og.w) * (o[et][3] * rstd * gn.w + sk.w * mc.w)); }
        uprev = u;
    }
    if (uprev >= 0) ML3_FLUSH();
#undef ML3_FLUSH
}


constexpr size_t DO_ATT = 0;
struct AttU { size_t tokb; int grp, h, dil, rr, nb; };
__device__ __forceinline__ AttU att_decode(int u) { AttU a; a.grp = u >> 10; const int v = u & 1023, blk = v >> 2, b = blk >> 7, bi = blk & 127; a.h = v & 3;
    a.dil = a.grp == 0 ? 1 : (a.grp == 1 ? 4 : 16); a.rr = bi % a.dil; a.nb = bi / a.dil; a.tokb = (size_t)b * SEQ; return a; }
__device__ __forceinline__ void att_load(const bf16_t* P, const AttU& a, int q_tid, u32x4_t (&kreg)[4], u32x4_t (&vreg)[8]) {
#pragma unroll
    for (int i = 0; i < 4; ++i) { const int c = q_tid + i * NTHR, j = c >> 3, cc = c & 7, u0 = (a.nb - 1) * 128 + j, uu = u0 < 0 ? u0 + 128 : u0;
        kreg[i] = *(const u32x4_t*)(P + (a.tokb + (size_t)uu * a.dil + a.rr) * NPP + C_AK + a.grp * 256 + a.h * 64 + cc * 8); }
#pragma unroll
    for (int i = 0; i < 8; ++i) { const int c = q_tid + i * NTHR, j = c >> 4, cc = c & 15, u0 = (a.nb - 1) * 128 + j, uu = u0 < 0 ? u0 + 128 : u0;
        vreg[i] = *(const u32x4_t*)(P + (a.tokb + (size_t)uu * a.dil + a.rr) * NPP + C_AV + a.grp * 512 + a.h * 128 + cc * 8); }
}
__device__ __forceinline__ void ph_att(const Params& p, int q_wave, int l, float* lds) {
    PH_PROLOGUE
    LDSP bf16_t* Ks = (LDSP bf16_t*)lds; LDSP bf16_t* Vs = Ks + 256 * 72; LDSP bf16_t* Pw = Vs + 272 * 136 + q_wave * (16 * 168);
    const bf16_t* P = (const bf16_t*)(q_ws + WS_P); bf16_t* ATT = (bf16_t*)((char*)q_out + DO_ATT); float* LSE = (float*)(q_ws + WS_LSE);
    const int lane = q_tid & 63, r = lane & 15, g = lane >> 4, i0 = q_wave * 16;
    __syncthreads();
    if (q_tid < 256) *(LDSP u32x4_t*)(Vs + (256 + (q_tid >> 4)) * 136 + (q_tid & 15) * 8) = (u32x4_t){0u, 0u, 0u, 0u};
    u32x4_t kreg[4], vreg[8]; bf16x8_t qn[2];
#define ATT_QLOAD(a_) do { const bf16_t* qr_ = P + ((a_).tokb + (size_t)((a_).nb * 128 + i0 + r) * (a_).dil + (a_).rr) * NPP + C_AQ + (a_).grp * 256 + (a_).h * 64 + 8 * g; qn[0] = ldnt_b8(qr_); qn[1] = ldnt_b8(qr_ + 32); } while (0)
    if (q_bid < 3072) { const AttU a0 = att_decode(q_bid); att_load(P, a0, q_tid, kreg, vreg); ATT_QLOAD(a0); }
    float lse_prev = 0.f; int uprev = -1;
#define ATT_FLUSH() do { const AttU ap = att_decode(uprev); _Pragma("unroll") for (int k = 0; k < 4; ++k) { const int rw = (lane >> 4) + 4 * k, ck = lane & 15; \
            const size_t tk = ap.tokb + (size_t)ap.rr * (SEQ / ap.dil) + (size_t)(ap.nb * 128 + i0 + rw);   \
            *(u32x4_t*)(ATT + ((size_t)ap.grp * T + tk) * MIXW + ap.h * 128 + ck * 8) = *(const LDSP u32x4_t*)(Pw + rw * 168 + ck * 8); } \
        if (g == 0) LSE[((size_t)ap.grp * T + ap.tokb + (size_t)ap.rr * (SEQ / ap.dil) + (size_t)(ap.nb * 128 + i0 + r)) * 4 + ap.h] = lse_prev; } while (0)
    for (int u = q_bid; u < 3072; u += gridDim.x) {
        const AttU a = att_decode(u); const int grp = a.grp, h = a.h, dil = a.dil, nb = a.nb;
        const float slope = exp2f(-8.0f * (float)(grp * 4 + h + 1) / 12.0f) * (float)dil;
        __syncthreads();
#pragma unroll
        for (int i = 0; i < 4; ++i) { const int c = q_tid + i * NTHR; *(LDSP u32x4_t*)(Ks + (c >> 3) * 72 + (c & 7) * 8) = kreg[i]; }
#pragma unroll
        for (int i = 0; i < 8; ++i) { const int c = q_tid + i * NTHR; *(LDSP u32x4_t*)(Vs + (c >> 4) * 136 + (c & 15) * 8) = vreg[i]; }
        const size_t tokq = a.tokb + (size_t)(nb * 128 + i0 + r) * dil + a.rr;
        bf16x8_t qf[2]; qf[0] = qn[0]; qf[1] = qn[1];
        __syncthreads();
        asm volatile("" : "+v"(qf[0]), "+v"(qf[1]));
        if (uprev >= 0) ATT_FLUSH();
        if (u + (int)gridDim.x < 3072) { const AttU an = att_decode(u + gridDim.x); att_load(P, an, q_tid, kreg, vreg); ATT_QLOAD(an); }
        f32x4_t sc[9]; float mx = -INFINITY;
#pragma unroll
        for (int tt = 0; tt < 9; ++tt) { f32x4_t a4 = (f32x4_t){0.f, 0.f, 0.f, 0.f}; const int j0 = (q_wave + tt) * 16;
            a4 = mma(a4, frag_row(Ks, 72, j0, 0, r, g), qf[0]); a4 = mma(a4, frag_row(Ks, 72, j0, 32, r, g), qf[1]);
#pragma unroll
            for (int ii = 0; ii < 4; ++ii) { const int delta = r + 128 - 16 * tt - 4 * g - ii, j = j0 + 4 * g + ii; const bool ok = delta >= 0 && delta <= 128 && (nb > 0 || j >= 128);
                a4[ii] = ok ? a4[ii] * 0.125f - slope * (float)delta : -INFINITY; mx = fmaxf(mx, a4[ii]); }
            sc[tt] = a4; }
        mx = fmaxf(mx, __shfl_xor(mx, 16)); mx = fmaxf(mx, __shfl_xor(mx, 32));
        float ls = 0.f;
#pragma unroll
        for (int tt = 0; tt < 9; ++tt) { float pv[4];
#pragma unroll
            for (int ii = 0; ii < 4; ++ii) { pv[ii] = __expf(sc[tt][ii] - mx); ls += pv[ii]; }
            *(LDSP u32x2_t*)(Pw + r * 168 + tt * 16 + 4 * g) = (u32x2_t){pk2(pv[0], pv[1]), pk2(pv[2], pv[3])}; }
        *(LDSP u32x2_t*)(Pw + r * 168 + 144 + 4 * g) = (u32x2_t){0u, 0u};
        ls += __shfl_xor(ls, 16); ls += __shfl_xor(ls, 32);
        f32x4_t o[8];
#pragma unroll
        for (int et = 0; et < 8; ++et) o[et] = (f32x4_t){0.f, 0.f, 0.f, 0.f};
#pragma unroll
        for (int jj0 = 0; jj0 < 160; jj0 += 32) { const bf16x8_t sy = frag_row(Pw, 168, 0, jj0, r, g);
#pragma unroll
            for (int et = 0; et < 8; ++et) o[et] = mma(o[et], frag_tr(Vs, 136, i0 + jj0, et * 16, r, g), sy); }
        const float inv = 1.0f / ls;
#pragma unroll
        for (int et = 0; et < 8; ++et) *(LDSP u32x2_t*)(Pw + r * 168 + et * 16 + 4 * g) = (u32x2_t){pk2(o[et][0] * inv, o[et][1] * inv), pk2(o[et][2] * inv, o[et][3] * inv)};
        lse_prev = mx + __logf(ls); uprev = u;
    }
    if (uprev >= 0) ATT_FLUSH();
#undef ATT_FLUSH
#undef ATT_QLOAD
}
__device__ __forceinline__ void ph_att_combine(const Params& p, int q_wave, int l) {
    PH_PROLOGUE
    const bf16_t* ATT = (const bf16_t*)((char*)q_out + DO_ATT); const float* LSE = (const float*)(q_ws + WS_LSE); bf16_t* YA = (bf16_t*)((char*)q_out + DO_YA);
    const size_t step = (size_t)gridDim.x * NTHR;
    for (size_t i0 = (size_t)q_bid * NTHR + q_tid; i0 < (size_t)T * 64; i0 += 4 * step) {
        u32x4_t qa[4], qb[4], qc[4]; float l0[4], l1[4], l2[4];
#pragma unroll
        for (int j = 0; j < 4; ++j) { const size_t i = i0 + j * step < (size_t)T * 64 ? i0 + j * step : i0; const size_t tok = i >> 6; const int c8 = (int)(i & 63) * 8, h = c8 >> 7;
            const size_t ts = tok & (size_t)(SEQ - 1), tb = tok - ts, r1 = (size_t)T + tb + (ts & 3) * (SEQ / 4) + (ts >> 2), r2 = (size_t)2 * T + tb + (ts & 15) * (SEQ / 16) + (ts >> 4);
            l0[j] = LSE[tok * 4 + h]; l1[j] = LSE[r1 * 4 + h]; l2[j] = LSE[r2 * 4 + h];
            qa[j] = ldnt_u4(ATT + tok * MIXW + c8); qb[j] = ldnt_u4(ATT + r1 * MIXW + c8); qc[j] = ldnt_u4(ATT + r2 * MIXW + c8); }
        asm volatile("" ::: "memory");
#pragma unroll
        for (int j = 0; j < 4; ++j) { const size_t i = i0 + j * step; if (i < (size_t)T * 64) { const size_t tok = i >> 6; const int c8 = (int)(i & 63) * 8;
            const float m = fmaxf(l0[j], fmaxf(l1[j], l2[j])), e0 = __expf(l0[j] - m), e1 = __expf(l1[j] - m), e2 = __expf(l2[j] - m), inv = 1.0f / (e0 + e1 + e2);
            float a[8], b8[8], c[8]; unpack8u(qa[j], a); unpack8u(qb[j], b8); unpack8u(qc[j], c);
#pragma unroll
            for (int jj = 0; jj < 8; ++jj) a[jj] = (a[jj] * e0 + b8[jj] * e1 + c[jj] * e2) * inv;
            *(u32x2_t*)((unsigned char*)YA + tok * MIXW + c8) = (u32x2_t){pk4_fp8(a[0], a[1], a[2], a[3]), pk4_fp8(a[4], a[5], a[6], a[7])}; } }
    }
}


__device__ __forceinline__ void ln_row(float4 (&v)[4], const float* g, const float* b, int lane) {
    float s = 0.f;
#pragma unroll
    for (int i = 0; i < 4; ++i) s += (v[i].x + v[i].y) + (v[i].z + v[i].w);
    const float mu = wsum(s) * (1.0f / D); float q = 0.f;
#pragma unroll
    for (int i = 0; i < 4; ++i) { v[i].x -= mu; v[i].y -= mu; v[i].z -= mu; v[i].w -= mu; q += (v[i].x * v[i].x + v[i].y * v[i].y) + (v[i].z * v[i].z + v[i].w * v[i].w); }
    const float rstd = rsqrtf(wsum(q) * (1.0f / D) + LN_EPS);
#pragma unroll
    for (int i = 0; i < 4; ++i) { const float4 gg = *(const float4*)(g + RC(i)), bb = *(const float4*)(b + RC(i));
        v[i].x = v[i].x * rstd * gg.x + bb.x; v[i].y = v[i].y * rstd * gg.y + bb.y; v[i].z = v[i].z * rstd * gg.z + bb.z; v[i].w = v[i].w * rstd * gg.w + bb.w; }
}

__device__ __forceinline__ void ph_ln1_router(const Params& p, int q_wave, int l, float* lds) {
    PH_PROLOGUE
    float* X = (float*)(q_ws + WS_X); bf16_t* XB = (bf16_t*)(q_ws + WS_XB); unsigned char* XB8 = (unsigned char*)(q_ws + WS_XB8);
    const float* g1 = p.in[14] + l * D; const float* b1 = p.in[15] + l * D;
    const float* wr = p.in[16] + (size_t)l * D * NE; const float* br = p.in[17] + l * NE;
    int* topi = (int*)(q_ws + WS_TOPI); float* topp = (float*)(q_ws + WS_TOPP);
    unsigned* ctl = (unsigned*)(q_ws + WS_CTL);
    const int lane = q_tid & 63, wv = q_tid >> 6;
    LDSP float* ybuf = (LDSP float*)lds + wv * (4 * D);
    LDSP unsigned* cnt = (LDSP unsigned*)((LDSP float*)lds + 8 * 4 * D);
    for (int ch = q_bid; ch < T / 128; ch += gridDim.x) {
        if (q_tid < NE) cnt[q_tid] = 0u;
        __syncthreads();
        float4 nx[4];
#pragma unroll
        for (int i = 0; i < 4; ++i) nx[i] = ldnt_f4(X + (size_t)(ch * 128 + wv * 16) * D + RC(i));
        for (int grp = 0; grp < 4; ++grp) {
#pragma unroll
            for (int tt = 0; tt < 4; ++tt) {
                const int it = grp * 4 + tt, tok = ch * 128 + wv * 16 + it;
                float4 v[4];
#pragma unroll
                for (int i = 0; i < 4; ++i) v[i] = nx[i];
                if (it < 15) {
#pragma unroll
                    for (int i = 0; i < 4; ++i) nx[i] = ldnt_f4(X + (size_t)(tok + 1) * D + RC(i)); }
                ln_row(v, g1, b1, lane);
#pragma unroll
                for (int i = 0; i < 4; ++i) { const int cb = RC(i), sw = lane & 7;
                    ybuf[((cb + 0) ^ sw) * 4 + tt] = v[i].x; ybuf[((cb + 1) ^ sw) * 4 + tt] = v[i].y; ybuf[((cb + 2) ^ sw) * 4 + tt] = v[i].z; ybuf[((cb + 3) ^ sw) * 4 + tt] = v[i].w; }
#pragma unroll
                for (int c = 0; c < 2; ++c) { const float f8[8] = {v[2 * c].x, v[2 * c].y, v[2 * c].z, v[2 * c].w, v[2 * c + 1].x, v[2 * c + 1].y, v[2 * c + 1].z, v[2 * c + 1].w};
                    *(u32x4_t*)(XB + (size_t)tok * D + c * 512 + lane * 8) = pack8u(f8);
                    *(u32x2_t*)(XB8 + (size_t)tok * D + c * 512 + lane * 8) = (u32x2_t){pk4_fp8(f8[0], f8[1], f8[2], f8[3]), pk4_fp8(f8[4], f8[5], f8[6], f8[7])}; }
            }
            const int e = lane & 31, hf = lane >> 5; f32x2_t a01 = (f32x2_t){0.f, 0.f}, a23 = (f32x2_t){0.f, 0.f};
            const float* wp = wr + (size_t)(hf * 512) * NE + e; const LDSP float* yq = ybuf + hf * 512 * 4;
#pragma unroll 8
            for (int c = 0; c < 512; ++c) { const f32x4_t y = *(const LDSP f32x4_t*)(yq + c * 4); const float w = wp[(size_t)(c ^ ((c >> 3) & 7)) * NE];     const f32x2_t w2 = (f32x2_t){w, w};
                a01 = __builtin_elementwise_fma((f32x2_t){y[0], y[1]}, w2, a01); a23 = __builtin_elementwise_fma((f32x2_t){y[2], y[3]}, w2, a23); }
            float lg4[4] = {a01[0], a01[1], a23[0], a23[1]};
#pragma unroll
            for (int tt = 0; tt < 4; ++tt) { const int tok = ch * 128 + wv * 16 + grp * 4 + tt;
                float acc = lg4[tt]; acc += __shfl_xor(acc, 32); acc += br[e];
                float val = lane < 32 ? acc : -INFINITY; float tv[4]; int ti[4];
#pragma unroll
                for (int r = 0; r < 4; ++r) { const float mx = wmax(val); const unsigned long long bal = __ballot(val == mx); const int idx = __ffsll((long long)bal) - 1; tv[r] = mx; ti[r] = idx; if (lane == idx) val = -INFINITY; }
                const float e1 = __expf(tv[1] - tv[0]), e2 = __expf(tv[2] - tv[0]), e3 = __expf(tv[3] - tv[0]), inv = 1.0f / (1.0f + e1 + e2 + e3);
                if (lane == 0) { *(int4*)(topi + (size_t)tok * 4) = make_int4(ti[0], ti[1], ti[2], ti[3]); *(float4*)(topp + (size_t)tok * 4) = make_float4(inv, e1 * inv, e2 * inv, e3 * inv); }
                { const int myti = lane == 0 ? ti[0] : (lane == 1 ? ti[1] : (lane == 2 ? ti[2] : ti[3])); if (lane < 4) __hip_atomic_fetch_add(&cnt[myti], 1u, __ATOMIC_RELAXED, __HIP_MEMORY_SCOPE_WORKGROUP); } }
        }
        __syncthreads();
        if (q_tid < NE) ctl[CW_CHCNT + ch * NE + q_tid] = cnt[q_tid];
        __syncthreads();
    }
}
__device__ __forceinline__ void ph_assign(const Params& p, int q_wave, int l, float* lds) {
    PH_PROLOGUE
    unsigned* ctl = (unsigned*)(q_ws + WS_CTL);
    const int* topi = (const int*)(q_ws + WS_TOPI); const float* topp = (const float*)(q_ws + WS_TOPP);
    int* tokrow = (int*)(q_ws + WS_TOKROW); int* rowtok = (int*)(q_ws + WS_ROWTOK); float* rowp = (float*)(q_ws + WS_ROWP);
    LDSP unsigned* base = (LDSP unsigned*)lds;
    LDSP unsigned* tot = base + 32;
    LDSP unsigned* pst = base + 64;
    LDSP unsigned* red = base + 128;
    for (int ch = q_bid; ch < T / 128; ch += gridDim.x) {
        { const int e = q_tid & 31, part = q_tid >> 5; unsigned before = 0, all = 0;
#pragma unroll
          for (int k = 0; k < 16; ++k) { const int c = part * 16 + k; const unsigned v = ctl[CW_CHCNT + c * NE + e]; all += v; before += c < ch ? v : 0u; }
          red[q_tid] = before; red[512 + q_tid] = all; }
        __syncthreads();
        if (q_tid < NE) { unsigned before = 0, all = 0;
#pragma unroll
          for (int k = 0; k < 16; ++k) { before += red[k * 32 + q_tid]; all += red[512 + k * 32 + q_tid]; }
          base[q_tid] = before; tot[q_tid] = all; }
        __syncthreads();
        if (q_tid == 0) { unsigned s = 0; for (int e = 0; e < NE; ++e) { pst[e] = s; s += (tot[e] + 255u) / 256u * 256u; } pst[NE] = s; }
        __syncthreads();
        if (q_tid < NE) base[q_tid] += pst[q_tid];
        __syncthreads();
        { const int tok = ch * 128 + (q_tid >> 2), k = q_tid & 3; const int e = topi[(size_t)tok * 4 + k];
          const unsigned row = __hip_atomic_fetch_add(&base[e], 1u, __ATOMIC_RELAXED, __HIP_MEMORY_SCOPE_WORKGROUP); tokrow[(size_t)tok * 4 + k] = (int)row; rowtok[row] = tok; rowp[row] = topp[(size_t)tok * 4 + k]; }
        if (ch == 0) {
            for (int e = 0; e < NE; ++e) { const unsigned s = pst[e] + tot[e], en = pst[e + 1]; for (unsigned r = s + q_tid; r < en; r += NTHR) { rowtok[r] = 0; rowp[r] = 0.f; } }
            if (q_tid < NE) { ctl[CW_PSTART + q_tid] = pst[q_tid]; for (unsigned tl = pst[q_tid] / 256u; tl < pst[q_tid + 1] / 256u; ++tl) ctl[CW_TILEE + tl] = q_tid; }
            if (q_tid == 0) ctl[CW_NTILES] = pst[NE] / 256u;
        }
        __syncthreads();
    }
}
__device__ __forceinline__ void ph_ln2(const Params& p, int q_wave, int l, float* lds) {
    PH_PROLOGUE
    LDSP float* wig = (LDSP float*)lds; float* IGF = (float*)(q_ws + WS_IGF); unsigned char* XB8 = (unsigned char*)(q_ws + WS_XB8);
    if (l != DEPTH - 1) { __syncthreads(); stage_wig(p.in[1] + (size_t)(l + 1) * D * DIN, wig, q_tid); __syncthreads(); }
    float* X = (float*)(q_ws + WS_X); bf16_t* XB = (bf16_t*)(q_ws + WS_XB); const bf16_t* Y = (const bf16_t*)(q_ws + WS_Y);
    const int* tokrow = (const int*)(q_ws + WS_TOKROW);
    const float* g2 = p.in[24] + l * D; const float* b2 = p.in[25] + l * D;
    const int lane = q_tid & 63, wv = q_tid >> 6;
    const int tstep = gridDim.x * 8; int tok = q_bid * 8 + wv;
    int4 r1 = make_int4(0, 0, 0, 0); u32x4_t xq[2], yq[2][4];
    const bool y8 = l == DEPTH - 1;
#define LN2_LOAD(t_, r_) do { const int rr_[4] = {(r_).x, (r_).y, (r_).z, (r_).w}; _Pragma("unroll") for (int c = 0; c < 2; ++c) { xq[c] = ldnt_u4(XB + (size_t)(t_) * D + c * 512 + lane * 8); \
        _Pragma("unroll") for (int k = 0; k < 4; ++k) { if (y8) { const uint2 t8_ = ldnt_u2((const unsigned char*)Y + (size_t)rr_[k] * D + c * 512 + lane * 8); yq[c][k] = (u32x4_t){t8_.x, t8_.y, 0u, 0u}; } \
            else yq[c][k] = ldnt_u4(Y + (size_t)rr_[k] * D + c * 512 + lane * 8); } } } while (0)
    if (tok < T) { const int4 r0 = *(const int4*)(tokrow + (size_t)tok * 4); if (tok + tstep < T) r1 = *(const int4*)(tokrow + (size_t)(tok + tstep) * 4); LN2_LOAD(tok, r0); }
    int tprev = -1; u32x4_t hb[2] = {}; u32x2_t h8[2] = {}; float hg[8] = {}; f32x4_t ho[4] = {};
#define LN2_FLUSH() do { if (l == DEPTH - 1) { _Pragma("unroll") for (int i = 0; i < 4; ++i) __builtin_nontemporal_store(ho[i], (f32x4_t*)(q_out + (size_t)tprev * D + RC(i))); } \
        else { _Pragma("unroll") for (int c = 0; c < 2; ++c) { *(u32x4_t*)(XB + (size_t)tprev * D + c * 512 + lane * 8) = hb[c]; *(u32x2_t*)(XB8 + (size_t)tprev * D + c * 512 + lane * 8) = h8[c]; } igf_store(hg, IGF, tprev, lane); } } while (0)
    for (; tok < T; tok += tstep) {
        float4 v[4];
#pragma unroll
        for (int c = 0; c < 2; ++c) { float xa[8]; unpack8u(xq[c], xa);
#pragma unroll
            for (int j = 0; j < 8; ++j) xa[j] *= DN_ALPHA;
#pragma unroll
            for (int k = 0; k < 4; ++k) { float ya[8];
                if (y8) { const f32x2_t a0 = __builtin_amdgcn_cvt_pk_f32_fp8((int)yq[c][k][0], false), a1 = __builtin_amdgcn_cvt_pk_f32_fp8((int)yq[c][k][0], true), a2 = __builtin_amdgcn_cvt_pk_f32_fp8((int)yq[c][k][1], false), a3 = __builtin_amdgcn_cvt_pk_f32_fp8((int)yq[c][k][1], true);
                    ya[0] = a0[0] * (1.0f / YSC); ya[1] = a0[1] * (1.0f / YSC); ya[2] = a1[0] * (1.0f / YSC); ya[3] = a1[1] * (1.0f / YSC); ya[4] = a2[0] * (1.0f / YSC); ya[5] = a2[1] * (1.0f / YSC); ya[6] = a3[0] * (1.0f / YSC); ya[7] = a3[1] * (1.0f / YSC); }
                else unpack8u(yq[c][k], ya);
#pragma unroll
                for (int j = 0; j < 8; ++j) xa[j] += ya[j]; }
            v[2 * c] = make_float4(xa[0], xa[1], xa[2], xa[3]); v[2 * c + 1] = make_float4(xa[4], xa[5], xa[6], xa[7]); }
        asm volatile("" : "+v"(v[0].x), "+v"(v[1].x), "+v"(v[2].x), "+v"(v[3].x));
        if (tprev >= 0) LN2_FLUSH();
        if (tok + tstep < T) { const int4 rc = r1; if (tok + 2 * tstep < T) r1 = *(const int4*)(tokrow + (size_t)(tok + 2 * tstep) * 4); LN2_LOAD(tok + tstep, rc); }
        ln_row(v, g2, b2, lane);
        if (l == DEPTH - 1) {
#pragma unroll
            for (int i = 0; i < 4; ++i) ho[i] = (f32x4_t){v[i].x, v[i].y, v[i].z, v[i].w};
        } else {
#pragma unroll
            for (int c = 0; c < 2; ++c) { const float f8[8] = {v[2 * c].x, v[2 * c].y, v[2 * c].z, v[2 * c].w, v[2 * c + 1].x, v[2 * c + 1].y, v[2 * c + 1].z, v[2 * c + 1].w};
                hb[c] = pack8u(f8); h8[c] = (u32x2_t){pk4_fp8(f8[0], f8[1], f8[2], f8[3]), pk4_fp8(f8[4], f8[5], f8[6], f8[7])}; }
            igf_calc(v, wig, lane, hg);
        }
        tprev = tok;
    }
    if (tprev >= 0) LN2_FLUSH();
#undef LN2_FLUSH
#undef LN2_LOAD
}

#define XB_TMO      128
#define XB_XCNT(j)  (256  + 64 * (j))
#define XB_XSUB(j)  (1280 + 64 * (j))
#define XB_XGEN(j)  (2304 + 64 * (j))
#define XB_TOP      3328
#define XB_TOPGEN   3392
#define XCD_BAR_WORDS 3456
#define XB_SPIN_CAP (1u << 22)
#define LAS __attribute__((address_space(3)))
__device__ __forceinline__ unsigned xb_ld(unsigned* p)              { return __hip_atomic_load(p, __ATOMIC_RELAXED, __HIP_MEMORY_SCOPE_AGENT); }
__device__ __forceinline__ unsigned xb_add(unsigned* p, unsigned v) { return __hip_atomic_fetch_add(p, v, __ATOMIC_RELAXED, __HIP_MEMORY_SCOPE_AGENT); }
__device__ __forceinline__ unsigned xb_xcc_id() { return (unsigned)__builtin_amdgcn_s_getreg((3 << 11) | 20) & 0xFu; }
#define XB_SPIN(cond, bar) do { unsigned _sp = 0; while (cond) { __builtin_amdgcn_s_sleep(1); \
    if ((++_sp & 255u) == 0u) { if (xb_ld(&(bar)[XB_TMO])) break; if (_sp > XB_SPIN_CAP) { atomicAdd(&(bar)[XB_TMO], 1u); break; } } } } while (0)
struct XcdBarrier { unsigned* bar; unsigned x; volatile LAS unsigned* st; int wave; };
__device__ __forceinline__ XcdBarrier xcd_barrier_post(unsigned* bar, volatile LAS unsigned* st, int wave) {
    XcdBarrier b; b.bar = bar; b.x = xb_xcc_id(); b.st = st; b.wave = wave;
    if (wave == 0 && lane_id() == 0) (void)xb_add(&bar[XB_XCNT(b.x)], 1u);
    return b;
}
__device__ __forceinline__ void xcd_barrier_complete(unsigned* bar, unsigned x, unsigned& nloc, unsigned& nx) {
    const unsigned G = gridDim.x * gridDim.y * gridDim.z;
    unsigned sum, cnt, mine, sp = 0u;
    for (;;) {
        sum = 0u; cnt = 0u; mine = 0u;
#pragma unroll
        for (unsigned j = 0; j < 16; ++j) { const unsigned c = xb_ld(&bar[XB_XCNT(j)]); sum += c; cnt += (c > 0u) ? 1u : 0u; mine = (j == x) ? c : mine; }
        if (sum == G) break;
        __builtin_amdgcn_s_sleep(1);
        if ((++sp & 255u) == 0u) { if (xb_ld(&bar[XB_TMO])) break; if (sp > XB_SPIN_CAP) { atomicAdd(&bar[XB_TMO], 1u); break; } }
    }
    nloc = mine > 0u ? mine : 1u; nx = cnt > 0u ? cnt : 1u;
}
__device__ __forceinline__ void xcd_barrier(const XcdBarrier& b) {
    asm volatile("s_waitcnt vmcnt(0)" ::: "memory");
    __syncthreads();
    if (b.wave == 0 && lane_id() == 0) {
        unsigned* bar = b.bar;
        __builtin_amdgcn_s_waitcnt(0);
        unsigned nloc = b.st[0], nx = b.st[1];
        if (nloc == 0u) { xcd_barrier_complete(bar, b.x, nloc, nx); b.st[0] = nloc; b.st[1] = nx; }
        const unsigned old = xb_add(&bar[XB_XSUB(b.x)], 1u);
        const unsigned gen = old / nloc;
        if (old + 1u == (gen + 1u) * nloc) {
            __builtin_amdgcn_fence(__ATOMIC_RELEASE, "agent");
            asm volatile("s_waitcnt vmcnt(0)" ::: "memory");
            const unsigned og = xb_add(&bar[XB_TOP], 1u);
            const unsigned tg = og / nx;
            if (og + 1u == (tg + 1u) * nx) xb_add(&bar[XB_TOPGEN], 1u);
            else XB_SPIN(xb_ld(&bar[XB_TOPGEN]) == tg, bar);
            __builtin_amdgcn_fence(__ATOMIC_ACQUIRE, "agent");
            xb_add(&bar[XB_XGEN(b.x)], 1u);
            asm volatile("s_waitcnt vmcnt(0)" ::: "memory");
        } else {
            XB_SPIN(xb_ld(&bar[XB_XGEN(b.x)]) == gen, bar);
            __builtin_amdgcn_fence(__ATOMIC_ACQUIRE, "agent");
            asm volatile("s_waitcnt vmcnt(0)" ::: "memory");
        }
    }
    __syncthreads();
}
constexpr int CW_BAR = 65536;
constexpr int LDS_BYTES = 154112;

__global__ void __launch_bounds__(NTHR, 2) k_mega(Params pk) {
    extern __shared__ __attribute__((aligned(16))) float lds[];
    volatile LAS unsigned* xbw = (volatile LAS unsigned*)((LAS char*)lds + LDS_BYTES - 16);
    const int q_wave = __builtin_amdgcn_readfirstlane((int)(threadIdx.x >> 6));
    if (threadIdx.x == 0) { xbw[0] = 0u; xbw[1] = 0u; xbw[2] = 0u; xbw[3] = 0u; }
    __syncthreads();
    const Params& p = pk;
    (void)xcd_barrier_post((unsigned*)(uni_ptr(pk.ws) + WS_CTL) + CW_BAR, xbw, q_wave);
#define GRID_SYNC() do { XcdBarrier bar_; bar_.bar = (unsigned*)(uni_ptr(pk.ws) + WS_CTL) + CW_BAR; bar_.x = xb_xcc_id(); bar_.st = xbw; bar_.wave = q_wave; xcd_barrier(bar_); } while (0)
#define LAYER_BODY(l) do { \
        if (l == 0) { ph_pre(p, q_wave, l, lds);               GRID_SYNC(); } \
        ph_inproj_mfma(p, q_wave, l, lds);       GRID_SYNC(); \
        ph_ret1(p, q_wave, l, lds); ph_ml1(p, q_wave, l, lds); ph_att(p, q_wave, l, lds);   GRID_SYNC(); \
        ph_ret2(p, q_wave, l); ph_ml2(p, q_wave, l, lds);   GRID_SYNC(); \
        ph_ret3(p, q_wave, l, lds); ph_ml3(p, q_wave, l, lds); ph_att_combine(p, q_wave, l);   GRID_SYNC(); \
        ph_merge_mfma(p, q_wave, l, lds);        GRID_SYNC(); \
        ph_outproj_mfma(p, q_wave, l, lds);      GRID_SYNC(); \
        ph_ln1_router(p, q_wave, l, lds);        GRID_SYNC(); \
        ph_assign(p, q_wave, l, lds); if (l + 1 < DEPTH) ph_prew(p, q_wave, l + 1, lds); ph_mwc_tail(p, q_wave, l, lds);   GRID_SYNC(); \
        ph_moe1_mfma(p, q_wave, l, lds);         GRID_SYNC(); \
        ph_moe2_mfma(p, q_wave, l, lds);         GRID_SYNC(); \
        ph_ln2(p, q_wave, l, lds);               GRID_SYNC(); \
    } while (0)
    LAYER_BODY(0);
    LAYER_BODY(1);
#undef LAYER_BODY
}

}

extern "C" void kernel_launch(void* const* d_in, const int* in_sizes, int n_in, void* d_out, int out_size, void* d_ws, size_t ws_size, hipStream_t stream) {
    if (n_in != 26 || out_size != T * D || ws_size < WS_END) { fprintf(stderr, "kernel_launch: unexpected shapes (n_in %d out %d ws %zu need %zu)\n", n_in, out_size, ws_size, (size_t)WS_END); return; }
    Params p; memset(&p, 0, sizeof(p));
    for (int i = 0; i < 26; ++i) p.in[i] = (const float*)d_in[i];
    p.out = (float*)d_out; p.ws = (char*)d_ws;
    (void)hipMemsetAsync((char*)d_ws + WS_CTL, 0, CTL_BYTES, stream);
    static int grid = 0;
    if (!grid) {
        int dev = 0, cus = 0, per_cu = 0;
        if (hipGetDevice(&dev) != hipSuccess || hipDeviceGetAttribute(&cus, hipDeviceAttributeMultiprocessorCount, dev) != hipSuccess) { fprintf(stderr, "kernel_launch: device query failed\n"); grid = -1; return; }
        (void)hipFuncSetAttribute((const void*)k_mega, hipFuncAttributeMaxDynamicSharedMemorySize, LDS_BYTES);
        if (hipOccupancyMaxActiveBlocksPerMultiprocessor(&per_cu, (const void*)k_mega, NTHR, LDS_BYTES) != hipSuccess || per_cu < 1) { fprintf(stderr, "kernel_launch: occupancy query says %d\n", per_cu); grid = -1; return; }
        grid = cus;
    }
    if (grid < 0) return;
    hipLaunchKernelGGL(k_mega, dim3(grid), dim3(NTHR), LDS_BYTES, stream, p);
}
```

```cpp
#include <hip/hip_runtime.h>
#include <type_traits>
#include <stdint.h>
#include <stdio.h>
#include <string.h>

namespace {
typedef unsigned short bf16_t;
typedef short bf16x8_t __attribute__((ext_vector_type(8)));
typedef short s16x4_t __attribute__((ext_vector_type(4)));
typedef float f32x4_t __attribute__((ext_vector_type(4)));
typedef float f32x2_t __attribute__((ext_vector_type(2)));
typedef unsigned u32x4_t __attribute__((ext_vector_type(4)));
typedef unsigned u32x2_t __attribute__((ext_vector_type(2)));
#define LDSP __attribute__((address_space(3)))
constexpr int D = 1024, BATCH = 2, SEQ = 16384, T = BATCH * SEQ, DEPTH = 2;
constexpr int MIXW = 512, DIN = 8712, NP = 8704, NPP = 5632;
constexpr int C_RQ = 0, C_RK = 256, C_RV = 512, C_RG = 1024, C_MX = 1536, C_MO = 2048, C_AQ = 2560, C_AK = 3328, C_AV = 4096, C_GT = 5632;
constexpr int NE = 32, TOPK = 4, RMAX = 139264  , MAXTILES = 544;
constexpr float DN_ALPHA = 1.41421356237f, LN_EPS = 1e-5f, SWI_LIMIT = 7.0f, SWI_ALPHA = 1.702f;
constexpr int NTHR = 512;
#define RC(i) ((((i) >> 1) * 512) + lane * 8 + (((i) & 1) * 4))
constexpr float WSC_OUT = 32.0f;
constexpr float WSC_BR = 32.0f;
constexpr float WSC_IN = 32.0f;

constexpr size_t MiB = 1u << 20;
constexpr size_t WS_CTL = 0, CTL_BYTES = 1 * MiB;
constexpr size_t WS_P = WS_CTL + CTL_BYTES;
constexpr size_t P_BYTES = (size_t)T * NP * 2;
constexpr size_t WS_H = WS_P, WS_Y = WS_P + (size_t)RMAX * D * 2;
constexpr size_t WS_G = WS_P + (size_t)T * NPP * 2;
constexpr size_t WS_B = WS_P + P_BYTES;
constexpr size_t B_BYTES = (size_t)NE * 3 * D * D * 2;
constexpr size_t WS_S = WS_B;
constexpr size_t WS_MLC = WS_B + 32 * MiB, WS_MQ = WS_B + 96 * MiB, WS_MK = WS_B + 128 * MiB, WS_MV = WS_B + 160 * MiB;
constexpr size_t WS_X = WS_B + B_BYTES;
constexpr size_t WS_XB = WS_X + (size_t)T * D * 4;
constexpr size_t WS_YR = WS_X, WS_YM = WS_X + (size_t)T * MIXW;
constexpr size_t WS_IGF = WS_XB + (size_t)T * D * 2;
constexpr size_t WS_TOPI = WS_IGF + (size_t)T * 8 * 4;
constexpr size_t WS_TOPP = WS_TOPI + (size_t)T * 4 * 4;
constexpr size_t WS_TOKROW = WS_TOPP + (size_t)T * 4 * 4;
constexpr size_t WS_ROWTOK = WS_TOKROW + (size_t)T * 4 * 4;
constexpr size_t WS_ROWP = WS_ROWTOK + (size_t)RMAX * 4;
constexpr size_t WS_WIN = WS_ROWP + (size_t)RMAX * 4;
constexpr size_t WS_WBT = WS_WIN + (size_t)NP * D * 2;
constexpr size_t WS_WOT = WS_WBT + (size_t)3 * D * MIXW * 2;
constexpr size_t WS_MC = WS_WOT + (size_t)D * D * 2;
constexpr size_t WS_MLN = WS_MC + (size_t)T * MIXW * 2;
constexpr size_t WS_MLS = WS_MLN + (size_t)128 * 8 * 128 * 4;
constexpr size_t WS_LSE = WS_MLS + (size_t)128 * 8 * 4 * 4;
constexpr size_t WS_XB8 = WS_LSE + (size_t)3 * T * 4 * 4;
constexpr size_t WS_GT = WS_XB8 + (size_t)T * D;
constexpr size_t WS_END = WS_GT + (size_t)256 * 4 * 384 * 4;
constexpr size_t DO_MG = 0;
constexpr size_t DO_YA = 3 * (size_t)T * MIXW * 2;
constexpr int CW_CHCNT = 1024;
constexpr int CW_PSTART = 16384;
constexpr int CW_NTILES = 16500;
constexpr int CW_TILEE = 16640;

struct Params {
    const float* in[26];
    float* out;
    char* ws;
};

__device__ __forceinline__ int lane_id() { return (int)__builtin_amdgcn_mbcnt_hi(~0u, __builtin_amdgcn_mbcnt_lo(~0u, 0u)); }
__device__ __forceinline__ int tid_of(int q_wave) { int t = q_wave * 64 + lane_id(); asm volatile("" : "+v"(t)); return t; }
__device__ __forceinline__ float4 ldnt_f4(const float* p) { const f32x4_t v = __builtin_nontemporal_load((const f32x4_t*)p); return make_float4(v[0], v[1], v[2], v[3]); }
__device__ __forceinline__ uint2 ldnt_u2(const void* p) { const u32x2_t v = __builtin_nontemporal_load((const u32x2_t*)p); return make_uint2(v[0], v[1]); }
__device__ __forceinline__ u32x4_t ldnt_u4(const void* p) { return __builtin_nontemporal_load((const u32x4_t*)p); }
__device__ __forceinline__ bf16x8_t ldnt_b8(const bf16_t* p) { return __builtin_nontemporal_load((const bf16x8_t*)p); }
__device__ __forceinline__ float4 ldnt_bf4(const bf16_t* p) { const u32x2_t u = __builtin_nontemporal_load((const u32x2_t*)p); return make_float4(__uint_as_float(u[0] << 16), __uint_as_float(u[0] & 0xffff0000u), __uint_as_float(u[1] << 16), __uint_as_float(u[1] & 0xffff0000u)); }
__device__ __forceinline__ float bf2f(bf16_t b) { return __uint_as_float(((unsigned)b) << 16); }
__device__ __forceinline__ unsigned cvtpk_bf16(float lo, float hi) { unsigned r; asm("v_cvt_pk_bf16_f32 %0, %1, %2" : "=v"(r) : "v"(lo), "v"(hi)); return r; }
__device__ __forceinline__ bf16_t f2bf(float f) { unsigned u = __float_as_uint(f); u += 0x7FFFu + ((u >> 16) & 1u); return (bf16_t)(u >> 16); }
__device__ __forceinline__ unsigned pk4_fp8(float a, float b, float c, float d) { int w = 0; w = __builtin_amdgcn_cvt_pk_fp8_f32(a, b, w, false); w = __builtin_amdgcn_cvt_pk_fp8_f32(c, d, w, true); return (unsigned)w; }
__device__ __forceinline__ float sigmoidf_(float x) { return __builtin_amdgcn_rcpf(1.0f + __expf(-x)); }
__device__ __forceinline__ float wsum(float v) {
#pragma unroll
    for (int o = 32; o > 0; o >>= 1) v += __shfl_xor(v, o);
    return v; }
__device__ __forceinline__ float wmax(float v) {
#pragma unroll
    for (int o = 32; o > 0; o >>= 1) v = fmaxf(v, __shfl_xor(v, o));
    return v; }

__device__ __forceinline__ float4 ld_bf4(const bf16_t* p) { const uint2 u = *(const uint2*)p; return make_float4(__uint_as_float(u.x << 16), __uint_as_float(u.x & 0xffff0000u), __uint_as_float(u.y << 16), __uint_as_float(u.y & 0xffff0000u)); }
__device__ __forceinline__ void st_bf4(bf16_t* p, float4 v) { uint2 u; u.x = cvtpk_bf16(v.x, v.y); u.y = cvtpk_bf16(v.z, v.w); *(uint2*)p = u; }

__device__ __forceinline__ char* uni_ptr(const void* p) { const unsigned long long v = (unsigned long long)p; unsigned lo = __builtin_amdgcn_readfirstlane((unsigned)v), hi = __builtin_amdgcn_readfirstlane((unsigned)(v >> 32)); asm volatile("" : "+s"(lo), "+s"(hi)); return (char*)(__attribute__((address_space(1))) char*)(((unsigned long long)hi << 32) | lo); }
#define PH_PROLOGUE int q_tid = tid_of(q_wave), q_bid = blockIdx.x; asm volatile("" : "+s"(q_bid)); char* q_ws = uni_ptr(p.ws); float* q_out = (float*)uni_ptr(p.out);
namespace pg8 {
#define PG8_LAS __attribute__((address_space(3)))
typedef short bf16x8 __attribute__((ext_vector_type(8)));
typedef float f32x4 __attribute__((ext_vector_type(4)));
typedef unsigned u32x4 __attribute__((ext_vector_type(4)));
constexpr int BM = 256, BK = 64, HALF = 128, HTB = HALF * BK * 2, STAGE_BYTES = 8 * HTB, NXCD = 8, WGM = 8;
__device__ __forceinline__ int lds_byte(int r, int c) { const int st = (r >> 4) * 2 + (c >> 5), rr = r & 15, cc = c & 31, ob = rr * 64 + cc * 2; return st * 1024 + (ob ^ (((ob >> 9) & 1) << 5)); }
__device__ __forceinline__ void stage_rc(int b, int& R, int& C) { const int st = b / 1024, sb = b % 1024, swz = sb ^ (((sb >> 9) & 1) << 5); R = (st >> 1) * 16 + swz / 64; C = (st & 1) * 32 + (swz % 64) / 2; }
__device__ __forceinline__ int perm32(int rho) { const int n = rho >> 4, i = rho & 15; return 8 * (i >> 2) + 4 * n + (i & 3); }
__device__ __forceinline__ unsigned cvt_pk_bf16(float lo, float hi) { unsigned r; asm volatile("v_cvt_pk_bf16_f32 %0, %1, %2" : "=v"(r) : "v"(lo), "v"(hi)); return r; }
typedef int i32x4 __attribute__((ext_vector_type(4)));
typedef int i32x8 __attribute__((ext_vector_type(8)));

struct Unit { const char* a0; const char* a1; const char* b0; const char* b1; int row0, col0, aux; };
template <bool GATHER, bool F8, class Epi, class Sched>
__device__ __forceinline__ void gemm_phase(const int tid, PG8_LAS unsigned char* lds, const int K, const int* __restrict__ rowidx, const Sched& S, const Epi& E) {
    const int wid = __builtin_amdgcn_readfirstlane(tid >> 6), lane = tid & 63, wr = wid >> 2, wc = wid & 3, fr = lane & 15, fq = lane >> 4;
    const int nt = K / BK;
    unsigned voffA[2], voffB[2]; int rA[2];
#pragma unroll
    for (int i = 0; i < 2; ++i) { int R, C; stage_rc(tid * 16 + i * 8192, R, C); const int Rb = Epi::PERM ? ((R & ~31) + perm32(R & 31)) : R;
        voffA[i] = GATHER ? (unsigned)(C * 2) : (unsigned)(R * K + C) * 2u; voffB[i] = (unsigned)(Rb * K + C) * 2u; rA[i] = R; }
    const size_t kstep = (size_t)(BK * 2);
    const unsigned ldsw = (unsigned)wid * 1024u;
    const int aoff = lds_byte(wr * 64 + fr, fq * 8), boff = lds_byte(wc * 32 + fr, fq * 8);
#define PG8_SA(b, h) (((b) * 2 + (h)) * HTB)
#define PG8_SB(b, h) ((4 + (b) * 2 + (h)) * HTB)
#define PG8_STAGE(bufoff, gbase, v0, v1) do { \
        __builtin_amdgcn_global_load_lds((const unsigned*)((const char*)(gbase) + (v0)), (PG8_LAS unsigned*)(lds + (bufoff) + ldsw), 16, 0, 0); \
        __builtin_amdgcn_global_load_lds((const unsigned*)((const char*)(gbase) + (v1)), (PG8_LAS unsigned*)(lds + (bufoff) + ldsw + 8192), 16, 0, 0); } while (0)
#define PG8_LDA(dst, b, h) do { _Pragma("unroll") for (int m = 0; m < 4; ++m) { const i32x4 lo_ = *(const PG8_LAS i32x4*)(lds + PG8_SA(b, h) + aoff + m * 2048), hi_ = *(const PG8_LAS i32x4*)(lds + PG8_SA(b, h) + aoff + m * 2048 + 1024); \
        dst[m] = __builtin_shufflevector(lo_, hi_, 0, 1, 2, 3, 4, 5, 6, 7); } } while (0)
#define PG8_LDB(dst, b, h) do { _Pragma("unroll") for (int n = 0; n < 2; ++n) { const i32x4 lo_ = *(const PG8_LAS i32x4*)(lds + PG8_SB(b, h) + boff + n * 2048), hi_ = *(const PG8_LAS i32x4*)(lds + PG8_SB(b, h) + boff + n * 2048 + 1024); \
        dst[n] = __builtin_shufflevector(lo_, hi_, 0, 1, 2, 3, 4, 5, 6, 7); } } while (0)
#define PG8_LO(v) __builtin_bit_cast(bf16x8, (i32x4)__builtin_shufflevector(v, v, 0, 1, 2, 3))
#define PG8_HI(v) __builtin_bit_cast(bf16x8, (i32x4)__builtin_shufflevector(v, v, 4, 5, 6, 7))
#define PG8_MMA(ai, bj, At, Bt) do { __builtin_amdgcn_s_setprio(1); \
        if constexpr (F8) { _Pragma("unroll") for (int m = 0; m < 4; ++m) _Pragma("unroll") for (int n = 0; n < 2; ++n) \
            asm volatile("v_mfma_scale_f32_16x16x128_f8f6f4 %0, %1, %2, %0, %3, %3 op_sel_hi:[0,0,0]" : "+v"(acc[ai][bj][m][n]) : "v"(Bt[n]), "v"(At[m]), "v"(sc1)); } \
        else { _Pragma("unroll") for (int m = 0; m < 4; ++m) _Pragma("unroll") for (int n = 0; n < 2; ++n) { \
            acc[ai][bj][m][n] = __builtin_amdgcn_mfma_f32_16x16x32_bf16(PG8_LO(Bt[n]), PG8_LO(At[m]), acc[ai][bj][m][n], 0, 0, 0); \
            acc[ai][bj][m][n] = __builtin_amdgcn_mfma_f32_16x16x32_bf16(PG8_HI(Bt[n]), PG8_HI(At[m]), acc[ai][bj][m][n], 0, 0, 0); } } \
        __builtin_amdgcn_s_setprio(0); } while (0)
#define PG8_WAIT_V(n) asm volatile("s_waitcnt vmcnt(" #n ")" ::: "memory")
#define PG8_WAIT_L(n) asm volatile("s_waitcnt lgkmcnt(" #n ")" ::: "memory")
#define PG8_BAR __builtin_amdgcn_s_barrier()
#define PG8_SCHED __builtin_amdgcn_sched_barrier(0)
    int sc1 = 0x7f7f7f7f; asm volatile("" : "+v"(sc1));
    Unit cur, nxt; int ui = 0;
    if (!S.next(0, cur)) return;
    f32x4 acc[2][2][4][2];
#pragma unroll
    for (int a = 0; a < 2; ++a)
#pragma unroll
        for (int b = 0; b < 2; ++b)
#pragma unroll
            for (int m = 0; m < 4; ++m)
#pragma unroll
                for (int n = 0; n < 2; ++n) acc[a][b][m][n] = (f32x4){0.f, 0.f, 0.f, 0.f};
    i32x8 At[4], B0[2], B1[2];
    unsigned cA00 = voffA[0], cA01 = voffA[1], cA10 = voffA[0], cA11 = voffA[1], nA00 = voffA[0], nA01 = voffA[1], nA10 = voffA[0], nA11 = voffA[1];
    if (GATHER) { const int* ix = rowidx + cur.row0;
        cA00 = (unsigned)ix[rA[0]] * (unsigned)(K * 2) + voffA[0]; cA01 = (unsigned)ix[rA[1]] * (unsigned)(K * 2) + voffA[1];
        cA10 = (unsigned)ix[128 + rA[0]] * (unsigned)(K * 2) + voffA[0]; cA11 = (unsigned)ix[128 + rA[1]] * (unsigned)(K * 2) + voffA[1]; }
    PG8_STAGE(PG8_SB(0, 0), cur.b0, voffB[0], voffB[1]); PG8_STAGE(PG8_SA(0, 0), cur.a0, cA00, cA01); PG8_STAGE(PG8_SB(0, 1), cur.b1, voffB[0], voffB[1]); PG8_STAGE(PG8_SA(0, 1), cur.a1, cA10, cA11);
    if (wr == 1) PG8_BAR;
    PG8_WAIT_V(4); PG8_BAR;
    PG8_STAGE(PG8_SB(1, 0), cur.b0 + kstep, voffB[0], voffB[1]); PG8_STAGE(PG8_SA(1, 0), cur.a0 + kstep, cA00, cA01); PG8_STAGE(PG8_SB(1, 1), cur.b1 + kstep, voffB[0], voffB[1]);
    PG8_WAIT_V(6); PG8_BAR;
    for (;;) {
        const bool has_next = S.next(ui + 1, nxt);
        if (!has_next) nxt = cur;
        if (GATHER) { const int* ix = rowidx + nxt.row0;
            nA00 = (unsigned)ix[rA[0]] * (unsigned)(K * 2) + voffA[0]; nA01 = (unsigned)ix[rA[1]] * (unsigned)(K * 2) + voffA[1];
            nA10 = (unsigned)ix[128 + rA[0]] * (unsigned)(K * 2) + voffA[0]; nA11 = (unsigned)ix[128 + rA[1]] * (unsigned)(K * 2) + voffA[1]; }
#pragma unroll 1
        for (int t = 0; t < nt; t += 2) {
            const bool last = (t == nt - 2);
            const char* a1h1 = cur.a1 + (size_t)(t + 1) * kstep;
            const char* a2h0 = last ? nxt.a0 : cur.a0 + (size_t)(t + 2) * kstep; const char* a2h1 = last ? nxt.a1 : cur.a1 + (size_t)(t + 2) * kstep;
            const char* b2h0 = last ? nxt.b0 : cur.b0 + (size_t)(t + 2) * kstep; const char* b2h1 = last ? nxt.b1 : cur.b1 + (size_t)(t + 2) * kstep;
            const unsigned x00 = (GATHER && last) ? nA00 : cA00, x01 = (GATHER && last) ? nA01 : cA01, x10 = (GATHER && last) ? nA10 : cA10, x11 = (GATHER && last) ? nA11 : cA11;
            PG8_LDB(B0, 0, 0); PG8_SCHED; PG8_LDA(At, 0, 0); PG8_STAGE(PG8_SA(1, 1), a1h1, cA10, cA11);
            PG8_WAIT_L(8); PG8_BAR; PG8_WAIT_L(0); PG8_MMA(0, 0, At, B0); PG8_BAR; PG8_SCHED;
            PG8_LDB(B1, 0, 1); PG8_STAGE(PG8_SB(0, 0), b2h0, voffB[0], voffB[1]);
            PG8_BAR; PG8_WAIT_L(0); PG8_MMA(0, 1, At, B1); PG8_BAR;
            PG8_LDA(At, 0, 1); PG8_STAGE(PG8_SA(0, 0), a2h0, x00, x01);
            PG8_BAR; PG8_WAIT_L(0); PG8_MMA(1, 0, At, B0); PG8_BAR; PG8_SCHED;
            PG8_STAGE(PG8_SB(0, 1), b2h1, voffB[0], voffB[1]);
            PG8_WAIT_V(6); PG8_BAR; PG8_MMA(1, 1, At, B1); PG8_BAR;
            PG8_LDB(B0, 1, 0); PG8_SCHED; PG8_LDA(At, 1, 0); PG8_STAGE(PG8_SA(0, 1), a2h1, x10, x11);
            PG8_WAIT_L(8); PG8_BAR; PG8_WAIT_L(0); PG8_MMA(0, 0, At, B0); PG8_BAR; PG8_SCHED;
            PG8_LDB(B1, 1, 1); PG8_STAGE(PG8_SB(1, 0), b2h0 + kstep, voffB[0], voffB[1]);
            PG8_BAR; PG8_WAIT_L(0); PG8_MMA(0, 1, At, B1); PG8_BAR;
            PG8_LDA(At, 1, 1); PG8_STAGE(PG8_SA(1, 0), a2h0 + kstep, x00, x01);
            PG8_BAR; PG8_WAIT_L(0); PG8_MMA(1, 0, At, B0); PG8_BAR; PG8_SCHED;
            PG8_STAGE(PG8_SB(1, 1), b2h1 + kstep, voffB[0], voffB[1]);
            PG8_WAIT_V(6); PG8_BAR; PG8_MMA(1, 1, At, B1); PG8_BAR;
        }
        if constexpr (F8) asm volatile("s_nop 15\n\ts_nop 15" ::: "memory");
        E(acc, cur, wr, wc, fr, fq);
        if (!has_next) break;
#pragma unroll
        for (int a = 0; a < 2; ++a)
#pragma unroll
            for (int b = 0; b < 2; ++b)
#pragma unroll
                for (int m = 0; m < 4; ++m)
#pragma unroll
                    for (int n = 0; n < 2; ++n) acc[a][b][m][n] = (f32x4){0.f, 0.f, 0.f, 0.f};
        cur = nxt; cA00 = nA00; cA01 = nA01; cA10 = nA10; cA11 = nA11; ++ui;
    }
    PG8_WAIT_V(0);
    if (wr == 0) PG8_BAR;
    PG8_BAR;
#undef PG8_SA
#undef PG8_SB
#undef PG8_STAGE
#undef PG8_LDA
#undef PG8_LDB
#undef PG8_LO
#undef PG8_HI
#undef PG8_MMA
#undef PG8_WAIT_V
#undef PG8_WAIT_L
#undef PG8_BAR
#undef PG8_SCHED
}
struct GridOrder {
    int nM, nN, nwg, G, c;
    __device__ __forceinline__ bool locate(int i, int& pm, int& pn) const {
        const long L = (long)i * G + c; if (L >= nwg) return false;
        int wgid = (int)L; { const int q = nwg / NXCD, r = nwg % NXCD, xcd = wgid % NXCD, off = wgid / NXCD; wgid = (xcd < r ? xcd * (q + 1) : r * (q + 1) + (xcd - r) * q) + off; }
        const int nig = WGM * nN, gid = wgid / nig, fm = gid * WGM, gsz = (nM - fm) < WGM ? (nM - fm) : WGM;
        pm = fm + ((wgid % nig) % gsz); pn = (wgid % nig) / gsz; return true;
    }
};
}

__device__ __forceinline__ void cvt_load(int q_tid, const float* src, int ldn, float4& va, float4& vb) {
    const int k = q_tid >> 4, n4 = (q_tid & 15) * 4; va = ldnt_f4(src + (size_t)k * ldn + n4); vb = ldnt_f4(src + (size_t)(k + 32) * ldn + n4); }
__device__ __forceinline__ void cvt_tile(int q_tid, LDSP bf16_t* tl, const float4 va, const float4 vb, bf16_t* dst, int K, int k0) {
    __syncthreads();
#pragma unroll
    for (int h = 0; h < 2; ++h) { const int k = (q_tid >> 4) + h * 32, nq = q_tid & 15, n4 = nq * 4; const float4 v = h ? vb : va;
        const int ko = ((((k >> 3) ^ (nq & 7)) << 3) | (k & 7));
        tl[(n4 + 0) * 64 + ko] = f2bf(v.x); tl[(n4 + 1) * 64 + ko] = f2bf(v.y); tl[(n4 + 2) * 64 + ko] = f2bf(v.z); tl[(n4 + 3) * 64 + ko] = f2bf(v.w); }
    __syncthreads();
    { const int n = q_tid >> 3, kc = q_tid & 7; *(u32x4_t*)(dst + (size_t)n * K + k0 + kc * 8) = *(const LDSP u32x4_t*)(tl + n * 64 + ((kc ^ ((n >> 2) & 7)) << 3)); }
}

__device__ __forceinline__ void cvt_tile8(int q_tid, LDSP unsigned char* tl, const float4 va, const float4 vb, unsigned char* dst, int K, int k0, float sc) {
    const int k = q_tid >> 4, nq = q_tid & 15, n4 = nq * 4;
    __syncthreads();
    { const unsigned wa = pk4_fp8(va.x * sc, va.y * sc, va.z * sc, va.w * sc), wb = pk4_fp8(vb.x * sc, vb.y * sc, vb.z * sc, vb.w * sc);
      const int ko = ((((k >> 4) ^ (nq & 3)) << 4) | (k & 15)), ko2 = (((((k + 32) >> 4) ^ (nq & 3)) << 4) | (k & 15));
#pragma unroll
      for (int j = 0; j < 4; ++j) { tl[(n4 + j) * 64 + ko] = (unsigned char)(wa >> (8 * j)); tl[(n4 + j) * 64 + ko2] = (unsigned char)(wb >> (8 * j)); } }
    __syncthreads();
    if (q_tid < 256) { const int n = q_tid >> 2, kc = q_tid & 3; *(u32x4_t*)(dst + (size_t)n * K + k0 + kc * 16) = *(const LDSP u32x4_t*)(tl + n * 64 + ((kc ^ ((n >> 2) & 3)) << 4)); }
}
__device__ __forceinline__ void pre_weights(const Params& p, char* q_ws, int l, float* lds, int q_tid, int q_bid) {
    LDSP bf16_t* tl = (LDSP bf16_t*)lds;
    const float* W = p.in[1] + (size_t)l * D * DIN; const float* WB = p.in[12] + (size_t)l * 3 * MIXW * D; const float* WO = p.in[13] + (size_t)l * D * D;
    bf16_t* WBT = (bf16_t*)(q_ws + WS_WBT); bf16_t* WOT = (bf16_t*)(q_ws + WS_WOT);
    for (int ub = q_bid; ub < 2816; ub += 4 * gridDim.x) {
        float4 va[4], vb[4];
#pragma unroll
        for (int j = 0; j < 4; ++j) { const int u = ub + j * gridDim.x;
            if (u < 2176) { const int n0 = (u >> 4) * 64, kt = u & 15; cvt_load(q_tid, W + n0 + (n0 >= 2048 ? 8 : 0) + (size_t)(kt * 64) * DIN, DIN, va[j], vb[j]); }
            else if (u < 2560) { const int v = u - 2176, br = v >> 7, r = v & 127, n0 = (r >> 3) * 64, kt = r & 7; cvt_load(q_tid, WB + (size_t)br * MIXW * D + n0 + (size_t)(kt * 64) * D, D, va[j], vb[j]); }
            else if (u < 2816) { const int v = u - 2560, n0 = (v >> 4) * 64, kt = v & 15; cvt_load(q_tid, WO + n0 + (size_t)(kt * 64) * D, D, va[j], vb[j]); } }
#pragma unroll
        for (int j = 0; j < 4; ++j) { const int u = ub + j * gridDim.x;
            if (u < 2176) { const int n0 = (u >> 4) * 64, kt = u & 15; cvt_tile8(q_tid, (LDSP unsigned char*)lds, va[j], vb[j], (unsigned char*)(q_ws + WS_WIN) + (size_t)n0 * D, D, kt * 64, WSC_IN); }
            else if (u < 2560) { const int v = u - 2176, br = v >> 7, r = v & 127, n0 = (r >> 3) * 64, kt = r & 7; cvt_tile8(q_tid, (LDSP unsigned char*)lds, va[j], vb[j], (unsigned char*)WBT + ((size_t)br * D + n0) * MIXW, MIXW, kt * 64, WSC_BR); }
            else if (u < 2816) { const int v = u - 2560, n0 = (v >> 4) * 64, kt = v & 15; cvt_tile8(q_tid, (LDSP unsigned char*)lds, va[j], vb[j], (unsigned char*)WOT + (size_t)n0 * D, D, kt * 64, WSC_OUT); } }
    }
    __syncthreads();
}
__device__ __forceinline__ void ph_prew(const Params& p, int q_wave, int l, float* lds) { PH_PROLOGUE pre_weights(p, q_ws, l, lds, q_tid, q_bid); }
__device__ __forceinline__ void stage_wig(const float* W, LDSP float* wig, int q_tid) {
    float4 t[2][2];
#pragma unroll
    for (int j = 0; j < 2; ++j) { const float* src = W + (size_t)(q_tid + j * NTHR) * DIN + 2048; t[j][0] = *(const float4*)src; t[j][1] = *(const float4*)(src + 4); }
#pragma unroll
    for (int j = 0; j < 2; ++j) { const int c = q_tid + j * NTHR; wig[c] = t[j][0].x; wig[1024 + c] = t[j][0].y; wig[2048 + c] = t[j][0].z; wig[3072 + c] = t[j][0].w; wig[4096 + c] = t[j][1].x; wig[5120 + c] = t[j][1].y; wig[6144 + c] = t[j][1].z; wig[7168 + c] = t[j][1].w; }
}
__device__ __forceinline__ void igf_calc(const float4 (&v)[4], const LDSP float* wig, int lane, float (&a8)[8]) {
#pragma unroll
    for (int k = 0; k < 8; ++k) a8[k] = 0.f;
#pragma unroll
    for (int i = 0; i < 4; ++i)
#pragma unroll
        for (int k = 0; k < 8; ++k) { const f32x4_t w = *(const LDSP f32x4_t*)(wig + k * 1024 + RC(i)); a8[k] += v[i].x * w[0] + v[i].y * w[1] + v[i].z * w[2] + v[i].w * w[3]; }
#pragma unroll
    for (int k = 0; k < 8; ++k) a8[k] = wsum(a8[k]);
}
__device__ __forceinline__ void igf_store(const float (&a8)[8], float* IGF, int tok, int lane) {
    if (lane == 0) { *(float4*)(IGF + (size_t)tok * 8) = make_float4(a8[0], a8[1], a8[2], a8[3]); *(float4*)(IGF + (size_t)tok * 8 + 4) = make_float4(a8[4], a8[5], a8[6], a8[7]); }
}
__device__ __forceinline__ void igf_row(const float4 (&v)[4], const LDSP float* wig, float* IGF, int tok, int lane) {
    float a8[8];
#pragma unroll
    for (int k = 0; k < 8; ++k) a8[k] = 0.f;
#pragma unroll
    for (int i = 0; i < 4; ++i)
#pragma unroll
        for (int k = 0; k < 8; ++k) { const f32x4_t w = *(const LDSP f32x4_t*)(wig + k * 1024 + RC(i)); a8[k] += v[i].x * w[0] + v[i].y * w[1] + v[i].z * w[2] + v[i].w * w[3]; }
#pragma unroll
    for (int k = 0; k < 8; ++k) a8[k] = wsum(a8[k]);
    if (lane == 0) { *(float4*)(IGF + (size_t)tok * 8) = make_float4(a8[0], a8[1], a8[2], a8[3]); *(float4*)(IGF + (size_t)tok * 8 + 4) = make_float4(a8[4], a8[5], a8[6], a8[7]); }
}
__device__ __forceinline__ void ph_pre(const Params& p, int q_wave, int l, float* lds) {
    PH_PROLOGUE
    LDSP float* wig = (LDSP float*)lds + 4096;
    stage_wig(p.in[1] + (size_t)l * D * DIN, wig, q_tid);
    pre_weights(p, q_ws, l, lds, q_tid, q_bid);
    __syncthreads();
    const float* X = p.in[0]; unsigned char* XB8 = (unsigned char*)(q_ws + WS_XB8); float* IGF = (float*)(q_ws + WS_IGF);
    const int lane = q_tid & 63, wv = q_tid >> 6;
    float4 v[4], vn[4];
    { const int tok0 = q_bid * 8 + wv;
#pragma unroll
      for (int i = 0; i < 4; ++i) v[i] = ldnt_f4(X + (size_t)tok0 * D + RC(i)); }
    for (int tok = q_bid * 8 + wv; tok < T; tok += gridDim.x * 8) {
        const int tn = tok + gridDim.x * 8 < T ? tok + gridDim.x * 8 : tok;
#pragma unroll
        for (int i = 0; i < 4; ++i) vn[i] = ldnt_f4(X + (size_t)tn * D + RC(i));
#pragma unroll
        for (int i = 0; i < 4; ++i) *(unsigned*)(XB8 + (size_t)tok * D + RC(i)) = pk4_fp8(v[i].x, v[i].y, v[i].z, v[i].w);
        igf_row(v, wig, IGF, tok, lane);
#pragma unroll
        for (int i = 0; i < 4; ++i) v[i] = vn[i];
    }
}

struct EpiStoreBf16 {
    static constexpr bool PERM = true;
    bf16_t* O; bf16_t* G; int ldc; float sc;
    __device__ __forceinline__ void operator()(const pg8::f32x4 (&acc)[2][2][4][2], const pg8::Unit& u, int wr, int wc, int fr, int fq) const {
        const bool gate = u.col0 >= C_GT; const int j = (u.col0 - C_GT) >> 8;
        unsigned char* gt = (unsigned char*)G + ((size_t)((u.row0 >> 8) * 12 + j) << 16) + (size_t)(wr * 4 + wc) * 8192 + (fq * 16 + fr) * 16;
        const int lane = fq * 16 + fr, pr = lane >> 2, pq = lane & 3, srcl = (pq * 16 + pr) * 4;
        bf16_t* prow = O + (size_t)(u.row0 + wr * 64 + pr) * ldc + u.col0 + wc * 32 + 8 * pq;
        if (gate) {
#pragma unroll
            for (int ai = 0; ai < 2; ++ai)
#pragma unroll
                for (int m = 0; m < 4; ++m) { pg8::u32x4 w;
                    { const pg8::f32x4 v0 = acc[ai][0][m][0] * sc, v1 = acc[ai][0][m][1] * sc; w.x = pk4_fp8(v0[0], v0[1], v0[2], v0[3]); w.y = pk4_fp8(v1[0], v1[1], v1[2], v1[3]); }
                    { const pg8::f32x4 v0 = acc[ai][1][m][0] * sc, v1 = acc[ai][1][m][1] * sc; w.z = pk4_fp8(v0[0], v0[1], v0[2], v0[3]); w.w = pk4_fp8(v1[0], v1[1], v1[2], v1[3]); }
                    __builtin_nontemporal_store(w, (pg8::u32x4*)(gt + (ai * 4 + m) * 1024)); }
            return; }
#pragma unroll
        for (int ai = 0; ai < 2; ++ai)
#pragma unroll
            for (int m = 0; m < 4; ++m) {
#pragma unroll
                for (int bj = 0; bj < 2; ++bj) { const pg8::f32x4 v0 = acc[ai][bj][m][0] * sc, v1 = acc[ai][bj][m][1] * sc;
                    pg8::u32x4 w; w.x = pg8::cvt_pk_bf16(v0[0], v0[1]); w.y = pg8::cvt_pk_bf16(v0[2], v0[3]); w.z = pg8::cvt_pk_bf16(v1[0], v1[1]); w.w = pg8::cvt_pk_bf16(v1[2], v1[3]);
                    pg8::u32x4 x; x.x = (unsigned)__builtin_amdgcn_ds_bpermute(srcl, (int)w.x); x.y = (unsigned)__builtin_amdgcn_ds_bpermute(srcl, (int)w.y); x.z = (unsigned)__builtin_amdgcn_ds_bpermute(srcl, (int)w.z); x.w = (unsigned)__builtin_amdgcn_ds_bpermute(srcl, (int)w.w);
                    *(pg8::u32x4*)(prow + (size_t)(ai * 128 + m * 16) * ldc + bj * 128) = x; } }
    }
};
struct SchedGrid {
    pg8::GridOrder g; const char* A; const char* B; int K;
    __device__ __forceinline__ bool next(int i, pg8::Unit& u) const { int pm, pn; if (!g.locate(i, pm, pn)) return false;
        u.a0 = A + (size_t)pm * 256 * K * 2; u.a1 = u.a0 + (size_t)128 * K * 2; u.b0 = B + (size_t)pn * 256 * K * 2; u.b1 = u.b0 + (size_t)128 * K * 2; u.row0 = pm * 256; u.col0 = pn * 256; u.aux = 0; return true; }
};
__device__ __forceinline__ void ph_inproj_mfma(const Params& p, int q_wave, int l, float* lds) {
    PH_PROLOGUE
    SchedGrid S; S.g.nM = T / 256; S.g.nN = NP / 256; S.g.nwg = S.g.nM * S.g.nN; S.g.G = gridDim.x; S.g.c = q_bid; S.A = q_ws + WS_XB8; S.B = q_ws + WS_WIN; S.K = D / 2;
    EpiStoreBf16 E; E.O = (bf16_t*)(q_ws + WS_P); E.ldc = NPP; E.G = (bf16_t*)(q_ws + WS_G); E.sc = 1.0f / WSC_IN;
    pg8::gemm_phase<false, true>(q_tid, (PG8_LAS unsigned char*)lds, D / 2, nullptr, S, E);
}

struct SchedMerge {
    pg8::GridOrder g; const char* Y0; const char* Y1; const char* Y2; const char* B;
    __device__ __forceinline__ bool next(int i, pg8::Unit& u) const { const int j = i / 3, br = i - 3 * j; int pm, pn; if (!g.locate(j, pm, pn)) return false;
        const char* Y = Y0 + (size_t)br * ((size_t)T * MIXW); if (br == 2) Y = Y2;
        u.a0 = Y + (size_t)pm * 256 * MIXW; u.a1 = u.a0 + (size_t)128 * MIXW; u.b0 = B + ((size_t)br * D + (size_t)pn * 256) * MIXW; u.b1 = u.b0 + (size_t)128 * MIXW;
        u.row0 = pm * 256; u.col0 = pn * 256; u.aux = br; return true; }
};
__device__ __forceinline__ void unpack8(const pg8::u32x4 w, float (&f)[8]) {
    f[0] = __uint_as_float(w.x << 16); f[1] = __uint_as_float(w.x & 0xffff0000u); f[2] = __uint_as_float(w.y << 16); f[3] = __uint_as_float(w.y & 0xffff0000u);
    f[4] = __uint_as_float(w.z << 16); f[5] = __uint_as_float(w.z & 0xffff0000u); f[6] = __uint_as_float(w.w << 16); f[7] = __uint_as_float(w.w & 0xffff0000u); }
struct EpiMerge {
    static constexpr bool PERM = true;
    const bf16_t* G; bf16_t* S; bf16_t* MG;
    __device__ __forceinline__ void operator()(const pg8::f32x4 (&acc)[2][2][4][2], const pg8::Unit& u, int wr, int wc, int fr, int fq) const {
        const int row0 = u.row0 + wr * 64 + fr, col0 = u.col0 + wc * 32 + 8 * fq, br = u.aux, pm = u.row0 >> 8, pn = u.col0 >> 8;
        const size_t lo = (size_t)(wr * 4 + wc) * 8192 + (fq * 16 + fr) * 8;
        const unsigned char* gp = (const unsigned char*)G + ((size_t)(pm * 12 + br * 4 + pn) << 16) + (size_t)(wr * 4 + wc) * 8192 + (fq * 16 + fr) * 16; bf16_t* sp = S + ((size_t)(pm * 4 + pn) << 16) + lo; bf16_t* mp = MG + (size_t)row0 * D + col0;
        pg8::u32x4 gq[3], mq[3][2];
#define MERGE_LOAD(k, s) do { gq[s] = __builtin_nontemporal_load((const pg8::u32x4*)(gp + (k) * 1024)); \
            if (br > 0) { mq[s][0] = __builtin_nontemporal_load((const pg8::u32x4*)(sp + (k) * 1024)); mq[s][1] = __builtin_nontemporal_load((const pg8::u32x4*)(sp + (k) * 1024 + 512)); } } while (0)
        MERGE_LOAD(0, 0); MERGE_LOAD(1, 1);
#pragma unroll
        for (int k = 0; k < 8; ++k) { const int ai = k >> 2, m = k & 3, sl = k % 3;
            if (k < 6) { if ((k + 2) % 3 == 0) MERGE_LOAD(k + 2, 0); else if ((k + 2) % 3 == 1) MERGE_LOAD(k + 2, 1); else MERGE_LOAD(k + 2, 2); }
            asm volatile("" ::: "memory");
#pragma unroll
            for (int bj = 0; bj < 2; ++bj) { float g[8], o[8]; { const unsigned w0 = bj ? gq[sl].z : gq[sl].x, w1 = bj ? gq[sl].w : gq[sl].y;
                    const f32x2_t a0 = __builtin_amdgcn_cvt_pk_f32_fp8((int)w0, false), a1 = __builtin_amdgcn_cvt_pk_f32_fp8((int)w0, true), a2 = __builtin_amdgcn_cvt_pk_f32_fp8((int)w1, false), a3 = __builtin_amdgcn_cvt_pk_f32_fp8((int)w1, true);
                    g[0] = a0[0]; g[1] = a0[1]; g[2] = a1[0]; g[3] = a1[1]; g[4] = a2[0]; g[5] = a2[1]; g[6] = a3[0]; g[7] = a3[1]; }
                if (br > 0) unpack8(mq[sl][bj], o); else {
#pragma unroll
                    for (int j = 0; j < 8; ++j) o[j] = 0.f; }
                const pg8::f32x4 v0 = acc[ai][bj][m][0] * (1.0f / WSC_BR), v1 = acc[ai][bj][m][1] * (1.0f / WSC_BR);
#pragma unroll
                for (int j = 0; j < 4; ++j) { o[j] += sigmoidf_(g[j]) * v0[j]; o[4 + j] += sigmoidf_(g[4 + j]) * v1[j]; }
                pg8::u32x4 w; w.x = pg8::cvt_pk_bf16(o[0], o[1]); w.y = pg8::cvt_pk_bf16(o[2], o[3]); w.z = pg8::cvt_pk_bf16(o[4], o[5]); w.w = pg8::cvt_pk_bf16(o[6], o[7]);
                if (br < 2) *(pg8::u32x4*)(sp + k * 1024 + bj * 512) = w; else *(u32x2_t*)((unsigned char*)MG + (size_t)(row0 + ai * 128 + m * 16) * D + col0 + bj * 128) = (u32x2_t){pk4_fp8(o[0], o[1], o[2], o[3]), pk4_fp8(o[4], o[5], o[6], o[7])}; }
            asm volatile("" ::: "memory"); }
#undef MERGE_LOAD
    }
};
__device__ __forceinline__ void ph_merge_mfma(const Params& p, int q_wave, int l, float* lds) {
    PH_PROLOGUE
    SchedMerge S; S.g.nM = T / 256; S.g.nN = D / 256; S.g.nwg = S.g.nM * S.g.nN; S.g.G = gridDim.x; S.g.c = q_bid;
    S.Y0 = q_ws + WS_YR; S.Y1 = q_ws + WS_YM; S.Y2 = (const char*)q_out + DO_YA; S.B = q_ws + WS_WBT;
    EpiMerge E; E.G = (const bf16_t*)(q_ws + WS_G); E.S = (bf16_t*)(q_ws + WS_S); E.MG = (bf16_t*)((char*)q_out + DO_MG);
    pg8::gemm_phase<false, true>(q_tid, (PG8_LAS unsigned char*)lds, MIXW / 2, nullptr, S, E);
}
template <bool RESBF> struct EpiOut {
    static constexpr bool PERM = false;
    const float* XR; const bf16_t* XRB; float* X;
    typedef typename std::conditional<RESBF, u32x2_t, pg8::f32x4>::type raw_t;
    static constexpr int NST = RESBF ? 8 : 4;
    __device__ __forceinline__ raw_t ldraw(size_t o) const { if constexpr (RESBF) return *(const u32x2_t*)(XRB + o); else return __builtin_nontemporal_load((const pg8::f32x4*)(XR + o)); }
    static __device__ __forceinline__ pg8::f32x4 cvres(const raw_t w) { if constexpr (RESBF) return (pg8::f32x4){__uint_as_float(w.x << 16), __uint_as_float(w.x & 0xffff0000u), __uint_as_float(w.y << 16), __uint_as_float(w.y & 0xffff0000u)}; else return w; }
    __device__ __forceinline__ void operator()(const pg8::f32x4 (&acc)[2][2][4][2], const pg8::Unit& u, int wr, int wc, int fr, int fq) const {
        const int row0 = u.row0 + wr * 64 + fr, col0 = u.col0 + wc * 32 + 4 * fq;
        const size_t base = (size_t)row0 * D + col0; float* op = X + base;
        raw_t xq[NST][4];
#define OUT_LOAD(k, s) do { const size_t ro = base + (size_t)(((k) >> 2) * 128 + ((k) & 3) * 16) * D; \
            xq[s][0] = ldraw(ro); xq[s][1] = ldraw(ro + 16); xq[s][2] = ldraw(ro + 128); xq[s][3] = ldraw(ro + 144); } while (0)
#pragma unroll
        for (int k = 0; k < NST - 1; ++k) OUT_LOAD(k, k);
#pragma unroll
        for (int k = 0; k < 8; ++k) { const int ai = k >> 2, m = k & 3, sl = k % NST; const size_t ro = (size_t)(ai * 128 + m * 16) * D;
            if (k + NST - 1 < 8) OUT_LOAD(k + NST - 1, (k + NST - 1) % NST);
            asm volatile("" ::: "memory");
#pragma unroll
            for (int bj = 0; bj < 2; ++bj)
#pragma unroll
                for (int n = 0; n < 2; ++n) *(pg8::f32x4*)(op + ro + bj * 128 + n * 16) = cvres(xq[sl][bj * 2 + n]) * DN_ALPHA + acc[ai][bj][m][n] * (1.0f / WSC_OUT);
            asm volatile("" ::: "memory"); }
#undef OUT_LOAD
    }
};
constexpr float WSC_GU = 32.0f, WSC_DN = 64.0f;
__device__ __forceinline__ void moe_weight_convert(const Params& p, char* q_ws, int l, float* lds, int q_tid, int q_bid, int u_lo, int u_hi) {
    LDSP unsigned char* tl = (LDSP unsigned char*)lds; unsigned char* WM = (unsigned char*)(q_ws + WS_B);
    const int k = q_tid >> 4, nq = q_tid & 15, n4 = nq * 4;
    float4 v[8];
#define MWC_SRC(u_) (p.in[((u_) >> 6) % 3 == 0 ? 18 : (((u_) >> 6) % 3 == 1 ? 20 : 22)] + ((size_t)l * NE + ((u_) >> 6) / 3) * D * D + (size_t)(((u_) & 3) * 256) * D + (((u_) >> 2) & 15) * 64)
#define MWC_LOAD(u_) do { const float* src_ = MWC_SRC(u_) + (size_t)k * D + n4; _Pragma("unroll") for (int i = 0; i < 8; ++i) v[i] = ldnt_f4(src_ + (size_t)(32 * i) * D); } while (0)
    if (u_lo + q_bid < u_hi) MWC_LOAD(u_lo + q_bid);
    for (int u = u_lo + q_bid; u < u_hi; u += gridDim.x) {
        const float sc = ((u >> 6) % 3 == 2) ? WSC_DN : WSC_GU;
        __syncthreads();
#pragma unroll
        for (int i = 0; i < 8; ++i) { const unsigned w = pk4_fp8(v[i].x * sc, v[i].y * sc, v[i].z * sc, v[i].w * sc); const int kk = k + 32 * (i & 1), ko = ((((kk >> 4) ^ (nq & 3)) << 4) | (kk & 15));
#pragma unroll
            for (int j = 0; j < 4; ++j) tl[(i >> 1) * 4096 + (n4 + j) * 64 + ko] = (unsigned char)(w >> (8 * j)); }
        const int un = u + gridDim.x;
        if (un < u_hi) MWC_LOAD(un);
        __syncthreads();
#pragma unroll
        for (int s2 = 0; s2 < 2; ++s2) { const int idx = q_tid + s2 * NTHR, n = idx >> 4, c16 = idx & 15, blk = c16 >> 2, kc = c16 & 3;
            unsigned char* dst = WM + (size_t)(u >> 6) * D * D + (size_t)(((u >> 2) & 15) * 64 + n) * D + (u & 3) * 256 + c16 * 16;
            *(u32x4_t*)dst = *(const LDSP u32x4_t*)(tl + blk * 4096 + n * 64 + ((kc ^ ((n >> 2) & 3)) << 4)); }
    }
#undef MWC_LOAD
#undef MWC_SRC
    __syncthreads();
}
constexpr int MWC_NU = NE * 3 * 64, MWC_SPLIT = MWC_NU * 2 / 3;
__device__ __forceinline__ void ph_outproj_mfma(const Params& p, int q_wave, int l, float* lds) {
    PH_PROLOGUE
    SchedGrid S; S.g.nM = T / 256; S.g.nN = D / 256; S.g.nwg = S.g.nM * S.g.nN; S.g.G = gridDim.x; S.g.c = q_bid; S.A = (const char*)q_out + DO_MG; S.B = q_ws + WS_WOT; S.K = D / 2;
    const bool conv_first = (q_bid >> 3) & 1;
    if (conv_first) moe_weight_convert(p, q_ws, l, lds, q_tid, q_bid, 0, MWC_SPLIT);
    if (l == 0) { EpiOut<false> E; E.XR = p.in[0]; E.XRB = nullptr; E.X = (float*)(q_ws + WS_X); pg8::gemm_phase<false, true>(q_tid, (PG8_LAS unsigned char*)lds, D / 2, nullptr, S, E); }
    else { EpiOut<true> E; E.XR = nullptr; E.XRB = (const bf16_t*)(q_ws + WS_XB); E.X = (float*)(q_ws + WS_X); pg8::gemm_phase<false, true>(q_tid, (PG8_LAS unsigned char*)lds, D / 2, nullptr, S, E); }
    __syncthreads();
    if (!conv_first) moe_weight_convert(p, q_ws, l, lds, q_tid, q_bid, 0, MWC_SPLIT);
}
__device__ __forceinline__ void ph_mwc_tail(const Params& p, int q_wave, int l, float* lds) {
    PH_PROLOGUE
    __syncthreads();
    moe_weight_convert(p, q_ws, l, lds, q_tid, q_bid, MWC_SPLIT, MWC_NU);
}
struct SchedMoe1 {
    const unsigned* ctl; const char* XB8; const char* WM; int nun, G, c;
    __device__ __forceinline__ bool next(int i, pg8::Unit& u) const {
        const int li = i * (G >> 3) + (c >> 3), tile = (li >> 3) * 8 + (c & 7), pn = li & 7; if (tile * 8 >= nun) return false;
        const int e = __builtin_amdgcn_readfirstlane((int)ctl[CW_TILEE + tile]);
        u.a0 = XB8; u.a1 = XB8; u.b0 = WM + ((size_t)(e * 3 + 0) * D + (size_t)pn * 128) * D; u.b1 = WM + ((size_t)(e * 3 + 1) * D + (size_t)pn * 128) * D;
        u.row0 = tile * 256; u.col0 = pn * 128; u.aux = e; return true; }
};
struct EpiMoe1 {
    static constexpr bool PERM = true;
    const float* bg; const float* bu; unsigned char* H;
    __device__ __forceinline__ void operator()(const pg8::f32x4 (&acc)[2][2][4][2], const pg8::Unit& u, int wr, int wc, int fr, int fq) const {
        const int row0 = u.row0 + wr * 64 + fr, col0 = u.col0 + wc * 32 + 8 * fq;
        const pg8::f32x4 g0 = *(const pg8::f32x4*)(bg + u.aux * D + col0), g1 = *(const pg8::f32x4*)(bg + u.aux * D + col0 + 4), u0 = *(const pg8::f32x4*)(bu + u.aux * D + col0), u1 = *(const pg8::f32x4*)(bu + u.aux * D + col0 + 4);
#pragma unroll
        for (int ai = 0; ai < 2; ++ai)
#pragma unroll
            for (int m = 0; m < 4; ++m) { float hh[8];
#pragma unroll
                for (int n = 0; n < 2; ++n) { const pg8::f32x4 gv = acc[ai][0][m][n] * (1.0f / WSC_GU) + (n ? g1 : g0), uv = acc[ai][1][m][n] * (1.0f / WSC_GU) + (n ? u1 : u0);
#pragma unroll
                    for (int j = 0; j < 4; ++j) { const float g = fminf(gv[j], SWI_LIMIT), uu = fminf(fmaxf(uv[j], -SWI_LIMIT), SWI_LIMIT); hh[n * 4 + j] = (uu + 1.0f) * g * sigmoidf_(SWI_ALPHA * g); } }
                *(u32x2_t*)(H + (size_t)(row0 + ai * 128 + m * 16) * D + col0) = (u32x2_t){pk4_fp8(hh[0], hh[1], hh[2], hh[3]), pk4_fp8(hh[4], hh[5], hh[6], hh[7])}; }
    }
};
__device__ __forceinline__ void ph_moe1_mfma(const Params& p, int q_wave, int l, float* lds) {
    PH_PROLOGUE
    const unsigned* ctl = (const unsigned*)(q_ws + WS_CTL);
    SchedMoe1 S; S.ctl = ctl; S.XB8 = q_ws + WS_XB8; S.WM = q_ws + WS_B; S.nun = __builtin_amdgcn_readfirstlane((int)ctl[CW_NTILES]) * 8; S.G = gridDim.x; S.c = q_bid;
    EpiMoe1 E; E.bg = p.in[19] + (size_t)l * NE * D; E.bu = p.in[21] + (size_t)l * NE * D; E.H = (unsigned char*)(q_ws + WS_H);
    pg8::gemm_phase<true, true>(q_tid, (PG8_LAS unsigned char*)lds, D / 2, (const int*)(q_ws + WS_ROWTOK), S, E);
}
struct SchedMoe2 {
    const unsigned* ctl; const char* H; const char* WM; int nun, G, c;
    __device__ __forceinline__ bool next(int i, pg8::Unit& u) const {
        const int li = i * (G >> 3) + (c >> 3), tile = (li >> 2) * 8 + (c & 7), pn = li & 3; if (tile * 4 >= nun) return false;
        const int e = __builtin_amdgcn_readfirstlane((int)ctl[CW_TILEE + tile]);
        u.a0 = H + (size_t)tile * 256 * D; u.a1 = u.a0 + (size_t)128 * D; u.b0 = WM + ((size_t)(e * 3 + 2) * D + (size_t)pn * 256) * D; u.b1 = u.b0 + (size_t)128 * D;
        u.row0 = tile * 256; u.col0 = pn * 256; u.aux = e; return true; }
};
constexpr float YSC = 16.0f;
template <bool Y8> struct EpiMoe2 {
    static constexpr bool PERM = true;
    const float* bd; const float* rowp; bf16_t* Y;
    __device__ __forceinline__ void operator()(const pg8::f32x4 (&acc)[2][2][4][2], const pg8::Unit& u, int wr, int wc, int fr, int fq) const {
        const int row0 = u.row0 + wr * 64 + fr, col0 = u.col0 + wc * 32 + 8 * fq;
        float pr[8]; pg8::f32x4 bb[2][2];
#pragma unroll
        for (int k = 0; k < 8; ++k) pr[k] = rowp[row0 + (k >> 2) * 128 + (k & 3) * 16] * (Y8 ? YSC : 1.0f);
#pragma unroll
        for (int bj = 0; bj < 2; ++bj) { bb[bj][0] = *(const pg8::f32x4*)(bd + u.aux * D + col0 + bj * 128); bb[bj][1] = *(const pg8::f32x4*)(bd + u.aux * D + col0 + bj * 128 + 4); }
#pragma unroll
        for (int ai = 0; ai < 2; ++ai)
#pragma unroll
            for (int m = 0; m < 4; ++m) { const int row = row0 + ai * 128 + m * 16; const float p1 = pr[ai * 4 + m];
#pragma unroll
                for (int bj = 0; bj < 2; ++bj) { const pg8::f32x4 v0 = (acc[ai][bj][m][0] * (1.0f / WSC_DN) + bb[bj][0]) * p1, v1 = (acc[ai][bj][m][1] * (1.0f / WSC_DN) + bb[bj][1]) * p1;
                    if (Y8) *(u32x2_t*)((unsigned char*)Y + (size_t)row * D + col0 + bj * 128) = (u32x2_t){pk4_fp8(v0[0], v0[1], v0[2], v0[3]), pk4_fp8(v1[0], v1[1], v1[2], v1[3])};
                    else { pg8::u32x4 w; w.x = pg8::cvt_pk_bf16(v0[0], v0[1]); w.y = pg8::cvt_pk_bf16(v0[2], v0[3]); w.z = pg8::cvt_pk_bf16(v1[0], v1[1]); w.w = pg8::cvt_pk_bf16(v1[2], v1[3]);
                        *(pg8::u32x4*)(Y + (size_t)row * D + col0 + bj * 128) = w; } } }
    }
};
__device__ __forceinline__ void ph_moe2_mfma(const Params& p, int q_wave, int l, float* lds) {
    PH_PROLOGUE
    const unsigned* ctl = (const unsigned*)(q_ws + WS_CTL);
    SchedMoe2 S; S.ctl = ctl; S.H = q_ws + WS_H; S.WM = q_ws + WS_B; S.nun = __builtin_amdgcn_readfirstlane((int)ctl[CW_NTILES]) * 4; S.G = gridDim.x; S.c = q_bid;
    if (l == DEPTH - 1) { EpiMoe2<true> E; E.bd = p.in[23] + (size_t)l * NE * D; E.rowp = (const float*)(q_ws + WS_ROWP); E.Y = (bf16_t*)(q_ws + WS_Y); pg8::gemm_phase<false, true>(q_tid, (PG8_LAS unsigned char*)lds, D / 2, nullptr, S, E); }
    else { EpiMoe2<false> E; E.bd = p.in[23] + (size_t)l * NE * D; E.rowp = (const float*)(q_ws + WS_ROWP); E.Y = (bf16_t*)(q_ws + WS_Y); pg8::gemm_phase<false, true>(q_tid, (PG8_LAS unsigned char*)lds, D / 2, nullptr, S, E); }
}

__device__ __forceinline__ bf16x8_t frag_row(const LDSP bf16_t* M, int ld, int row0, int k0, int r, int g) { return *(const LDSP bf16x8_t*)(M + (row0 + r) * ld + k0 + 8 * g); }
__device__ __forceinline__ bf16x8_t frag_tr(const LDSP bf16_t* M, int ld, int k0, int n0, int r, int g) {
    const LDSP bf16_t* a = M + (k0 + 8 * g + (r >> 2)) * ld + n0 + 4 * (r & 3);
    const s16x4_t lo = __builtin_amdgcn_ds_read_tr16_b64_v4i16((LDSP s16x4_t*)a), hi = __builtin_amdgcn_ds_read_tr16_b64_v4i16((LDSP s16x4_t*)(a + 4 * ld));
    return (bf16x8_t){lo[0], lo[1], lo[2], lo[3], hi[0], hi[1], hi[2], hi[3]};
}
__device__ __forceinline__ f32x4_t mma(f32x4_t acc, bf16x8_t X, bf16x8_t Y) { return __builtin_amdgcn_mfma_f32_16x16x32_bf16(X, Y, acc, 0, 0, 0); }
__device__ __forceinline__ unsigned pk2(float lo, float hi) { return cvtpk_bf16(lo, hi); }
__device__ __forceinline__ void unpack8u(const u32x4_t w, float (&f)[8]) {
    f[0] = __uint_as_float(w.x << 16); f[1] = __uint_as_float(w.x & 0xffff0000u); f[2] = __uint_as_float(w.y << 16); f[3] = __uint_as_float(w.y & 0xffff0000u);
    f[4] = __uint_as_float(w.z << 16); f[5] = __uint_as_float(w.z & 0xffff0000u); f[6] = __uint_as_float(w.w << 16); f[7] = __uint_as_float(w.w & 0xffff0000u); }
__device__ __forceinline__ u32x4_t pack8u(const float (&f)[8]) { return (u32x4_t){pk2(f[0], f[1]), pk2(f[2], f[3]), pk2(f[4], f[5]), pk2(f[6], f[7])}; }
__device__ __forceinline__ bf16x8_t scale_frag(bf16x8_t q, float s) { const u32x4_t w = __builtin_bit_cast(u32x4_t, q); float f[8]; unpack8u(w, f);
#pragma unroll
    for (int j = 0; j < 8; ++j) f[j] *= s;
    return __builtin_bit_cast(bf16x8_t, pack8u(f)); }

constexpr size_t WS_RKV = WS_B;
__device__ __forceinline__ float ret_lg(int h) { return log1pf(-exp2f(-5.0f - (float)h)); }
__device__ __forceinline__ void ret1_load(const bf16_t* P, int u, int q_tid, u32x4_t (&kr)[2], u32x4_t (&vr)[4]) {
    const int ch = u >> 2, h = u & 3, tok0 = ch * 128;
#pragma unroll
    for (int i = 0; i < 2; ++i) { const int c = q_tid + i * NTHR; kr[i] = *(const u32x4_t*)(P + (size_t)(tok0 + (c >> 3)) * NPP + C_RK + h * 64 + (c & 7) * 8); }
#pragma unroll
    for (int i = 0; i < 4; ++i) { const int c = q_tid + i * NTHR; vr[i] = *(const u32x4_t*)(P + (size_t)(tok0 + (c >> 4)) * NPP + C_RV + h * 128 + (c & 15) * 8); }
}
__device__ __forceinline__ void ph_ret1(const Params& p, int q_wave, int l, float* lds) {
    PH_PROLOGUE
    LDSP bf16_t* Ks = (LDSP bf16_t*)lds; LDSP bf16_t* Vs = Ks + 128 * 72;
    const bf16_t* P = (const bf16_t*)(q_ws + WS_P); bf16_t* RKV = (bf16_t*)(q_ws + WS_RKV);
    const int lane = q_tid & 63, r = lane & 15, g = lane >> 4;
    for (int ub = q_bid; ub < (T / 128) * 4; ub += 4 * gridDim.x) {
    u32x4_t kr4[4][2], vr4[4][4];
#pragma unroll
    for (int s = 0; s < 4; ++s) if (ub + s * (int)gridDim.x < (T / 128) * 4) ret1_load(P, ub + s * gridDim.x, q_tid, kr4[s], vr4[s]);
#pragma unroll
    for (int s = 0; s < 4; ++s) { const int u = ub + s * gridDim.x; if (u >= (T / 128) * 4) break;
        const u32x4_t (&kr)[2] = kr4[s]; const u32x4_t (&vr)[4] = vr4[s];
        const int ch = u >> 2, h = u & 3, b = ch >> 7, n = ch & 127; const float lg = ret_lg(h);
        __syncthreads();
#pragma unroll
        for (int i = 0; i < 2; ++i) { const int c = q_tid + i * NTHR, j = c >> 3; float f[8]; unpack8u(kr[i], f);
            const float sc = __expf(lg * (float)(127 - j)) * 0.125f;
#pragma unroll
            for (int q = 0; q < 8; ++q) f[q] *= sc;
            *(LDSP u32x4_t*)(Ks + j * 72 + (c & 7) * 8) = pack8u(f); }
#pragma unroll
        for (int i = 0; i < 4; ++i) { const int c = q_tid + i * NTHR; *(LDSP u32x4_t*)(Vs + (c >> 4) * 136 + (c & 15) * 8) = vr[i]; }
        __syncthreads();
        f32x4_t acc[4];
#pragma unroll
        for (int dt = 0; dt < 4; ++dt) acc[dt] = (f32x4_t){0.f, 0.f, 0.f, 0.f};
#pragma unroll
        for (int j0 = 0; j0 < 128; j0 += 32) { const bf16x8_t vy = frag_tr(Vs, 136, j0, q_wave * 16, r, g);
#pragma unroll
            for (int dt = 0; dt < 4; ++dt) acc[dt] = mma(acc[dt], frag_tr(Ks, 72, j0, dt * 16, r, g), vy); }
        LDSP float* ob = (LDSP float*)(Vs + 128 * 136) + q_wave * (16 * 68);
#pragma unroll
        for (int dt = 0; dt < 4; ++dt) *(LDSP f32x4_t*)(ob + r * 68 + dt * 16 + 4 * g) = acc[dt];
        bf16_t* dst = RKV + ((((size_t)n * 2 + b) * 4 + h) * 128 + q_wave * 16) * 64;
#pragma unroll
        for (int k = 0; k < 2; ++k) { const int rw = (lane >> 3) + 8 * k, ck = lane & 7; const f32x4_t lo = *(const LDSP f32x4_t*)(ob + rw * 68 + ck * 8), hi = *(const LDSP f32x4_t*)(ob + rw * 68 + ck * 8 + 4);
            *(u32x4_t*)(dst + rw * 64 + ck * 8) = (u32x4_t){pk2(lo[0], lo[1]), pk2(lo[2], lo[3]), pk2(hi[0], hi[1]), pk2(hi[2], hi[3])}; }
    }
    }
}
__device__ __forceinline__ void ph_ret2(const Params& p, int q_wave, int l) {
    PH_PROLOGUE
    bf16_t* RKV = (bf16_t*)(q_ws + WS_RKV);
    for (int idx = q_bid * NTHR + q_tid; idx < 32768; idx += gridDim.x * NTHR) {
        const float cd = __expf(ret_lg((idx >> 12) & 3) * 128.0f); float2 st = make_float2(0.f, 0.f);
#pragma unroll 32
        for (int n = 0; n < 128; ++n) { unsigned* q = (unsigned*)(RKV + (size_t)n * 65536) + idx; const unsigned kv = *q; *q = pk2(st.x, st.y); st.x = cd * st.x + __uint_as_float(kv << 16); st.y = cd * st.y + __uint_as_float(kv & 0xffff0000u); }
    }
}
__device__ __forceinline__ void ret3_load(const bf16_t* P, const bf16_t* RKV, int u, int q_tid, u32x4_t (&kr)[2], u32x4_t (&vr)[4], u32x4_t (&pr)[2]) {
    const int ch = u >> 2, h = u & 3, b = ch >> 7, n = ch & 127, tok0 = ch * 128;
#pragma unroll
    for (int i = 0; i < 2; ++i) { const int c = q_tid + i * NTHR; kr[i] = ldnt_u4(P + (size_t)(tok0 + (c >> 3)) * NPP + C_RK + h * 64 + (c & 7) * 8); }
#pragma unroll
    for (int i = 0; i < 4; ++i) { const int c = q_tid + i * NTHR; vr[i] = ldnt_u4(P + (size_t)(tok0 + (c >> 4)) * NPP + C_RV + h * 128 + (c & 15) * 8); }
    const bf16_t* src = RKV + (((size_t)n * 2 + b) * 4 + h) * 8192;
#pragma unroll
    for (int i = 0; i < 2; ++i) pr[i] = ldnt_u4(src + (q_tid + i * NTHR) * 8);
}
__device__ __forceinline__ void ph_ret3(const Params& p, int q_wave, int l, float* lds) {
    PH_PROLOGUE
    LDSP bf16_t* Ks = (LDSP bf16_t*)lds; LDSP bf16_t* Vs = Ks + 128 * 72; LDSP bf16_t* Pt = Vs + 128 * 136; LDSP bf16_t* Sw = Pt + 128 * 72 + q_wave * (16 * 136);
    const bf16_t* P = (const bf16_t*)(q_ws + WS_P); const bf16_t* RKV = (const bf16_t*)(q_ws + WS_RKV); bf16_t* YR = (bf16_t*)(q_ws + WS_YR);
    const float* rgn = p.in[2] + l * MIXW;
    LDSP float* gw = (LDSP float*)(Pt + 128 * 72 + 8 * 16 * 136);
    __syncthreads(); gw[q_tid] = rgn[q_tid];
    const int lane = q_tid & 63, r = lane & 15, g = lane >> 4, i0 = q_wave * 16;
    u32x4_t kr[2], vr[4], pr[2]; bf16x8_t qn[2];
#define RET3_QLOAD(u_) do { const bf16_t* qr_ = P + (size_t)(((u_) >> 2) * 128 + i0 + r) * NPP + C_RQ + ((u_) & 3) * 64 + 8 * g; qn[0] = ldnt_b8(qr_); qn[1] = ldnt_b8(qr_ + 32); } while (0)
    if (q_bid < (T / 128) * 4) { ret3_load(P, RKV, q_bid, q_tid, kr, vr, pr); RET3_QLOAD(q_bid); }
    int uprev = -1;
#define RET3_FLUSH() do { _Pragma("unroll") for (int k = 0; k < 4; ++k) { const int rw = (lane >> 4) + 4 * k, ck = lane & 15; \
        *(u32x4_t*)(YR + (size_t)((uprev >> 2) * 128 + i0 + rw) * MIXW + (uprev & 3) * 128 + ck * 8) = *(const LDSP u32x4_t*)(Sw + rw * 136 + ck * 8); } } while (0)
#undef RET3_FLUSH
#define RET3_FLUSH() do { _Pragma("unroll") for (int k = 0; k < 2; ++k) { const int rw = (lane >> 3) + 8 * k, ck = lane & 7; \
        *(u32x4_t*)((unsigned char*)YR + (size_t)((uprev >> 2) * 128 + i0 + rw) * MIXW + (uprev & 3) * 128 + ck * 16) = *(const LDSP u32x4_t*)((LDSP unsigned char*)Sw + rw * 144 + ck * 16); } } while (0)
    for (int u = q_bid; u < (T / 128) * 4; u += gridDim.x) {
        const int ch = u >> 2, h = u & 3, tok0 = ch * 128; const float lg = ret_lg(h);
        __syncthreads();
#pragma unroll
        for (int i = 0; i < 2; ++i) { const int c = q_tid + i * NTHR; *(LDSP u32x4_t*)(Ks + (c >> 3) * 72 + (c & 7) * 8) = kr[i]; }
#pragma unroll
        for (int i = 0; i < 4; ++i) { const int c = q_tid + i * NTHR; *(LDSP u32x4_t*)(Vs + (c >> 4) * 136 + (c & 15) * 8) = vr[i]; }
#pragma unroll
        for (int i = 0; i < 2; ++i) { const int c = q_tid + i * NTHR, e = c >> 3, d = (c & 7) * 8; *(LDSP u32x4_t*)(Pt + e * 72 + d) = pr[i]; }
        bf16x8_t qf[2]; qf[0] = qn[0]; qf[1] = qn[1];
        __syncthreads();
        asm volatile("" : "+v"(qf[0]), "+v"(qf[1]));
        if (uprev >= 0) RET3_FLUSH();
        u32x2_t rgq[8];
#pragma unroll
        for (int et = 0; et < 8; ++et) rgq[et] = *(const u32x2_t*)(P + (size_t)(tok0 + i0 + r) * NPP + C_RG + h * 128 + et * 16 + 4 * g);
        if (u + (int)gridDim.x < (T / 128) * 4) { ret3_load(P, RKV, u + gridDim.x, q_tid, kr, vr, pr); RET3_QLOAD(u + gridDim.x); }
        const int ntile = q_wave + 1, nt2 = (ntile + 1) & ~1;
        for (int jt = 0; jt < nt2; ++jt) { f32x4_t a = (f32x4_t){0.f, 0.f, 0.f, 0.f};
            if (jt < ntile) { a = mma(a, frag_row(Ks, 72, jt * 16, 0, r, g), qf[0]); a = mma(a, frag_row(Ks, 72, jt * 16, 32, r, g), qf[1]); }
            float sv[4];
#pragma unroll
            for (int ii = 0; ii < 4; ++ii) { const int dij = (i0 + r) - (jt * 16 + 4 * g + ii); sv[ii] = dij >= 0 ? a[ii] * 0.125f * __expf(lg * (float)dij) : 0.f; }
            *(LDSP u32x2_t*)(Sw + r * 136 + jt * 16 + 4 * g) = (u32x2_t){pk2(sv[0], sv[1]), pk2(sv[2], sv[3])}; }
        f32x4_t o[8];
#pragma unroll
        for (int et = 0; et < 8; ++et) o[et] = (f32x4_t){0.f, 0.f, 0.f, 0.f};
        for (int j0 = 0; j0 < nt2 * 16; j0 += 32) { const bf16x8_t sy = frag_row(Sw, 136, 0, j0, r, g);
#pragma unroll
            for (int et = 0; et < 8; ++et) o[et] = mma(o[et], frag_tr(Vs, 136, j0, et * 16, r, g), sy); }
        { const float qd = __expf(lg * (float)(i0 + r + 1)); const bf16x8_t q0 = scale_frag(qf[0], qd), q1 = scale_frag(qf[1], qd);
#pragma unroll
          for (int et = 0; et < 8; ++et) { o[et] = mma(o[et], frag_row(Pt, 72, et * 16, 0, r, g), q0); o[et] = mma(o[et], frag_row(Pt, 72, et * 16, 32, r, g), q1); } }
        float s1 = 0.f;
#pragma unroll
        for (int et = 0; et < 8; ++et) s1 += (o[et][0] + o[et][1]) + (o[et][2] + o[et][3]);
        s1 += __shfl_xor(s1, 16); s1 += __shfl_xor(s1, 32);
        const float mu = s1 * (1.0f / 128.0f); float s2 = 0.f;
#pragma unroll
        for (int et = 0; et < 8; ++et) { o[et] -= mu; s2 += (o[et][0] * o[et][0] + o[et][1] * o[et][1]) + (o[et][2] * o[et][2] + o[et][3] * o[et][3]); }
        s2 += __shfl_xor(s2, 16); s2 += __shfl_xor(s2, 32);
        const float rstd = rsqrtf(s2 * (1.0f / 128.0f) + LN_EPS);
        const size_t tok = (size_t)(tok0 + i0 + r);
#pragma unroll
        for (int et = 0; et < 8; ++et) { const int c = h * 128 + et * 16 + 4 * g; const f32x4_t gn_ = *(const LDSP f32x4_t*)(gw + c); const float4 gn = make_float4(gn_[0], gn_[1], gn_[2], gn_[3]); const float4 rg = make_float4(__uint_as_float(rgq[et].x << 16), __uint_as_float(rgq[et].x & 0xffff0000u), __uint_as_float(rgq[et].y << 16), __uint_as_float(rgq[et].y & 0xffff0000u));
            *(LDSP unsigned*)((LDSP unsigned char*)Sw + r * 144 + et * 16 + 4 * g) = pk4_fp8(o[et][0] * rstd * gn.x * (rg.x * sigmoidf_(rg.x)), o[et][1] * rstd * gn.y * (rg.y * sigmoidf_(rg.y)), o[et][2] * rstd * gn.z * (rg.z * sigmoidf_(rg.z)), o[et][3] * rstd * gn.w * (rg.w * sigmoidf_(rg.w))); }
        uprev = u;
    }
    if (uprev >= 0) RET3_FLUSH();
#undef RET3_FLUSH
}

__device__ __forceinline__ float wscan_add(float v, int lane) {
#pragma unroll
    for (int o = 1; o < 64; o <<= 1) { const float t = __shfl_up(v, o); if (lane >= o) v += t; }
    return v; }
__device__ __forceinline__ float wscan_max(float v, int lane) {
#pragma unroll
    for (int o = 1; o < 64; o <<= 1) { const float t = __shfl_up(v, o); if (lane >= o) v = fmaxf(v, t); }
    return v; }
__device__ __forceinline__ float logsigmoidf_(float x) { return fminf(x, 0.f) - log1pf(__expf(-fabsf(x))); }
__device__ __forceinline__ void ml_gates(const float* IGF, const float* bi, const float* bfg, int tok0, int h, int lane, LDSP float* cum, LDSP float* ig, LDSP float* pm, float& tot, float& amax) {
    const float i0 = IGF[(size_t)(tok0 + lane) * 8 + h] + bi[h], i1 = IGF[(size_t)(tok0 + 64 + lane) * 8 + h] + bi[h];
    const float l0 = logsigmoidf_(IGF[(size_t)(tok0 + lane) * 8 + 4 + h] + bfg[h]), l1 = logsigmoidf_(IGF[(size_t)(tok0 + 64 + lane) * 8 + 4 + h] + bfg[h]);
    const float c0 = wscan_add(l0, lane), c1 = wscan_add(l1, lane) + __shfl(c0, 63);
    tot = __shfl(c1, 63);
    const float p0 = wscan_max(i0 - c0, lane), p1 = fmaxf(wscan_max(i1 - c1, lane), __shfl(p0, 63));
    amax = wmax(fmaxf(tot - c0 + i0, tot - c1 + i1));
    cum[lane] = c0; cum[64 + lane] = c1; ig[lane] = i0; ig[64 + lane] = i1; pm[lane] = p0; pm[64 + lane] = p1;
}
__device__ __forceinline__ void ph_ml1(const Params& p, int q_wave, int l, float* lds) {
    PH_PROLOGUE
    LDSP bf16_t* Ks = (LDSP bf16_t*)lds; LDSP bf16_t* Vs = Ks + 128 * 136; LDSP float* gt = (LDSP float*)(Vs + 128 * 136); LDSP bf16_t* Xs = (LDSP bf16_t*)(gt + 2048);
    const bf16_t* P = (const bf16_t*)(q_ws + WS_P); const float* IGF = (const float*)(q_ws + WS_IGF);
    bf16_t* MQ = (bf16_t*)(q_ws + WS_MQ); bf16_t* MK = (bf16_t*)(q_ws + WS_MK); bf16_t* MV = (bf16_t*)(q_ws + WS_MV); bf16_t* MC = (bf16_t*)(q_ws + WS_MC);
    bf16_t* MLC = (bf16_t*)(q_ws + WS_MLC); float* MLN = (float*)(q_ws + WS_MLN); float* MLS = (float*)(q_ws + WS_MLS);
    const float* wq = p.in[5] + (size_t)l * 128 * 16; const float* wk = p.in[6] + (size_t)l * 128 * 16; const float* wv = p.in[7] + (size_t)l * 128 * 16;
    const float* bi = p.in[8] + l * 4; const float* bfg = p.in[9] + l * 4; const float* cw = p.in[3] + (size_t)l * 4 * MIXW; const float* cb = p.in[4] + (size_t)l * MIXW;
    const int lane = q_tid & 63, r = lane & 15, g = lane >> 4;
    for (int ch = q_bid; ch < T / 128; ch += gridDim.x) {
        const int b = ch >> 7, n = ch & 127, tok0 = ch * 128;
        u32x4_t xr[5];
#define ML1_XLOAD(h_) do { _Pragma("unroll") for (int i = 0; i < 5; ++i) { const int c = q_tid + i * NTHR, jr = c >> 4, cc = c & 15; xr[i] = (u32x4_t){0u, 0u, 0u, 0u}; \
            if (c < 131 * 16 && (n > 0 || jr >= 3)) xr[i] = ldnt_u4(P + (size_t)(tok0 + jr - 3) * NPP + C_MX + (h_) * 128 + cc * 8); } } while (0)
        ML1_XLOAD(0);
        __syncthreads();
        if (q_wave < 4) { const int h = q_wave; float tot, amax; ml_gates(IGF, bi, bfg, tok0, h, lane, gt + h * 512, gt + h * 512 + 128, gt + h * 512 + 256, tot, amax);
            gt[h * 512 + 384 + lane] = __expf(tot - gt[h * 512 + lane] + gt[h * 512 + 128 + lane] - amax); gt[h * 512 + 384 + 64 + lane] = __expf(tot - gt[h * 512 + 64 + lane] + gt[h * 512 + 128 + 64 + lane] - amax);
            if (lane == 0) { float* ms = MLS + (((size_t)n * 2 + b) * 4 + h) * 4; ms[0] = tot; ms[1] = amax; }
            float* gtg = (float*)(q_ws + WS_GT) + (size_t)(ch * 4 + h) * 384;
#pragma unroll
            for (int q = 0; q < 3; ++q) { gtg[q * 128 + lane] = gt[h * 512 + q * 128 + lane]; gtg[q * 128 + 64 + lane] = gt[h * 512 + q * 128 + 64 + lane]; } }
        __syncthreads();
        for (int h = 0; h < 4; ++h) {
#pragma unroll
            for (int i = 0; i < 5; ++i) { const int c = q_tid + i * NTHR, jr = c >> 4, cc = c & 15; if (c < 131 * 16) *(LDSP u32x4_t*)(Xs + jr * 136 + cc * 8) = xr[i]; }
            if (h < 3) ML1_XLOAD(h + 1);
            const int nb = q_tid & 31, n4 = h * 32 + nb, jr0 = q_tid >> 5;
            float cwr[4][4], cbr[4], wqr[16], wkr[16], wvr[16];
#pragma unroll
            for (int i = 0; i < 4; ++i) { const float4 t4 = *(const float4*)(cw + i * MIXW + n4 * 4); cwr[i][0] = t4.x; cwr[i][1] = t4.y; cwr[i][2] = t4.z; cwr[i][3] = t4.w; }
            { const float4 t4 = *(const float4*)(cb + n4 * 4); cbr[0] = t4.x; cbr[1] = t4.y; cbr[2] = t4.z; cbr[3] = t4.w; }
#pragma unroll
            for (int i = 0; i < 4; ++i) { const float4 a4 = *(const float4*)(wq + n4 * 16 + i * 4), b4 = *(const float4*)(wk + n4 * 16 + i * 4), c4 = *(const float4*)(wv + n4 * 16 + i * 4);
                wqr[i * 4] = a4.x; wqr[i * 4 + 1] = a4.y; wqr[i * 4 + 2] = a4.z; wqr[i * 4 + 3] = a4.w; wkr[i * 4] = b4.x; wkr[i * 4 + 1] = b4.y; wkr[i * 4 + 2] = b4.z; wkr[i * 4 + 3] = b4.w;
                wvr[i * 4] = c4.x; wvr[i * 4 + 1] = c4.y; wvr[i * 4 + 2] = c4.z; wvr[i * 4 + 3] = c4.w; }
            __syncthreads();
#pragma unroll 2
            for (int it = 0; it < 8; ++it) { const int j = jr0 + 16 * it, tok = tok0 + j;
                float xv[4][4];
#pragma unroll
                for (int i = 0; i < 4; ++i) { const u32x2_t w = *(const LDSP u32x2_t*)(Xs + (j + i) * 136 + nb * 4);
                    xv[i][0] = __uint_as_float(w.x << 16); xv[i][1] = __uint_as_float(w.x & 0xffff0000u); xv[i][2] = __uint_as_float(w.y << 16); xv[i][3] = __uint_as_float(w.y & 0xffff0000u); }
                float mc[4], q[4] = {0, 0, 0, 0}, k[4] = {0, 0, 0, 0}, v[4] = {0, 0, 0, 0};
#pragma unroll
                for (int c = 0; c < 4; ++c) { float a = cbr[c];
#pragma unroll
                    for (int i = 0; i < 4; ++i) a += cwr[i][c] * xv[i][c];
                    mc[c] = a * sigmoidf_(a); }
#pragma unroll
                for (int c = 0; c < 4; ++c)
#pragma unroll
                    for (int d = 0; d < 4; ++d) { q[d] += mc[c] * wqr[c * 4 + d]; k[d] += mc[c] * wkr[c * 4 + d]; v[d] += xv[3][c] * wvr[c * 4 + d]; }
#pragma unroll
                for (int d = 0; d < 4; ++d) k[d] *= 0.08838834764831845f;
                const size_t o = (size_t)tok * MIXW + n4 * 4;
                st_bf4(MQ + o, make_float4(q[0], q[1], q[2], q[3])); st_bf4(MK + o, make_float4(k[0], k[1], k[2], k[3])); st_bf4(MV + o, make_float4(v[0], v[1], v[2], v[3])); st_bf4(MC + o, make_float4(mc[0], mc[1], mc[2], mc[3]));
                const float wa = gt[h * 512 + 384 + j];
                *(LDSP u32x2_t*)(Ks + j * 136 + nb * 4) = (u32x2_t){pk2(k[0] * wa, k[1] * wa), pk2(k[2] * wa, k[3] * wa)};
                *(LDSP u32x2_t*)(Vs + j * 136 + nb * 4) = (u32x2_t){pk2(v[0], v[1]), pk2(v[2], v[3])}; }
            __syncthreads();
            f32x4_t acc[8];
#pragma unroll
            for (int dt = 0; dt < 8; ++dt) acc[dt] = (f32x4_t){0.f, 0.f, 0.f, 0.f};
#pragma unroll
            for (int j0 = 0; j0 < 128; j0 += 32) { const bf16x8_t vy = frag_tr(Vs, 136, j0, q_wave * 16, r, g);
#pragma unroll
                for (int dt = 0; dt < 8; ++dt) acc[dt] = mma(acc[dt], frag_tr(Ks, 136, j0, dt * 16, r, g), vy); }
            const size_t sb = ((size_t)n * 2 + b) * 4 + h;
            { LDSP float* ob = (LDSP float*)(Xs + 131 * 136) + q_wave * (16 * 68);
              bf16_t* dst = MLC + (sb * 128 + q_wave * 16) * 128;
#pragma unroll
              for (int hf = 0; hf < 2; ++hf) {
#pragma unroll
                  for (int dt = 0; dt < 4; ++dt) *(LDSP f32x4_t*)(ob + r * 68 + dt * 16 + 4 * g) = acc[hf * 4 + dt];
#pragma unroll
                  for (int k = 0; k < 2; ++k) { const int rw = (lane >> 3) + 8 * k, ck = lane & 7; const f32x4_t lo = *(const LDSP f32x4_t*)(ob + rw * 68 + ck * 8), hi = *(const LDSP f32x4_t*)(ob + rw * 68 + ck * 8 + 4);
                      *(u32x4_t*)(dst + rw * 128 + hf * 64 + ck * 8) = (u32x4_t){pk2(lo[0], lo[1]), pk2(lo[2], lo[3]), pk2(hi[0], hi[1]), pk2(hi[2], hi[3])}; } } }
            if (q_tid < 128) { float sm = 0.f; for (int j = 0; j < 128; ++j) sm += bf2f(Ks[j * 136 + q_tid]); MLN[sb * 128 + q_tid] = sm; }
            __syncthreads();
        }
    }
}
#undef ML1_XLOAD
__device__ __forceinline__ void ph_ml2(const Params& p, int q_wave, int l, float* lds) {
    PH_PROLOGUE
    bf16_t* MLC = (bf16_t*)(q_ws + WS_MLC); float* MLN = (float*)(q_ws + WS_MLN); float* MLS = (float*)(q_ws + WS_MLS);
    LDSP float* co = (LDSP float*)lds;
    const int vb = gridDim.x - 1 - q_bid;
    if (vb * NTHR >= 8 * 16512 / 2) return;
    __syncthreads();
    for (int i = q_tid; i < 1024; i += NTHR) { const int n = i >> 3, bh = i & 7; const float4 ms = *(const float4*)(MLS + ((size_t)n * 8 + bh) * 4); co[(bh * 128 + n) * 2] = ms.x; co[(bh * 128 + n) * 2 + 1] = ms.y; }
    __syncthreads();
    if (q_tid < 8) { const int bh = q_tid; float m = 0.f;
        for (int n = 0; n < 128; ++n) { const float gs = co[(bh * 128 + n) * 2], am = co[(bh * 128 + n) * 2 + 1]; const float mn = fmaxf(gs + m, am);
            co[(bh * 128 + n) * 2] = __expf(gs + m - mn); co[(bh * 128 + n) * 2 + 1] = __expf(am - mn);
            if (vb == 0) MLS[((size_t)n * 8 + bh) * 4 + 2] = m;
            m = mn; } }
    __syncthreads();
    for (int idx = vb * NTHR + q_tid; idx < 8 * 16512 / 2; idx += gridDim.x * NTHR) {
        if (idx < 65536) { const int bh = idx >> 13; unsigned* base = (unsigned*)(MLC + (size_t)bh * 16384) + (idx & 8191); float2 st = make_float2(0.f, 0.f);
#pragma unroll 32
            for (int n = 0; n < 128; ++n) { const float so = co[(bh * 128 + n) * 2], sn = co[(bh * 128 + n) * 2 + 1];
                unsigned* q = base + (size_t)n * (8 * 16384 / 2); const unsigned cv = *q; *q = pk2(st.x, st.y); st.x = so * st.x + sn * __uint_as_float(cv << 16); st.y = so * st.y + sn * __uint_as_float(cv & 0xffff0000u); } }
        else { const int j = idx - 65536, bh = j >> 6; float* base = MLN + (size_t)bh * 128 + (j & 63) * 2; float2 st = make_float2(0.f, 0.f);
#pragma unroll 32
            for (int n = 0; n < 128; ++n) { const float so = co[(bh * 128 + n) * 2], sn = co[(bh * 128 + n) * 2 + 1];
                float2* q = (float2*)(base + (size_t)n * (8 * 128)); const float2 cv = *q; *q = st; st.x = so * st.x + sn * cv.x; st.y = so * st.y + sn * cv.y; } }
    }
}
__device__ __forceinline__ void ml3_load(const bf16_t* MK, const bf16_t* MV, const bf16_t* MLC, const float* GT, const float* MLN, int u, int q_tid, u32x4_t (&kr)[4], u32x4_t (&vr)[4], u32x4_t (&cr)[4], float& gv) {
    const int ch = u >> 2, h = u & 3, b = ch >> 7, n = ch & 127, tok0 = ch * 128; const size_t sb = ((size_t)n * 2 + b) * 4 + h;
#pragma unroll
    for (int i = 0; i < 4; ++i) { const int c = q_tid + i * NTHR; const size_t o = (size_t)(tok0 + (c >> 4)) * MIXW + h * 128 + (c & 15) * 8; kr[i] = ldnt_u4(MK + o); vr[i] = ldnt_u4(MV + o); }
#pragma unroll
    for (int i = 0; i < 4; ++i) cr[i] = ldnt_u4(MLC + sb * 16384 + (size_t)(q_tid + i * NTHR) * 8);
    gv = q_tid < 384 ? GT[(size_t)u * 384 + q_tid] : MLN[sb * 128 + (q_tid - 384)];
}
__device__ __forceinline__ void ph_ml3(const Params& p, int q_wave, int l, float* lds) {
    PH_PROLOGUE
    LDSP bf16_t* Ks = (LDSP bf16_t*)lds; LDSP bf16_t* Vs = Ks + 128 * 136; LDSP bf16_t* Ct = Vs + 128 * 136; LDSP bf16_t* Sw = Ct + 128 * 136 + q_wave * (16 * 136);
    LDSP float* gt = (LDSP float*)(Ct + 128 * 136 + 8 * 16 * 136);
    LDSP float* gw = gt + 512;
    const bf16_t* P = (const bf16_t*)(q_ws + WS_P); const float* IGF = (const float*)(q_ws + WS_IGF);
    const bf16_t* MQ = (const bf16_t*)(q_ws + WS_MQ); const bf16_t* MK = (const bf16_t*)(q_ws + WS_MK); const bf16_t* MV = (const bf16_t*)(q_ws + WS_MV); const bf16_t* MC = (const bf16_t*)(q_ws + WS_MC);
    const bf16_t* MLC = (const bf16_t*)(q_ws + WS_MLC); const float* MLN = (const float*)(q_ws + WS_MLN); const float* MLS = (const float*)(q_ws + WS_MLS);
    bf16_t* YM = (bf16_t*)(q_ws + WS_YM);
    const float* bi = p.in[8] + l * 4; const float* bfg = p.in[9] + l * 4; const float* mgn = p.in[10] + l * MIXW; const float* msk = p.in[11] + l * MIXW;
    const int lane = q_tid & 63, r = lane & 15, g = lane >> 4, i0 = q_wave * 16;
    u32x4_t kr[4], vr[4], cr[4]; float gv = 0.f; const float* GT = (const float*)(q_ws + WS_GT);
    __syncthreads(); gw[q_tid] = mgn[q_tid]; gw[512 + q_tid] = msk[q_tid];
    bf16x8_t qn[4];
#define ML3_QLOAD(u_) do { const bf16_t* qr_ = MQ + (size_t)(((u_) >> 2) * 128 + i0 + r) * MIXW + ((u_) & 3) * 128 + 8 * g; _Pragma("unroll") for (int ks_ = 0; ks_ < 4; ++ks_) qn[ks_] = ldnt_b8(qr_ + 32 * ks_); } while (0)
#define ML3_SB(u_) ((((size_t)(((u_) >> 2) & 127)) * 2 + ((u_) >> 9)) * 4 + ((u_) & 3))
    float mprev_n = 0.f;
    if (q_bid < (T / 128) * 4) { ml3_load(MK, MV, MLC, GT, MLN, q_bid, q_tid, kr, vr, cr, gv); ML3_QLOAD(q_bid); mprev_n = MLS[ML3_SB(q_bid) * 4 + 2]; }
    int uprev = -1;
#define ML3_FLUSH() do { _Pragma("unroll") for (int k = 0; k < 4; ++k) { const int rw = (lane >> 4) + 4 * k, ck = lane & 15; \
        *(u32x4_t*)(YM + (size_t)((uprev >> 2) * 128 + i0 + rw) * MIXW + (uprev & 3) * 128 + ck * 8) = *(const LDSP u32x4_t*)(Sw + rw * 136 + ck * 8); } } while (0)
#undef ML3_FLUSH
#define ML3_FLUSH() do { _Pragma("unroll") for (int k = 0; k < 2; ++k) { const int rw = (lane >> 3) + 8 * k, ck = lane & 7; \
        *(u32x4_t*)((unsigned char*)YM + (size_t)((uprev >> 2) * 128 + i0 + rw) * MIXW + (uprev & 3) * 128 + ck * 16) = *(const LDSP u32x4_t*)((LDSP unsigned char*)Sw + rw * 144 + ck * 16); } } while (0)
    for (int u = q_bid; u < (T / 128) * 4; u += gridDim.x) {
        const int ch = u >> 2, h = u & 3, tok0 = ch * 128;
        __syncthreads();
#pragma unroll
        for (int i = 0; i < 4; ++i) { const int c = q_tid + i * NTHR; *(LDSP u32x4_t*)(Ks + (c >> 4) * 136 + (c & 15) * 8) = kr[i]; *(LDSP u32x4_t*)(Vs + (c >> 4) * 136 + (c & 15) * 8) = vr[i]; }
#pragma unroll
        for (int i = 0; i < 4; ++i) { const int c = q_tid + i * NTHR, e = c >> 4, d = (c & 15) * 8; *(LDSP u32x4_t*)(Ct + e * 136 + d) = cr[i]; }
        gt[q_tid] = gv;
        bf16x8_t qf[4];
#pragma unroll
        for (int ks = 0; ks < 4; ++ks) qf[ks] = qn[ks];
        const float mprev = mprev_n;
        __syncthreads();
        asm volatile("" : "+v"(qf[0]), "+v"(qf[1]), "+v"(qf[2]), "+v"(qf[3]));
        if (uprev >= 0) ML3_FLUSH();
        u32x2_t ogq[8], mcq[8];
#pragma unroll
        for (int et = 0; et < 8; ++et) { const int c = h * 128 + et * 16 + 4 * g; ogq[et] = *(const u32x2_t*)(P + (size_t)(tok0 + i0 + r) * NPP + C_MO + c); mcq[et] = *(const u32x2_t*)(MC + (size_t)(tok0 + i0 + r) * MIXW + c); }
        if (u + (int)gridDim.x < (T / 128) * 4) { ml3_load(MK, MV, MLC, GT, MLN, u + gridDim.x, q_tid, kr, vr, cr, gv); ML3_QLOAD(u + gridDim.x); mprev_n = MLS[ML3_SB(u + gridDim.x) * 4 + 2]; }
        const float cum_i = gt[i0 + r], mq = cum_i + fmaxf(mprev, gt[256 + i0 + r]), inter = __expf(cum_i + mprev - mq);
        const int ntile = q_wave + 1, nt2 = (ntile + 1) & ~1;
        float den = 0.f;
        for (int jt = 0; jt < nt2; ++jt) { f32x4_t a = (f32x4_t){0.f, 0.f, 0.f, 0.f};
            if (jt < ntile) {
#pragma unroll
                for (int ks = 0; ks < 4; ++ks) a = mma(a, frag_row(Ks, 136, jt * 16, 32 * ks, r, g), qf[ks]); }
            float sv[4];
#pragma unroll
            for (int ii = 0; ii < 4; ++ii) { const int sj = jt * 16 + 4 * g + ii; sv[ii] = sj <= i0 + r ? a[ii] * __expf(cum_i - gt[sj] + gt[128 + sj] - mq) : 0.f; den += sv[ii]; }
            *(LDSP u32x2_t*)(Sw + r * 136 + jt * 16 + 4 * g) = (u32x2_t){pk2(sv[0], sv[1]), pk2(sv[2], sv[3])}; }
        f32x4_t o[8];
#pragma unroll
        for (int et = 0; et < 8; ++et) o[et] = (f32x4_t){0.f, 0.f, 0.f, 0.f};
        for (int j0 = 0; j0 < nt2 * 16; j0 += 32) { const bf16x8_t sy = frag_row(Sw, 136, 0, j0, r, g);
#pragma unroll
            for (int et = 0; et < 8; ++et) o[et] = mma(o[et], frag_tr(Vs, 136, j0, et * 16, r, g), sy); }
        float qn = 0.f;
#pragma unroll
        for (int ks = 0; ks < 4; ++ks) { float f[8]; unpack8u(__builtin_bit_cast(u32x4_t, qf[ks]), f);
#pragma unroll
            for (int jj = 0; jj < 8; ++jj) qn += f[jj] * gt[384 + 32 * ks + 8 * g + jj];
            qf[ks] = scale_frag(qf[ks], inter); }
#pragma unroll
        for (int et = 0; et < 8; ++et)
#pragma unroll
            for (int ks = 0; ks < 4; ++ks) o[et] = mma(o[et], frag_row(Ct, 136, et * 16, 32 * ks, r, g), qf[ks]);
        den += inter * qn; den += __shfl_xor(den, 16); den += __shfl_xor(den, 32);
        const float dinv = 1.0f / fmaxf(fabsf(den), __expf(-mq));
        float s1 = 0.f;
#pragma unroll
        for (int et = 0; et < 8; ++et) { o[et] *= dinv; s1 += (o[et][0] + o[et][1]) + (o[et][2] + o[et][3]); }
        s1 += __shfl_xor(s1, 16); s1 += __shfl_xor(s1, 32);
        const float mu = s1 * (1.0f / 128.0f); float s2 = 0.f;
#pragma unroll
        for (int et = 0; et < 8; ++et) { o[et] -= mu; s2 += (o[et][0] * o[et][0] + o[et][1] * o[et][1]) + (o[et][2] * o[et][2] + o[et][3] * o[et][3]); }
        s2 += __shfl_xor(s2, 16); s2 += __shfl_xor(s2, 32);
        const float rstd = rsqrtf(s2 * (1.0f / 128.0f) + LN_EPS);
        const size_t tok = (size_t)(tok0 + i0 + r);
#pragma unroll
        for (int et = 0; et < 8; ++et) { const int c = h * 128 + et * 16 + 4 * g; const f32x4_t gn_ = *(const LDSP f32x4_t*)(gw + c), sk_ = *(const LDSP f32x4_t*)(gw + 512 + c); const float4 gn = make_float4(gn_[0], gn_[1], gn_[2], gn_[3]), sk = make_float4(sk_[0], sk_[1], sk_[2], sk_[3]); const float4 og = make_float4(__uint_as_float(ogq[et].x << 16), __uint_as_float(ogq[et].x & 0xffff0000u), __uint_as_float(ogq[et].y << 16), __uint_as_float(ogq[et].y & 0xffff0000u)), mc = make_float4(__uint_as_float(mcq[et].x << 16), __uint_as_float(mcq[et].x & 0xffff0000u), __uint_as_float(mcq[et].y << 16), __uint_as_float(mcq[et].y & 0xffff0000u));
            *(LDSP unsigned*)((LDSP unsigned char*)Sw + r * 144 + et * 16 + 4 * g) = pk4_fp8(sigmoidf_(og.x) * (o[et][0] * rstd * gn.x + sk.x * mc.x), sigmoidf_(og.y) * (o[et][1] * rstd * gn.y + sk.y * mc.y), sigmoidf_(og.z) * (o[et][2] * rstd * gn.z + sk.z * mc.z), sigmoidf_(og.w) * (o[et][3] * rstd * gn.w + sk.w * mc.w)); }
        uprev = u;
    }
    if (uprev >= 0) ML3_FLUSH();
#undef ML3_FLUSH
}


constexpr size_t DO_ATT = 0;
struct AttU { size_t tokb; int grp, h, dil, rr, nb; };
__device__ __forceinline__ AttU att_decode(int u) { AttU a; a.grp = u >> 10; const int v = u & 1023, blk = v >> 2, b = blk >> 7, bi = blk & 127; a.h = v & 3;
    a.dil = a.grp == 0 ? 1 : (a.grp == 1 ? 4 : 16); a.rr = bi % a.dil; a.nb = bi / a.dil; a.tokb = (size_t)b * SEQ; return a; }
__device__ __forceinline__ void att_load(const bf16_t* P, const AttU& a, int q_tid, u32x4_t (&kreg)[4], u32x4_t (&vreg)[8]) {
#pragma unroll
    for (int i = 0; i < 4; ++i) { const int c = q_tid + i * NTHR, j = c >> 3, cc = c & 7, u0 = (a.nb - 1) * 128 + j, uu = u0 < 0 ? u0 + 128 : u0;
        kreg[i] = *(const u32x4_t*)(P + (a.tokb + (size_t)uu * a.dil + a.rr) * NPP + C_AK + a.grp * 256 + a.h * 64 + cc * 8); }
#pragma unroll
    for (int i = 0; i < 8; ++i) { const int c = q_tid + i * NTHR, j = c >> 4, cc = c & 15, u0 = (a.nb - 1) * 128 + j, uu = u0 < 0 ? u0 + 128 : u0;
        vreg[i] = *(const u32x4_t*)(P + (a.tokb + (size_t)uu * a.dil + a.rr) * NPP + C_AV + a.grp * 512 + a.h * 128 + cc * 8); }
}
__device__ __forceinline__ void ph_att(const Params& p, int q_wave, int l, float* lds) {
    PH_PROLOGUE
    LDSP bf16_t* Ks = (LDSP bf16_t*)lds; LDSP bf16_t* Vs = Ks + 256 * 72; LDSP bf16_t* Pw = Vs + 272 * 136 + q_wave * (16 * 168);
    const bf16_t* P = (const bf16_t*)(q_ws + WS_P); bf16_t* ATT = (bf16_t*)((char*)q_out + DO_ATT); float* LSE = (float*)(q_ws + WS_LSE);
    const int lane = q_tid & 63, r = lane & 15, g = lane >> 4, i0 = q_wave * 16;
    __syncthreads();
    if (q_tid < 256) *(LDSP u32x4_t*)(Vs + (256 + (q_tid >> 4)) * 136 + (q_tid & 15) * 8) = (u32x4_t){0u, 0u, 0u, 0u};
    u32x4_t kreg[4], vreg[8]; bf16x8_t qn[2];
#define ATT_QLOAD(a_) do { const bf16_t* qr_ = P + ((a_).tokb + (size_t)((a_).nb * 128 + i0 + r) * (a_).dil + (a_).rr) * NPP + C_AQ + (a_).grp * 256 + (a_).h * 64 + 8 * g; qn[0] = ldnt_b8(qr_); qn[1] = ldnt_b8(qr_ + 32); } while (0)
    if (q_bid < 3072) { const AttU a0 = att_decode(q_bid); att_load(P, a0, q_tid, kreg, vreg); ATT_QLOAD(a0); }
    float lse_prev = 0.f; int uprev = -1;
#define ATT_FLUSH() do { const AttU ap = att_decode(uprev); _Pragma("unroll") for (int k = 0; k < 4; ++k) { const int rw = (lane >> 4) + 4 * k, ck = lane & 15; \
            const size_t tk = ap.tokb + (size_t)ap.rr * (SEQ / ap.dil) + (size_t)(ap.nb * 128 + i0 + rw);   \
            *(u32x4_t*)(ATT + ((size_t)ap.grp * T + tk) * MIXW + ap.h * 128 + ck * 8) = *(const LDSP u32x4_t*)(Pw + rw * 168 + ck * 8); } \
        if (g == 0) LSE[((size_t)ap.grp * T + ap.tokb + (size_t)ap.rr * (SEQ / ap.dil) + (size_t)(ap.nb * 128 + i0 + r)) * 4 + ap.h] = lse_prev; } while (0)
    for (int u = q_bid; u < 3072; u += gridDim.x) {
        const AttU a = att_decode(u); const int grp = a.grp, h = a.h, dil = a.dil, nb = a.nb;
        const float slope = exp2f(-8.0f * (float)(grp * 4 + h + 1) / 12.0f) * (float)dil;
        __syncthreads();
#pragma unroll
        for (int i = 0; i < 4; ++i) { const int c = q_tid + i * NTHR; *(LDSP u32x4_t*)(Ks + (c >> 3) * 72 + (c & 7) * 8) = kreg[i]; }
#pragma unroll
        for (int i = 0; i < 8; ++i) { const int c = q_tid + i * NTHR; *(LDSP u32x4_t*)(Vs + (c >> 4) * 136 + (c & 15) * 8) = vreg[i]; }
        const size_t tokq = a.tokb + (size_t)(nb * 128 + i0 + r) * dil + a.rr;
        bf16x8_t qf[2]; qf[0] = qn[0]; qf[1] = qn[1];
        __syncthreads();
        asm volatile("" : "+v"(qf[0]), "+v"(qf[1]));
        if (uprev >= 0) ATT_FLUSH();
        if (u + (int)gridDim.x < 3072) { const AttU an = att_decode(u + gridDim.x); att_load(P, an, q_tid, kreg, vreg); ATT_QLOAD(an); }
        f32x4_t sc[9]; float mx = -INFINITY;
#pragma unroll
        for (int tt = 0; tt < 9; ++tt) { f32x4_t a4 = (f32x4_t){0.f, 0.f, 0.f, 0.f}; const int j0 = (q_wave + tt) * 16;
            a4 = mma(a4, frag_row(Ks, 72, j0, 0, r, g), qf[0]); a4 = mma(a4, frag_row(Ks, 72, j0, 32, r, g), qf[1]);
#pragma unroll
            for (int ii = 0; ii < 4; ++ii) { const int delta = r + 128 - 16 * tt - 4 * g - ii, j = j0 + 4 * g + ii; const bool ok = delta >= 0 && delta <= 128 && (nb > 0 || j >= 128);
                a4[ii] = ok ? a4[ii] * 0.125f - slope * (float)delta : -INFINITY; mx = fmaxf(mx, a4[ii]); }
            sc[tt] = a4; }
        mx = fmaxf(mx, __shfl_xor(mx, 16)); mx = fmaxf(mx, __shfl_xor(mx, 32));
        float ls = 0.f;
#pragma unroll
        for (int tt = 0; tt < 9; ++tt) { float pv[4];
#pragma unroll
            for (int ii = 0; ii < 4; ++ii) { pv[ii] = __expf(sc[tt][ii] - mx); ls += pv[ii]; }
            *(LDSP u32x2_t*)(Pw + r * 168 + tt * 16 + 4 * g) = (u32x2_t){pk2(pv[0], pv[1]), pk2(pv[2], pv[3])}; }
        *(LDSP u32x2_t*)(Pw + r * 168 + 144 + 4 * g) = (u32x2_t){0u, 0u};
        ls += __shfl_xor(ls, 16); ls += __shfl_xor(ls, 32);
        f32x4_t o[8];
#pragma unroll
        for (int et = 0; et < 8; ++et) o[et] = (f32x4_t){0.f, 0.f, 0.f, 0.f};
#pragma unroll
        for (int jj0 = 0; jj0 < 160; jj0 += 32) { const bf16x8_t sy = frag_row(Pw, 168, 0, jj0, r, g);
#pragma unroll
            for (int et = 0; et < 8; ++et) o[et] = mma(o[et], frag_tr(Vs, 136, i0 + jj0, et * 16, r, g), sy); }
        const float inv = 1.0f / ls;
#pragma unroll
        for (int et = 0; et < 8; ++et) *(LDSP u32x2_t*)(Pw + r * 168 + et * 16 + 4 * g) = (u32x2_t){pk2(o[et][0] * inv, o[et][1] * inv), pk2(o[et][2] * inv, o[et][3] * inv)};
        lse_prev = mx + __logf(ls); uprev = u;
    }
    if (uprev >= 0) ATT_FLUSH();
#undef ATT_FLUSH
#undef ATT_QLOAD
}
__device__ __forceinline__ void ph_att_combine(const Params& p, int q_wave, int l) {
    PH_PROLOGUE
    const bf16_t* ATT = (const bf16_t*)((char*)q_out + DO_ATT); const float* LSE = (const float*)(q_ws + WS_LSE); bf16_t* YA = (bf16_t*)((char*)q_out + DO_YA);
    const size_t step = (size_t)gridDim.x * NTHR;
    for (size_t i0 = (size_t)q_bid * NTHR + q_tid; i0 < (size_t)T * 64; i0 += 4 * step) {
        u32x4_t qa[4], qb[4], qc[4]; float l0[4], l1[4], l2[4];
#pragma unroll
        for (int j = 0; j < 4; ++j) { const size_t i = i0 + j * step < (size_t)T * 64 ? i0 + j * step : i0; const size_t tok = i >> 6; const int c8 = (int)(i & 63) * 8, h = c8 >> 7;
            const size_t ts = tok & (size_t)(SEQ - 1), tb = tok - ts, r1 = (size_t)T + tb + (ts & 3) * (SEQ / 4) + (ts >> 2), r2 = (size_t)2 * T + tb + (ts & 15) * (SEQ / 16) + (ts >> 4);
            l0[j] = LSE[tok * 4 + h]; l1[j] = LSE[r1 * 4 + h]; l2[j] = LSE[r2 * 4 + h];
            qa[j] = ldnt_u4(ATT + tok * MIXW + c8); qb[j] = ldnt_u4(ATT + r1 * MIXW + c8); qc[j] = ldnt_u4(ATT + r2 * MIXW + c8); }
        asm volatile("" ::: "memory");
#pragma unroll
        for (int j = 0; j < 4; ++j) { const size_t i = i0 + j * step; if (i < (size_t)T * 64) { const size_t tok = i >> 6; const int c8 = (int)(i & 63) * 8;
            const float m = fmaxf(l0[j], fmaxf(l1[j], l2[j])), e0 = __expf(l0[j] - m), e1 = __expf(l1[j] - m), e2 = __expf(l2[j] - m), inv = 1.0f / (e0 + e1 + e2);
            float a[8], b8[8], c[8]; unpack8u(qa[j], a); unpack8u(qb[j], b8); unpack8u(qc[j], c);
#pragma unroll
            for (int jj = 0; jj < 8; ++jj) a[jj] = (a[jj] * e0 + b8[jj] * e1 + c[jj] * e2) * inv;
            *(u32x2_t*)((unsigned char*)YA + tok * MIXW + c8) = (u32x2_t){pk4_fp8(a[0], a[1], a[2], a[3]), pk4_fp8(a[4], a[5], a[6], a[7])}; } }
    }
}


__device__ __forceinline__ void ln_row(float4 (&v)[4], const float* g, const float* b, int lane) {
    float s = 0.f;
#pragma unroll
    for (int i = 0; i < 4; ++i) s += (v[i].x + v[i].y) + (v[i].z + v[i].w);
    const float mu = wsum(s) * (1.0f / D); float q = 0.f;
#pragma unroll
    for (int i = 0; i < 4; ++i) { v[i].x -= mu; v[i].y -= mu; v[i].z -= mu; v[i].w -= mu; q += (v[i].x * v[i].x + v[i].y * v[i].y) + (v[i].z * v[i].z + v[i].w * v[i].w); }
    const float rstd = rsqrtf(wsum(q) * (1.0f / D) + LN_EPS);
#pragma unroll
    for (int i = 0; i < 4; ++i) { const float4 gg = *(const float4*)(g + RC(i)), bb = *(const float4*)(b + RC(i));
        v[i].x = v[i].x * rstd * gg.x + bb.x; v[i].y = v[i].y * rstd * gg.y + bb.y; v[i].z = v[i].z * rstd * gg.z + bb.z; v[i].w = v[i].w * rstd * gg.w + bb.w; }
}

__device__ __forceinline__ void ph_ln1_router(const Params& p, int q_wave, int l, float* lds) {
    PH_PROLOGUE
    float* X = (float*)(q_ws + WS_X); bf16_t* XB = (bf16_t*)(q_ws + WS_XB); unsigned char* XB8 = (unsigned char*)(q_ws + WS_XB8);
    const float* g1 = p.in[14] + l * D; const float* b1 = p.in[15] + l * D;
    const float* wr = p.in[16] + (size_t)l * D * NE; const float* br = p.in[17] + l * NE;
    int* topi = (int*)(q_ws + WS_TOPI); float* topp = (float*)(q_ws + WS_TOPP);
    unsigned* ctl = (unsigned*)(q_ws + WS_CTL);
    const int lane = q_tid & 63, wv = q_tid >> 6;
    LDSP float* ybuf = (LDSP float*)lds + wv * (4 * D);
    LDSP unsigned* cnt = (LDSP unsigned*)((LDSP float*)lds + 8 * 4 * D);
    for (int ch = q_bid; ch < T / 128; ch += gridDim.x) {
        if (q_tid < NE) cnt[q_tid] = 0u;
        __syncthreads();
        float4 nx[4];
#pragma unroll
        for (int i = 0; i < 4; ++i) nx[i] = ldnt_f4(X + (size_t)(ch * 128 + wv * 16) * D + RC(i));
        for (int grp = 0; grp < 4; ++grp) {
#pragma unroll
            for (int tt = 0; tt < 4; ++tt) {
                const int it = grp * 4 + tt, tok = ch * 128 + wv * 16 + it;
                float4 v[4];
#pragma unroll
                for (int i = 0; i < 4; ++i) v[i] = nx[i];
                if (it < 15) {
#pragma unroll
                    for (int i = 0; i < 4; ++i) nx[i] = ldnt_f4(X + (size_t)(tok + 1) * D + RC(i)); }
                ln_row(v, g1, b1, lane);
#pragma unroll
                for (int i = 0; i < 4; ++i) { const int cb = RC(i), sw = lane & 7;
                    ybuf[((cb + 0) ^ sw) * 4 + tt] = v[i].x; ybuf[((cb + 1) ^ sw) * 4 + tt] = v[i].y; ybuf[((cb + 2) ^ sw) * 4 + tt] = v[i].z; ybuf[((cb + 3) ^ sw) * 4 + tt] = v[i].w; }
#pragma unroll
                for (int c = 0; c < 2; ++c) { const float f8[8] = {v[2 * c].x, v[2 * c].y, v[2 * c].z, v[2 * c].w, v[2 * c + 1].x, v[2 * c + 1].y, v[2 * c + 1].z, v[2 * c + 1].w};
                    *(u32x4_t*)(XB + (size_t)tok * D + c * 512 + lane * 8) = pack8u(f8);
                    *(u32x2_t*)(XB8 + (size_t)tok * D + c * 512 + lane * 8) = (u32x2_t){pk4_fp8(f8[0], f8[1], f8[2], f8[3]), pk4_fp8(f8[4], f8[5], f8[6], f8[7])}; }
            }
            const int e = lane & 31, hf = lane >> 5; f32x2_t a01 = (f32x2_t){0.f, 0.f}, a23 = (f32x2_t){0.f, 0.f};
            const float* wp = wr + (size_t)(hf * 512) * NE + e; const LDSP float* yq = ybuf + hf * 512 * 4;
#pragma unroll 8
            for (int c = 0; c < 512; ++c) { const f32x4_t y = *(const LDSP f32x4_t*)(yq + c * 4); const float w = wp[(size_t)(c ^ ((c >> 3) & 7)) * NE];     const f32x2_t w2 = (f32x2_t){w, w};
                a01 = __builtin_elementwise_fma((f32x2_t){y[0], y[1]}, w2, a01); a23 = __builtin_elementwise_fma((f32x2_t){y[2], y[3]}, w2, a23); }
            float lg4[4] = {a01[0], a01[1], a23[0], a23[1]};
#pragma unroll
            for (int tt = 0; tt < 4; ++tt) { const int tok = ch * 128 + wv * 16 + grp * 4 + tt;
                float acc = lg4[tt]; acc += __shfl_xor(acc, 32); acc += br[e];
                float val = lane < 32 ? acc : -INFINITY; float tv[4]; int ti[4];
#pragma unroll
                for (int r = 0; r < 4; ++r) { const float mx = wmax(val); const unsigned long long bal = __ballot(val == mx); const int idx = __ffsll((long long)bal) - 1; tv[r] = mx; ti[r] = idx; if (lane == idx) val = -INFINITY; }
                const float e1 = __expf(tv[1] - tv[0]), e2 = __expf(tv[2] - tv[0]), e3 = __expf(tv[3] - tv[0]), inv = 1.0f / (1.0f + e1 + e2 + e3);
                if (lane == 0) { *(int4*)(topi + (size_t)tok * 4) = make_int4(ti[0], ti[1], ti[2], ti[3]); *(float4*)(topp + (size_t)tok * 4) = make_float4(inv, e1 * inv, e2 * inv, e3 * inv); }
                { const int myti = lane == 0 ? ti[0] : (lane == 1 ? ti[1] : (lane == 2 ? ti[2] : ti[3])); if (lane < 4) __hip_atomic_fetch_add(&cnt[myti], 1u, __ATOMIC_RELAXED, __HIP_MEMORY_SCOPE_WORKGROUP); } }
        }
        __syncthreads();
        if (q_tid < NE) ctl[CW_CHCNT + ch * NE + q_tid] = cnt[q_tid];
        __syncthreads();
    }
}
__device__ __forceinline__ void ph_assign(const Params& p, int q_wave, int l, float* lds) {
    PH_PROLOGUE
    unsigned* ctl = (unsigned*)(q_ws + WS_CTL);
    const int* topi = (const int*)(q_ws + WS_TOPI); const float* topp = (const float*)(q_ws + WS_TOPP);
    int* tokrow = (int*)(q_ws + WS_TOKROW); int* rowtok = (int*)(q_ws + WS_ROWTOK); float* rowp = (float*)(q_ws + WS_ROWP);
    LDSP unsigned* base = (LDSP unsigned*)lds;
    LDSP unsigned* tot = base + 32;
    LDSP unsigned* pst = base + 64;
    LDSP unsigned* red = base + 128;
    for (int ch = q_bid; ch < T / 128; ch += gridDim.x) {
        { const int e = q_tid & 31, part = q_tid >> 5; unsigned before = 0, all = 0;
#pragma unroll
          for (int k = 0; k < 16; ++k) { const int c = part * 16 + k; const unsigned v = ctl[CW_CHCNT + c * NE + e]; all += v; before += c < ch ? v : 0u; }
          red[q_tid] = before; red[512 + q_tid] = all; }
        __syncthreads();
        if (q_tid < NE) { unsigned before = 0, all = 0;
#pragma unroll
          for (int k = 0; k < 16; ++k) { before += red[k * 32 + q_tid]; all += red[512 + k * 32 + q_tid]; }
          base[q_tid] = before; tot[q_tid] = all; }
        __syncthreads();
        if (q_tid == 0) { unsigned s = 0; for (int e = 0; e < NE; ++e) { pst[e] = s; s += (tot[e] + 255u) / 256u * 256u; } pst[NE] = s; }
        __syncthreads();
        if (q_tid < NE) base[q_tid] += pst[q_tid];
        __syncthreads();
        { const int tok = ch * 128 + (q_tid >> 2), k = q_tid & 3; const int e = topi[(size_t)tok * 4 + k];
          const unsigned row = __hip_atomic_fetch_add(&base[e], 1u, __ATOMIC_RELAXED, __HIP_MEMORY_SCOPE_WORKGROUP); tokrow[(size_t)tok * 4 + k] = (int)row; rowtok[row] = tok; rowp[row] = topp[(size_t)tok * 4 + k]; }
        if (ch == 0) {
            for (int e = 0; e < NE; ++e) { const unsigned s = pst[e] + tot[e], en = pst[e + 1]; for (unsigned r = s + q_tid; r < en; r += NTHR) { rowtok[r] = 0; rowp[r] = 0.f; } }
            if (q_tid < NE) { ctl[CW_PSTART + q_tid] = pst[q_tid]; for (unsigned tl = pst[q_tid] / 256u; tl < pst[q_tid + 1] / 256u; ++tl) ctl[CW_TILEE + tl] = q_tid; }
            if (q_tid == 0) ctl[CW_NTILES] = pst[NE] / 256u;
        }
        __syncthreads();
    }
}
__device__ __forceinline__ void ph_ln2(const Params& p, int q_wave, int l, float* lds) {
    PH_PROLOGUE
    LDSP float* wig = (LDSP float*)lds; float* IGF = (float*)(q_ws + WS_IGF); unsigned char* XB8 = (unsigned char*)(q_ws + WS_XB8);
    if (l != DEPTH - 1) { __syncthreads(); stage_wig(p.in[1] + (size_t)(l + 1) * D * DIN, wig, q_tid); __syncthreads(); }
    float* X = (float*)(q_ws + WS_X); bf16_t* XB = (bf16_t*)(q_ws + WS_XB); const bf16_t* Y = (const bf16_t*)(q_ws + WS_Y);
    const int* tokrow = (const int*)(q_ws + WS_TOKROW);
    const float* g2 = p.in[24] + l * D; const float* b2 = p.in[25] + l * D;
    const int lane = q_tid & 63, wv = q_tid >> 6;
    const int tstep = gridDim.x * 8; int tok = q_bid * 8 + wv;
    int4 r1 = make_int4(0, 0, 0, 0); u32x4_t xq[2], yq[2][4];
    const bool y8 = l == DEPTH - 1;
#define LN2_LOAD(t_, r_) do { const int rr_[4] = {(r_).x, (r_).y, (r_).z, (r_).w}; _Pragma("unroll") for (int c = 0; c < 2; ++c) { xq[c] = ldnt_u4(XB + (size_t)(t_) * D + c * 512 + lane * 8); \
        _Pragma("unroll") for (int k = 0; k < 4; ++k) { if (y8) { const uint2 t8_ = ldnt_u2((const unsigned char*)Y + (size_t)rr_[k] * D + c * 512 + lane * 8); yq[c][k] = (u32x4_t){t8_.x, t8_.y, 0u, 0u}; } \
            else yq[c][k] = ldnt_u4(Y + (size_t)rr_[k] * D + c * 512 + lane * 8); } } } while (0)
    if (tok < T) { const int4 r0 = *(const int4*)(tokrow + (size_t)tok * 4); if (tok + tstep < T) r1 = *(const int4*)(tokrow + (size_t)(tok + tstep) * 4); LN2_LOAD(tok, r0); }
    int tprev = -1; u32x4_t hb[2] = {}; u32x2_t h8[2] = {}; float hg[8] = {}; f32x4_t ho[4] = {};
#define LN2_FLUSH() do { if (l == DEPTH - 1) { _Pragma("unroll") for (int i = 0; i < 4; ++i) __builtin_nontemporal_store(ho[i], (f32x4_t*)(q_out + (size_t)tprev * D + RC(i))); } \
        else { _Pragma("unroll") for (int c = 0; c < 2; ++c) { *(u32x4_t*)(XB + (size_t)tprev * D + c * 512 + lane * 8) = hb[c]; *(u32x2_t*)(XB8 + (size_t)tprev * D + c * 512 + lane * 8) = h8[c]; } igf_store(hg, IGF, tprev, lane); } } while (0)
    for (; tok < T; tok += tstep) {
        float4 v[4];
#pragma unroll
        for (int c = 0; c < 2; ++c) { float xa[8]; unpack8u(xq[c], xa);
#pragma unroll
            for (int j = 0; j < 8; ++j) xa[j] *= DN_ALPHA;
#pragma unroll
            for (int k = 0; k < 4; ++k) { float ya[8];
                if (y8) { const f32x2_t a0 = __builtin_amdgcn_cvt_pk_f32_fp8((int)yq[c][k][0], false), a1 = __builtin_amdgcn_cvt_pk_f32_fp8((int)yq[c][k][0], true), a2 = __builtin_amdgcn_cvt_pk_f32_fp8((int)yq[c][k][1], false), a3 = __builtin_amdgcn_cvt_pk_f32_fp8((int)yq[c][k][1], true);
                    ya[0] = a0[0] * (1.0f / YSC); ya[1] = a0[1] * (1.0f / YSC); ya[2] = a1[0] * (1.0f / YSC); ya[3] = a1[1] * (1.0f / YSC); ya[4] = a2[0] * (1.0f / YSC); ya[5] = a2[1] * (1.0f / YSC); ya[6] = a3[0] * (1.0f / YSC); ya[7] = a3[1] * (1.0f / YSC); }
                else unpack8u(yq[c][k], ya);
#pragma unroll
                for (int j = 0; j < 8; ++j) xa[j] += ya[j]; }
            v[2 * c] = make_float4(xa[0], xa[1], xa[2], xa[3]); v[2 * c + 1] = make_float4(xa[4], xa[5], xa[6], xa[7]); }
        asm volatile("" : "+v"(v[0].x), "+v"(v[1].x), "+v"(v[2].x), "+v"(v[3].x));
        if (tprev >= 0) LN2_FLUSH();
        if (tok + tstep < T) { const int4 rc = r1; if (tok + 2 * tstep < T) r1 = *(const int4*)(tokrow + (size_t)(tok + 2 * tstep) * 4); LN2_LOAD(tok + tstep, rc); }
        ln_row(v, g2, b2, lane);
        if (l == DEPTH - 1) {
#pragma unroll
            for (int i = 0; i < 4; ++i) ho[i] = (f32x4_t){v[i].x, v[i].y, v[i].z, v[i].w};
        } else {
#pragma unroll
            for (int c = 0; c < 2; ++c) { const float f8[8] = {v[2 * c].x, v[2 * c].y, v[2 * c].z, v[2 * c].w, v[2 * c + 1].x, v[2 * c + 1].y, v[2 * c + 1].z, v[2 * c + 1].w};
                hb[c] = pack8u(f8); h8[c] = (u32x2_t){pk4_fp8(f8[0], f8[1], f8[2], f8[3]), pk4_fp8(f8[4], f8[5], f8[6], f8[7])}; }
            igf_calc(v, wig, lane, hg);
        }
        tprev = tok;
    }
    if (tprev >= 0) LN2_FLUSH();
#undef LN2_FLUSH
#undef LN2_LOAD
}

#define XB_TMO      128
#define XB_XCNT(j)  (256  + 64 * (j))
#define XB_XSUB(j)  (1280 + 64 * (j))
#define XB_XGEN(j)  (2304 + 64 * (j))
#define XB_TOP      3328
#define XB_TOPGEN   3392
#define XCD_BAR_WORDS 3456
#define XB_SPIN_CAP (1u << 22)
#define LAS __attribute__((address_space(3)))
__device__ __forceinline__ unsigned xb_ld(unsigned* p)              { return __hip_atomic_load(p, __ATOMIC_RELAXED, __HIP_MEMORY_SCOPE_AGENT); }
__device__ __forceinline__ unsigned xb_add(unsigned* p, unsigned v) { return __hip_atomic_fetch_add(p, v, __ATOMIC_RELAXED, __HIP_MEMORY_SCOPE_AGENT); }
__device__ __forceinline__ unsigned xb_xcc_id() { return (unsigned)__builtin_amdgcn_s_getreg((3 << 11) | 20) & 0xFu; }
#define XB_SPIN(cond, bar) do { unsigned _sp = 0; while (cond) { __builtin_amdgcn_s_sleep(1); \
    if ((++_sp & 255u) == 0u) { if (xb_ld(&(bar)[XB_TMO])) break; if (_sp > XB_SPIN_CAP) { atomicAdd(&(bar)[XB_TMO], 1u); break; } } } } while (0)
struct XcdBarrier { unsigned* bar; unsigned x; volatile LAS unsigned* st; int wave; };
__device__ __forceinline__ XcdBarrier xcd_barrier_post(unsigned* bar, volatile LAS unsigned* st, int wave) {
    XcdBarrier b; b.bar = bar; b.x = xb_xcc_id(); b.st = st; b.wave = wave;
    if (wave == 0 && lane_id() == 0) (void)xb_add(&bar[XB_XCNT(b.x)], 1u);
    return b;
}
__device__ __forceinline__ void xcd_barrier_complete(unsigned* bar, unsigned x, unsigned& nloc, unsigned& nx) {
    const unsigned G = gridDim.x * gridDim.y * gridDim.z;
    unsigned sum, cnt, mine, sp = 0u;
    for (;;) {
        sum = 0u; cnt = 0u; mine = 0u;
#pragma unroll
        for (unsigned j = 0; j < 16; ++j) { const unsigned c = xb_ld(&bar[XB_XCNT(j)]); sum += c; cnt += (c > 0u) ? 1u : 0u; mine = (j == x) ? c : mine; }
        if (sum == G) break;
        __builtin_amdgcn_s_sleep(1);
        if ((++sp & 255u) == 0u) { if (xb_ld(&bar[XB_TMO])) break; if (sp > XB_SPIN_CAP) { atomicAdd(&bar[XB_TMO], 1u); break; } }
    }
    nloc = mine > 0u ? mine : 1u; nx = cnt > 0u ? cnt : 1u;
}
__device__ __forceinline__ void xcd_barrier(const XcdBarrier& b) {
    asm volatile("s_waitcnt vmcnt(0)" ::: "memory");
    __syncthreads();
    if (b.wave == 0 && lane_id() == 0) {
        unsigned* bar = b.bar;
        __builtin_amdgcn_s_waitcnt(0);
        unsigned nloc = b.st[0], nx = b.st[1];
        if (nloc == 0u) { xcd_barrier_complete(bar, b.x, nloc, nx); b.st[0] = nloc; b.st[1] = nx; }
        const unsigned old = xb_add(&bar[XB_XSUB(b.x)], 1u);
        const unsigned gen = old / nloc;
        if (old + 1u == (gen + 1u) * nloc) {
            __builtin_amdgcn_fence(__ATOMIC_RELEASE, "agent");
            asm volatile("s_waitcnt vmcnt(0)" ::: "memory");
            const unsigned og = xb_add(&bar[XB_TOP], 1u);
            const unsigned tg = og / nx;
            if (og + 1u == (tg + 1u) * nx) xb_add(&bar[XB_TOPGEN], 1u);
            else XB_SPIN(xb_ld(&bar[XB_TOPGEN]) == tg, bar);
            __builtin_amdgcn_fence(__ATOMIC_ACQUIRE, "agent");
            xb_add(&bar[XB_XGEN(b.x)], 1u);
            asm volatile("s_waitcnt vmcnt(0)" ::: "memory");
        } else {
            XB_SPIN(xb_ld(&bar[XB_XGEN(b.x)]) == gen, bar);
            __builtin_amdgcn_fence(__ATOMIC_ACQUIRE, "agent");
            asm volatile("s_waitcnt vmcnt(0)" ::: "memory");
        }
    }
    __syncthreads();
}
constexpr int CW_BAR = 65536;
constexpr int LDS_BYTES = 154112;

__global__ void __launch_bounds__(NTHR, 2) k_mega(Params pk) {
    extern __shared__ __attribute__((aligned(16))) float lds[];
    volatile LAS unsigned* xbw = (volatile LAS unsigned*)((LAS char*)lds + LDS_BYTES - 16);
    const int q_wave = __builtin_amdgcn_readfirstlane((int)(threadIdx.x >> 6));
    if (threadIdx.x == 0) { xbw[0] = 0u; xbw[1] = 0u; xbw[2] = 0u; xbw[3] = 0u; }
    __syncthreads();
    const Params& p = pk;
    (void)xcd_barrier_post((unsigned*)(uni_ptr(pk.ws) + WS_CTL) + CW_BAR, xbw, q_wave);
#define GRID_SYNC() do { XcdBarrier bar_; bar_.bar = (unsigned*)(uni_ptr(pk.ws) + WS_CTL) + CW_BAR; bar_.x = xb_xcc_id(); bar_.st = xbw; bar_.wave = q_wave; xcd_barrier(bar_); } while (0)
#define LAYER_BODY(l) do { \
        if (l == 0) { ph_pre(p, q_wave, l, lds);               GRID_SYNC(); } \
        ph_inproj_mfma(p, q_wave, l, lds);       GRID_SYNC(); \
        ph_ret1(p, q_wave, l, lds); ph_ml1(p, q_wave, l, lds); ph_att(p, q_wave, l, lds);   GRID_SYNC(); \
        ph_ret2(p, q_wave, l); ph_ml2(p, q_wave, l, lds);   GRID_SYNC(); \
        ph_ret3(p, q_wave, l, lds); ph_ml3(p, q_wave, l, lds); ph_att_combine(p, q_wave, l);   GRID_SYNC(); \
        ph_merge_mfma(p, q_wave, l, lds);        GRID_SYNC(); \
        ph_outproj_mfma(p, q_wave, l, lds);      GRID_SYNC(); \
        ph_ln1_router(p, q_wave, l, lds);        GRID_SYNC(); \
        ph_assign(p, q_wave, l, lds); if (l + 1 < DEPTH) ph_prew(p, q_wave, l + 1, lds); ph_mwc_tail(p, q_wave, l, lds);   GRID_SYNC(); \
        ph_moe1_mfma(p, q_wave, l, lds);         GRID_SYNC(); \
        ph_moe2_mfma(p, q_wave, l, lds);         GRID_SYNC(); \
        ph_ln2(p, q_wave, l, lds);               GRID_SYNC(); \
    } while (0)
    LAYER_BODY(0);
    LAYER_BODY(1);
#undef LAYER_BODY
}

}

extern "C" void kernel_launch(void* const* d_in, const int* in_sizes, int n_in, void* d_out, int out_size, void* d_ws, size_t ws_size, hipStream_t stream) {
    if (n_in != 26 || out_size != T * D || ws_size < WS_END) { fprintf(stderr, "kernel_launch: unexpected shapes (n_in %d out %d ws %zu need %zu)\n", n_in, out_size, ws_size, (size_t)WS_END); return; }
    Params p; memset(&p, 0, sizeof(p));
    for (int i = 0; i < 26; ++i) p.in[i] = (const float*)d_in[i];
    p.out = (float*)d_out; p.ws = (char*)d_ws;
    (void)hipMemsetAsync((char*)d_ws + WS_CTL, 0, CTL_BYTES, stream);
    static int grid = 0;
    if (!grid) {
        int dev = 0, cus = 0, per_cu = 0;
        if (hipGetDevice(&dev) != hipSuccess || hipDeviceGetAttribute(&cus, hipDeviceAttributeMultiprocessorCount, dev) != hipSuccess) { fprintf(stderr, "kernel_launch: device query failed\n"); grid = -1; return; }
        (void)hipFuncSetAttribute((const void*)k_mega, hipFuncAttributeMaxDynamicSharedMemorySize, LDS_BYTES);
        if (hipOccupancyMaxActiveBlocksPerMultiprocessor(&per_cu, (const void*)k_mega, NTHR, LDS_BYTES) != hipSuccess || per_cu < 1) { fprintf(stderr, "kernel_launch: occupancy query says %d\n", per_cu); grid = -1; return; }
        grid = cus;
    }
    if (grid < 0) return;
    hipLaunchKernelGGL(k_mega, dim3(grid), dim3(NTHR), LDS_BYTES, stream, p);
}
```
